# Optimizing an MI355X kernel written in HIP

```python
import jax, jax.numpy as jnp
from jax import lax
import numpy as np

D_MODEL = 1024
BATCH = 2
SEQ = 8192
DEPTH = 2

D_A = D_MODEL
CONV_W = 3
D_B = D_MODEL
DH_B = 128
G_B = D_B // DH_B
CHUNK = 128
D_C = D_MODEL
DH_C = 64
H_C = D_C // DH_C
QBLK = 128

IN_AB = 4 * D_A + 3 * D_B
IN_C = 4 * D_C
N_EVEN = (DEPTH + 1) // 2
N_ODD = DEPTH // 2
EPS = 1e-6

kernel_name = "hybrid_conv_sgmlp_stickbreak_adaln"


def rms_norm(x, g):
    xf = x.astype(jnp.float32)
    y = xf * lax.rsqrt(jnp.mean(xf * xf, axis=-1, keepdims=True) + EPS)
    return (y * g.astype(jnp.float32)).astype(x.dtype)


def conv_sgmlp_mixer(h, w_in, conv_w, sg_norm, sg_w, sg_b, w_out):
    bsz, s, _ = h.shape
    proj = h @ w_in
    cuts = [D_A, 2 * D_A, 3 * D_A, 4 * D_A, 4 * D_A + D_B, 4 * D_A + 2 * D_B]
    a_b, a_c, a_x, a_z, b_u, b_v, b_z = jnp.split(proj, cuts, axis=-1)
    conv = lax.conv_general_dilated(
        a_c * a_x, conv_w[:, None, :].astype(h.dtype), window_strides=(1,),
        padding=[(CONV_W - 1, 0)], dimension_numbers=('NWC', 'WIO', 'NWC'),
        feature_group_count=D_A)
    y_a = a_b * conv * jax.nn.silu(a_z)
    nc = s // CHUNK
    v = rms_norm(b_v.reshape(bsz, nc, CHUNK, G_B, DH_B), sg_norm)
    mask = jnp.tril(jnp.ones((CHUNK, CHUNK), dtype=bool))
    w_s = jnp.where(mask[None], sg_w, 0.0)
    sgate = jnp.einsum('gts,bcsgd->bctgd', w_s, v) + sg_b.T[:, :, None]
    y_b = b_u * sgate.reshape(bsz, s, D_B) * jax.nn.silu(b_z)
    return jnp.concatenate([y_a, y_b], axis=-1) @ w_out


def stick_breaking_attention(q, k, v):
    bsz, s, h, dh = q.shape
    nb = s // QBLK
    qf = q.astype(jnp.float32) * (dh ** -0.5)
    kf = k.astype(jnp.float32)
    vf = v.astype(jnp.float32)
    q_blocks = qf.reshape(bsz, nb, QBLK, h, dh).transpose(1, 0, 2, 3, 4)
    key_pos = jnp.arange(s)

    def block(args):
        qb, i = args
        qpos = i * QBLK + jnp.arange(QBLK)
        z = jnp.einsum('bthd,bshd->bhts', qb, kf)
        causal = key_pos[None, :] < qpos[:, None]
        log_beta = jax.nn.log_sigmoid(z)
        log_1mb = jnp.where(causal, log_beta - z, 0.0)
        suffix = lax.cumsum(log_1mb, axis=3, reverse=True) - log_1mb
        w = jnp.where(causal, jnp.exp(log_beta + suffix), 0.0)
        return jnp.einsum('bhts,bshd->bthd', w, vf)

    out = lax.map(block, (q_blocks, jnp.arange(nb)))
    return out.transpose(1, 0, 2, 3, 4).reshape(bsz, s, h, dh).astype(q.dtype)


def stick_breaking_mixer(h, w_in, q_norm, k_norm, w_out):
    bsz, s, _ = h.shape
    q, k, v, z = jnp.split(h @ w_in, 4, axis=-1)
    q = rms_norm(q.reshape(bsz, s, H_C, DH_C), q_norm)
    k = rms_norm(k.reshape(bsz, s, H_C, DH_C), k_norm)
    v = v.reshape(bsz, s, H_C, DH_C)
    o = stick_breaking_attention(q, k, v).reshape(bsz, s, D_C)
    return (o * jax.nn.silu(z)) @ w_out


def setup_inputs(seed: int = 0) -> dict:
    key = jax.random.key(seed)
    ks = jax.random.split(key, 16)

    def nrm(k, shape, scale):
        return jax.random.normal(k, shape, jnp.float32) * scale

    return {
        "x": nrm(ks[0], (BATCH, SEQ, D_MODEL), 1.0),
        "c": nrm(ks[1], (BATCH, D_MODEL), 1.0),
        "ln_g": 1.0 + nrm(ks[2], (DEPTH, D_MODEL), 0.1),
        "ada_w": nrm(ks[3], (DEPTH, D_MODEL, 3 * D_MODEL), D_MODEL ** -0.5),
        "ada_b": nrm(ks[4], (DEPTH, 3 * D_MODEL), 0.1),
        "w_in_ab": nrm(ks[5], (N_EVEN, D_MODEL, IN_AB), D_MODEL ** -0.5),
        "conv_w": nrm(ks[6], (N_EVEN, CONV_W, D_A), CONV_W ** -0.5),
        "sg_norm": 1.0 + nrm(ks[7], (N_EVEN, G_B, DH_B), 0.1),
        "sg_w": nrm(ks[8], (N_EVEN, G_B, CHUNK, CHUNK), CHUNK ** -0.5),
        "sg_b": 1.0 + nrm(ks[9], (N_EVEN, G_B, CHUNK), 0.1),
        "w_out_ab": nrm(ks[10], (N_EVEN, D_A + D_B, D_MODEL), (D_A + D_B) ** -0.5),
        "w_in_c": nrm(ks[11], (N_ODD, D_MODEL, IN_C), D_MODEL ** -0.5),
        "q_norm": 1.0 + nrm(ks[12], (N_ODD, DH_C), 0.1),
        "k_norm": 1.0 + nrm(ks[13], (N_ODD, DH_C), 0.1),
        "w_out_c": nrm(ks[14], (N_ODD, D_C, D_MODEL), D_C ** -0.5),
    }


def reference(x, c, ln_g, ada_w, ada_b, w_in_ab, conv_w, sg_norm, sg_w, sg_b,
              w_out_ab, w_in_c, q_norm, k_norm, w_out_c):
    c_act = jax.nn.silu(c)
    for l in range(DEPTH):
        mod = c_act @ ada_w[l] + ada_b[l]
        shift, scale, gate = jnp.split(mod, 3, axis=-1)
        h = rms_norm(x, ln_g[l]) * (1.0 + scale[:, None, :]) + shift[:, None, :]
        i = l // 2
        if l % 2 == 0:
            out = conv_sgmlp_mixer(h, w_in_ab[i], conv_w[i], sg_norm[i], sg_w[i],
                                   sg_b[i], w_out_ab[i])
        else:
            out = stick_breaking_mixer(h, w_in_c[i], q_norm[i], k_norm[i], w_out_c[i])
        x = x + gate[:, None, :] * out
    return x
```

```cpp
#include <hip/hip_runtime.h>
#include <hip/hip_cooperative_groups.h>
#include <cstdio>
#include <cstdint>
namespace cg = cooperative_groups;

#ifndef MK_MULTI
#define MK_MULTI 0
#endif

#define LAS __attribute__((address_space(3)))
typedef unsigned short bf16_t;
typedef short bf16x8 __attribute__((ext_vector_type(8)));
typedef float f32x4 __attribute__((ext_vector_type(4)));
typedef float f32x16 __attribute__((ext_vector_type(16)));
typedef unsigned u32x4 __attribute__((ext_vector_type(4)));
typedef unsigned u32x2 __attribute__((ext_vector_type(2)));

constexpr int BATCH = 2, SEQ = 8192, D = 1024, M = BATCH * SEQ;
constexpr int IN_AB = 7168, IN_C = 4096;
constexpr float EPS = 1e-6f;
constexpr int NWAVES = 8, NTHR = 512;
constexpr float LOG2E = 1.4426950408889634f;

constexpr size_t MiB = 1u << 20;
constexpr size_t WS_MOD = 1 * MiB;
constexpr size_t WS_WAB = 2 * MiB;
constexpr size_t WS_WOAB = 16 * MiB;
constexpr size_t WS_WC = 20 * MiB;
constexpr size_t WS_WOC = 28 * MiB;
constexpr size_t WS_U = 32 * MiB, WS_G = 64 * MiB, WS_UZ = 96 * MiB, WS_V = 128 * MiB;
constexpr size_t WS_H0 = 160 * MiB;
constexpr size_t WS_Y = 160 * MiB;
constexpr size_t WS_X1 = 32 * MiB;
constexpr size_t WS_H1 = 96 * MiB;
constexpr size_t WS_Q = 128 * MiB, WS_K = 160 * MiB, WS_Z = 192 * MiB, WS_VT = 224 * MiB;
constexpr size_t WS_OZ = 96 * MiB;
constexpr size_t WS_END = 256 * MiB;
static_assert(WS_G - WS_U == (size_t)M * D * 2 && WS_UZ - WS_G == (size_t)M * D * 2 && WS_V - WS_UZ == (size_t)M * D * 2 && WS_K - WS_Q == (size_t)M * D * 2 && WS_Z - WS_K == (size_t)M * D * 2, "contiguous activations");

constexpr int LDS_BYTES = 147456;

typedef float f32x2_t __attribute__((ext_vector_type(2))); typedef __bf16 bf16x2_t __attribute__((ext_vector_type(2)));
__device__ __forceinline__ unsigned cvt_pk_bf16(float lo, float hi) { f32x2_t v = {lo, hi}; bf16x2_t b = __builtin_convertvector(v, bf16x2_t); return __builtin_bit_cast(unsigned, b); }
__device__ __forceinline__ float bf_lo(unsigned u) { return __uint_as_float(u << 16); }
__device__ __forceinline__ float bf_hi(unsigned u) { return __uint_as_float(u & 0xffff0000u); }
__device__ __forceinline__ float fast_exp2(float x) { return __builtin_amdgcn_exp2f(x); }
__device__ __forceinline__ float fast_log2(float x) { return __builtin_amdgcn_logf(x); }
__device__ __forceinline__ float fast_rcp(float x) { return __builtin_amdgcn_rcpf(x); }
__device__ __forceinline__ float silu_f(float v) { return v * fast_rcp(1.0f + fast_exp2(-LOG2E * v)); }

namespace pg8 {
constexpr int BM = 256, BK = 64, HALF = 128, HTB = HALF * BK * 2, STAGE_BYTES = 8 * HTB, NXCD = 8, WGM = 8;
__host__ __device__ __forceinline__ int lds_byte(int r, int c) { const int st = (r >> 4) * 2 + (c >> 5), rr = r & 15, cc = c & 31, ob = rr * 64 + cc * 2; return st * 1024 + (ob ^ (((ob >> 9) & 1) << 5)); }
__host__ __device__ __forceinline__ void stage_rc(int b, int& R, int& C) { const int st = b / 1024, sb = b % 1024, swz = sb ^ (((sb >> 9) & 1) << 5); R = (st >> 1) * 16 + swz / 64; C = (st & 1) * 32 + (swz % 64) / 2; }
__host__ __device__ __forceinline__ int perm32(int rho) { const int n = rho >> 4, i = rho & 15; return 8 * (i >> 2) + 4 * n + (i & 3); }

struct Unit { int pm, pn, sel; };
struct Sched2 {
    const bf16_t *A0, *B0, *A1, *B1; int nM0, nN0, nwg0, nM1, nN1, nwg1, G, c, K;
    __device__ void init(const bf16_t* a0, const bf16_t* b0, int m0, int n0, const bf16_t* a1, const bf16_t* b1, int m1, int n1, int K_, int G_, int c_) {
        A0 = a0; B0 = b0; nM0 = m0 / BM; nN0 = n0 / BM; nwg0 = nM0 * nN0; A1 = a1; B1 = b1; nM1 = m1 / BM; nN1 = n1 / BM; nwg1 = nM1 * nN1; K = K_; G = G_; c = c_; }
    __device__ static void map(int wgid, int nM, int nN, int& pm, int& pn) {
        const int nwg = nM * nN; { const int q = nwg / NXCD, r = nwg % NXCD, xcd = wgid % NXCD, off = wgid / NXCD; wgid = (xcd < r ? xcd * (q + 1) : r * (q + 1) + (xcd - r) * q) + off; }
        const int nig = WGM * nN, gid = wgid / nig, fm = gid * WGM, gsz = (nM - fm) < WGM ? (nM - fm) : WGM;
        pm = fm + ((wgid % nig) % gsz); pn = (wgid % nig) / gsz; }
    __device__ bool next(int i, Unit& u) const {
        const int L = i * G + c;
        if (L < nwg0) { map(L, nM0, nN0, u.pm, u.pn); u.sel = 0; return true; }
        if (L < nwg0 + nwg1) { map(L - nwg0, nM1, nN1, u.pm, u.pn); u.sel = 1; return true; }
        return false; }
    __device__ __forceinline__ const char* baseA(const Unit& u) const { return (const char*)(u.sel ? A1 : A0) + (size_t)u.pm * BM * K * 2; }
    __device__ __forceinline__ const char* baseB(const Unit& u) const { return (const char*)(u.sel ? B1 : B0) + (size_t)u.pn * BM * K * 2; }
};

template <class Epi, bool ALIGN_EPI, bool SP2>
__device__ __forceinline__ void gemm_phase(LAS unsigned char* lds, const Sched2& S, const Epi& E) {
    const int tid = threadIdx.x, wid = __builtin_amdgcn_readfirstlane(tid >> 6), lane = tid & 63, wr = wid >> 2, wc = wid & 3, fr = lane & 15, fq = lane >> 4;
    const int K = S.K, nt = K / BK;
    unsigned voffA[2], voffB[2];
#pragma unroll
    for (int i = 0; i < 2; ++i) { int R, C; stage_rc(tid * 16 + i * 8192, R, C); const int Rb = Epi::PERM ? ((R & ~31) + perm32(R & 31)) : R;
        voffA[i] = (unsigned)(R * K + C) * 2u; voffB[i] = (unsigned)(Rb * K + C) * 2u; }
    const size_t kstep = (size_t)(BK * 2);
    const size_t hstep = (size_t)HALF * K * 2;
    const unsigned ldsw = (unsigned)wid * 1024u;
    const int aoff = lds_byte(wr * 64 + fr, fq * 8), boff = lds_byte(wc * 32 + fr, fq * 8);
#define PG8_SA(b, h) (((b) * 2 + (h)) * HTB)
#define PG8_SB(b, h) ((4 + (b) * 2 + (h)) * HTB)
#define PG8_STAGE(bufoff, gbase, voff) do { _Pragma("unroll") for (int _i = 0; _i < 2; ++_i) \
        __builtin_amdgcn_global_load_lds((const unsigned*)((const char*)(gbase) + (voff)[_i]), (LAS unsigned*)(lds + (bufoff) + ldsw + _i * 8192), 16, 0, 0); } while (0)
#define PG8_LDA(dst, b, h) do { _Pragma("unroll") for (int m = 0; m < 4; ++m) _Pragma("unroll") for (int k = 0; k < 2; ++k) dst[m][k] = *(const LAS bf16x8*)(lds + PG8_SA(b, h) + aoff + m * 2048 + k * 1024); } while (0)
#define PG8_LDB(dst, b, h) do { _Pragma("unroll") for (int n = 0; n < 2; ++n) _Pragma("unroll") for (int k = 0; k < 2; ++k) dst[n][k] = *(const LAS bf16x8*)(lds + PG8_SB(b, h) + boff + n * 2048 + k * 1024); } while (0)
#define PG8_MMA(ai, bj, At, Bt) do { __builtin_amdgcn_s_setprio(1); _Pragma("unroll") for (int m = 0; m < 4; ++m) _Pragma("unroll") for (int n = 0; n < 2; ++n) _Pragma("unroll") for (int k = 0; k < 2; ++k) \
        acc[ai][bj][m][n] = __builtin_amdgcn_mfma_f32_16x16x32_bf16(Bt[n][k], At[m][k], acc[ai][bj][m][n], 0, 0, 0); __builtin_amdgcn_s_setprio(0); } while (0)
#define PG8_WAIT_V(n) asm volatile("s_waitcnt vmcnt(" #n ")" ::: "memory")
#define PG8_WAIT_L(n) asm volatile("s_waitcnt lgkmcnt(" #n ")" ::: "memory")
#define PG8_BAR __builtin_amdgcn_s_barrier()
#define PG8_SCHED __builtin_amdgcn_sched_barrier(0)
    Unit cur, nxt; int ui = 0;
    if (!S.next(0, cur)) return;
    f32x4 acc[2][2][4][2];
#pragma unroll
    for (int a = 0; a < 2; ++a)
#pragma unroll
        for (int b = 0; b < 2; ++b)
#pragma unroll
            for (int m = 0; m < 4; ++m)
#pragma unroll
                for (int n = 0; n < 2; ++n) acc[a][b][m][n] = (f32x4){0.f, 0.f, 0.f, 0.f};
    bf16x8 At[4][2], B0[2][2], B1[2][2];
    const char* cA = S.baseA(cur); const char* cB = S.baseB(cur);
    if constexpr (SP2) {
        PG8_STAGE(PG8_SB(0, 0), cB, voffB); PG8_STAGE(PG8_SB(0, 1), cB + hstep, voffB); PG8_STAGE(PG8_SA(0, 0), cA, voffA); PG8_STAGE(PG8_SA(0, 1), cA + hstep, voffA);
        if (wr == 1) PG8_BAR;
        PG8_WAIT_V(2); PG8_BAR;
        PG8_STAGE(PG8_SB(1, 0), cB + kstep, voffB); PG8_STAGE(PG8_SA(1, 0), cA + kstep, voffA); PG8_STAGE(PG8_SB(1, 1), cB + hstep + kstep, voffB);
        PG8_WAIT_V(6); PG8_BAR;
    } else {
        PG8_STAGE(PG8_SB(0, 0), cB, voffB); PG8_STAGE(PG8_SA(0, 0), cA, voffA); PG8_STAGE(PG8_SB(0, 1), cB + hstep, voffB); PG8_STAGE(PG8_SA(0, 1), cA + hstep, voffA);
        if (wr == 1) PG8_BAR;
        PG8_WAIT_V(4); PG8_BAR;
        PG8_STAGE(PG8_SB(1, 0), cB + kstep, voffB); PG8_STAGE(PG8_SA(1, 0), cA + kstep, voffA); PG8_STAGE(PG8_SB(1, 1), cB + hstep + kstep, voffB);
        PG8_WAIT_V(6); PG8_BAR;
    }
    for (;;) {
        const bool has_next = S.next(ui + 1, nxt);
        const char* nA = has_next ? S.baseA(nxt) : cA; const char* nB = has_next ? S.baseB(nxt) : cB;
        for (int t = 0; t < nt; t += 2) {
            const bool last = (t == nt - 2);
            const char* a1 = cA + (size_t)(t + 1) * kstep;
            const char* a2 = last ? nA : cA + (size_t)(t + 2) * kstep; const char* b2 = last ? nB : cB + (size_t)(t + 2) * kstep;
            const char* a3 = a2 + kstep; const char* b3 = b2 + kstep;
            if constexpr (SP2) {
            PG8_LDB(B0, 0, 0); PG8_LDB(B1, 0, 1); PG8_SCHED; PG8_LDA(At, 0, 0); PG8_STAGE(PG8_SA(1, 1), a1 + hstep, voffA);
            PG8_WAIT_V(8); PG8_WAIT_L(0); PG8_BAR; PG8_MMA(0, 0, At, B0); PG8_MMA(0, 1, At, B1); PG8_BAR; PG8_SCHED;
            PG8_LDA(At, 0, 1); PG8_STAGE(PG8_SB(0, 0), b2, voffB); PG8_STAGE(PG8_SB(0, 1), b2 + hstep, voffB); PG8_STAGE(PG8_SA(0, 0), a2, voffA);
            PG8_WAIT_V(8); PG8_WAIT_L(0); PG8_BAR; PG8_MMA(1, 0, At, B0); PG8_MMA(1, 1, At, B1); PG8_BAR; PG8_SCHED;
            PG8_LDB(B0, 1, 0); PG8_LDB(B1, 1, 1); PG8_SCHED; PG8_LDA(At, 1, 0); PG8_STAGE(PG8_SA(0, 1), a2 + hstep, voffA);
            PG8_WAIT_V(8); PG8_WAIT_L(0); PG8_BAR; PG8_MMA(0, 0, At, B0); PG8_MMA(0, 1, At, B1); PG8_BAR; PG8_SCHED;
            PG8_LDA(At, 1, 1); PG8_STAGE(PG8_SB(1, 0), b3, voffB); PG8_STAGE(PG8_SB(1, 1), b3 + hstep, voffB); PG8_STAGE(PG8_SA(1, 0), a3, voffA);
            PG8_WAIT_V(8); PG8_WAIT_L(0); PG8_BAR; PG8_MMA(1, 0, At, B0); PG8_MMA(1, 1, At, B1); PG8_BAR; PG8_SCHED;
            } else {
            PG8_LDB(B0, 0, 0); PG8_SCHED; PG8_LDA(At, 0, 0); PG8_STAGE(PG8_SA(1, 1), a1 + hstep, voffA);
            PG8_WAIT_L(8); PG8_BAR; PG8_WAIT_L(0); PG8_MMA(0, 0, At, B0); PG8_BAR; PG8_SCHED;
            PG8_LDB(B1, 0, 1); PG8_STAGE(PG8_SB(0, 0), b2, voffB);
            PG8_BAR; PG8_WAIT_L(0); PG8_MMA(0, 1, At, B1); PG8_BAR;
            PG8_LDA(At, 0, 1); PG8_STAGE(PG8_SA(0, 0), a2, voffA);
            PG8_BAR; PG8_WAIT_L(0); PG8_MMA(1, 0, At, B0); PG8_BAR; PG8_SCHED;
            PG8_STAGE(PG8_SB(0, 1), b2 + hstep, voffB);
            PG8_WAIT_V(6); PG8_BAR; PG8_MMA(1, 1, At, B1); PG8_BAR;
            PG8_LDB(B0, 1, 0); PG8_SCHED; PG8_LDA(At, 1, 0); PG8_STAGE(PG8_SA(0, 1), a2 + hstep, voffA);
            PG8_WAIT_L(8); PG8_BAR; PG8_WAIT_L(0); PG8_MMA(0, 0, At, B0); PG8_BAR; PG8_SCHED;
            PG8_LDB(B1, 1, 1); PG8_STAGE(PG8_SB(1, 0), b3, voffB);
            PG8_BAR; PG8_WAIT_L(0); PG8_MMA(0, 1, At, B1); PG8_BAR;
            PG8_LDA(At, 1, 1); PG8_STAGE(PG8_SA(1, 0), a3, voffA);
            PG8_BAR; PG8_WAIT_L(0); PG8_MMA(1, 0, At, B0); PG8_BAR; PG8_SCHED;
            PG8_STAGE(PG8_SB(1, 1), b3 + hstep, voffB);
            PG8_WAIT_V(6); PG8_BAR; PG8_MMA(1, 1, At, B1); PG8_BAR;
            }
        }
        if constexpr (ALIGN_EPI) { if (wr == 0) PG8_BAR; }
        E(acc, cur, wr, wc, fr, fq);
        if (!has_next) break;
#pragma unroll
        for (int a = 0; a < 2; ++a)
#pragma unroll
            for (int b = 0; b < 2; ++b)
#pragma unroll
                for (int m = 0; m < 4; ++m)
#pragma unroll
                    for (int n = 0; n < 2; ++n) acc[a][b][m][n] = (f32x4){0.f, 0.f, 0.f, 0.f};
        cur = nxt; cA = nA; cB = nB; ++ui;
        if constexpr (ALIGN_EPI) { if (wr == 1) PG8_BAR; }
    }
    PG8_WAIT_V(0);
    if constexpr (!ALIGN_EPI) { if (wr == 0) PG8_BAR; }
    PG8_BAR;
#undef PG8_SA
#undef PG8_SB
#undef PG8_STAGE
#undef PG8_LDA
#undef PG8_LDB
#undef PG8_MMA
#undef PG8_WAIT_V
#undef PG8_WAIT_L
#undef PG8_BAR
#undef PG8_SCHED
}

struct EpiP1 {
    static constexpr bool PERM = true;
    bf16_t* U;
    __device__ __forceinline__ void operator()(const f32x4 (&acc)[2][2][4][2], const Unit& u, int wr, int wc, int fr, int fq) const {
        const int row0 = u.pm * BM + wr * 64 + fr;
        bf16_t* O = U + (size_t)(u.pn >> 3) * ((size_t)M * D);
        if (u.pn < 24) {
            const bool act = u.pn >= 8;
            const int col0 = (u.pn & 7) * 128 + wc * 32 + 8 * fq;
#pragma unroll
            for (int ai = 0; ai < 2; ++ai)
#pragma unroll
                for (int m = 0; m < 4; ++m) { bf16_t* rowp = O + (size_t)(row0 + ai * HALF + m * 16) * D + col0;
                    f32x4 a0 = acc[ai][0][m][0], a1 = acc[ai][0][m][1], b0 = acc[ai][1][m][0], b1 = acc[ai][1][m][1];
                    if (act) {
#pragma unroll
                        for (int j = 0; j < 4; ++j) { b0[j] = silu_f(b0[j]); b1[j] = silu_f(b1[j]); } }
                    a0 = a0 * b0; a1 = a1 * b1;
                    u32x4 w; w.x = cvt_pk_bf16(a0[0], a0[1]); w.y = cvt_pk_bf16(a0[2], a0[3]); w.z = cvt_pk_bf16(a1[0], a1[1]); w.w = cvt_pk_bf16(a1[2], a1[3]);
                    *(u32x4*)rowp = w; }
        } else {
            const int col0 = (u.pn - 24) * 256 + wc * 32 + 8 * fq;
#pragma unroll
            for (int ai = 0; ai < 2; ++ai)
#pragma unroll
                for (int m = 0; m < 4; ++m) { bf16_t* rowp = O + (size_t)(row0 + ai * HALF + m * 16) * D + col0;
#pragma unroll
                    for (int bj = 0; bj < 2; ++bj) { const f32x4 v0 = acc[ai][bj][m][0], v1 = acc[ai][bj][m][1];
                        u32x4 w; w.x = cvt_pk_bf16(v0[0], v0[1]); w.y = cvt_pk_bf16(v0[2], v0[3]); w.z = cvt_pk_bf16(v1[0], v1[1]); w.w = cvt_pk_bf16(v1[2], v1[3]);
                        *(u32x4*)(rowp + bj * HALF) = w; } }
        }
    }
};
struct EpiP5 {
    static constexpr bool PERM = true;
    bf16_t *Q, *VT; const float *qn, *kn;
    __device__ __forceinline__ void operator()(const f32x4 (&acc)[2][2][4][2], const Unit& u, int wr, int wc, int fr, int fq) const {
        const int row0 = u.pm * BM + wr * 64 + fr;
        if (u.sel == 1) {
            const int col0 = u.pn * BM + wc * 32 + 8 * fq;
#pragma unroll
            for (int ai = 0; ai < 2; ++ai)
#pragma unroll
                for (int m = 0; m < 4; ++m) { bf16_t* rowp = VT + (size_t)(row0 + ai * HALF + m * 16) * M + col0;
#pragma unroll
                    for (int bj = 0; bj < 2; ++bj) { const f32x4 v0 = acc[ai][bj][m][0], v1 = acc[ai][bj][m][1];
                        u32x4 w; w.x = cvt_pk_bf16(v0[0], v0[1]); w.y = cvt_pk_bf16(v0[2], v0[3]); w.z = cvt_pk_bf16(v1[0], v1[1]); w.w = cvt_pk_bf16(v1[2], v1[3]);
                        *(u32x4*)(rowp + bj * HALF) = w; } }
        } else if (u.pn >= 8) {
            const int col0 = (u.pn - 8) * BM + wc * 32 + 8 * fq;
#pragma unroll
            for (int ai = 0; ai < 2; ++ai)
#pragma unroll
                for (int m = 0; m < 4; ++m) { bf16_t* rowp = Q + 2 * (size_t)M * D + (size_t)(row0 + ai * HALF + m * 16) * D + col0;
#pragma unroll
                    for (int bj = 0; bj < 2; ++bj) { f32x4 v0 = acc[ai][bj][m][0], v1 = acc[ai][bj][m][1];
#pragma unroll
                        for (int j = 0; j < 4; ++j) { v0[j] = silu_f(v0[j]); v1[j] = silu_f(v1[j]); }
                        u32x4 w; w.x = cvt_pk_bf16(v0[0], v0[1]); w.y = cvt_pk_bf16(v0[2], v0[3]); w.z = cvt_pk_bf16(v1[0], v1[1]); w.w = cvt_pk_bf16(v1[2], v1[3]);
                        *(u32x4*)(rowp + bj * HALF) = w; } }
        } else {
            const bool isq = u.pn < 4; bf16_t* O = Q + (size_t)(u.pn >> 2) * ((size_t)M * D); const float* nw = qn; if (!isq) nw = kn; const float sc = isq ? (LOG2E * 0.125f) : 1.0f;
            const int col0 = (u.pn & 3) * BM + 64 * wc + 8 * fq;
            f32x4 w4[2][2];
#pragma unroll
            for (int bj = 0; bj < 2; ++bj)
#pragma unroll
                for (int n = 0; n < 2; ++n) w4[bj][n] = *(const f32x4*)(nw + 32 * bj + 8 * fq + 4 * n);
#pragma unroll
            for (int ai = 0; ai < 2; ++ai)
#pragma unroll
                for (int m = 0; m < 4; ++m) {
                    float ss = 0.f;
#pragma unroll
                    for (int bj = 0; bj < 2; ++bj)
#pragma unroll
                        for (int n = 0; n < 2; ++n) { const f32x4 v = acc[ai][bj][m][n]; ss += (v[0] * v[0] + v[1] * v[1]) + (v[2] * v[2] + v[3] * v[3]); }
                    ss += __shfl_xor(ss, 16); ss += __shfl_xor(ss, 32);
                    const float rs = __builtin_amdgcn_rsqf(ss * (1.0f / 64.0f) + EPS) * sc;
                    bf16_t* rowp = O + (size_t)(row0 + ai * HALF + m * 16) * D + col0;
#pragma unroll
                    for (int bj = 0; bj < 2; ++bj) { const f32x4 v0 = acc[ai][bj][m][0] * rs * w4[bj][0], v1 = acc[ai][bj][m][1] * rs * w4[bj][1];
                        u32x4 w; w.x = cvt_pk_bf16(v0[0], v0[1]); w.y = cvt_pk_bf16(v0[2], v0[3]); w.z = cvt_pk_bf16(v1[0], v1[1]); w.w = cvt_pk_bf16(v1[2], v1[3]);
                        *(u32x4*)(rowp + 32 * bj) = w; } }
        }
    }
};
struct EpiRes {
    static constexpr bool PERM = false;
    const float* base; float* out; const float* gate;
    __device__ __forceinline__ void operator()(const f32x4 (&acc)[2][2][4][2], const Unit& u, int wr, int wc, int fr, int fq) const {
        const int row0 = u.pm * BM + wr * 64 + fr, col0 = u.pn * BM + wc * 32 + 4 * fq;
        const float* gp = gate + ((u.pm * BM) / SEQ) * 3072 + col0;
        f32x4 gv[2][2];
#pragma unroll
        for (int bj = 0; bj < 2; ++bj)
#pragma unroll
            for (int n = 0; n < 2; ++n) gv[bj][n] = *(const f32x4*)(gp + bj * HALF + n * 16);
#pragma unroll
        for (int ai = 0; ai < 2; ++ai)
#pragma unroll
            for (int m = 0; m < 4; ++m) { const size_t off = (size_t)(row0 + ai * HALF + m * 16) * D + col0;
#pragma unroll
                for (int bj = 0; bj < 2; ++bj)
#pragma unroll
                    for (int n = 0; n < 2; ++n) { const f32x4 bs = *(const f32x4*)(base + off + bj * HALF + n * 16);
                        *(f32x4*)(out + off + bj * HALF + n * 16) = bs + gv[bj][n] * acc[ai][bj][m][n]; } }
    }
};
}

struct Args {
    const float *x, *c, *ln_g, *ada_w, *ada_b, *w_in_ab, *conv_w, *sg_norm, *sg_w, *sg_b, *w_out_ab, *w_in_c, *q_norm, *k_norm, *w_out_c;
    float* out; unsigned char* ws; int ph_lo, ph_hi;
};

__device__ __forceinline__ int ab_row(int c) {
    const int seg = c >> 10, cc = c & 1023, t = cc >> 7, r = cc & 127;
    switch (seg) {
        case 1: return 256 * t + r;
        case 2: return 256 * t + 128 + r;
        case 0: return 256 * (8 + t) + r;
        case 3: return 256 * (8 + t) + 128 + r;
        case 4: return 256 * (16 + t) + r;
        case 6: return 256 * (16 + t) + 128 + r;
        default: return 256 * 24 + cc;
    }
}
__device__ __forceinline__ int c_row(int c) {
    const int seg = c >> 10, cc = c & 1023;
    if (seg == 2) return 3072 + cc;
    if (seg == 3) return 2048 + cc;
    const int tile = cc >> 8, ct = cc & 255, hh = ct >> 6, bj = (ct >> 5) & 1, i = ct & 31;
    return seg * 1024 + tile * 256 + 128 * bj + 32 * hh + i;
}
template <int MODE>
__device__ __forceinline__ void p0_transpose_item(const float* W, int K, int N, bf16_t* WT, LAS float* scr, int item, int lane) {
    const int nblk = N / 32, kb = item / nblk, nb = item % nblk, k0 = 64 * kb, n0 = 32 * nb;
    const int rb = MODE == 1 ? ab_row(n0) : (MODE == 2 ? c_row(n0) : n0);
#pragma unroll 8
    for (int i = 0; i < 32; ++i) { const int kk = 2 * i + (lane >> 5); scr[kk * 33 + (lane & 31)] = W[(size_t)(k0 + kk) * N + n0 + (lane & 31)]; }
    asm volatile("s_waitcnt lgkmcnt(0)" ::: "memory");
    const int c = lane & 7;
#pragma unroll
    for (int j = 0; j < 4; ++j) { const int n = (lane >> 3) + 8 * j; const LAS float* s = scr + (8 * c) * 33 + n;
        u32x4 o; o.x = cvt_pk_bf16(s[0 * 33], s[1 * 33]); o.y = cvt_pk_bf16(s[2 * 33], s[3 * 33]); o.z = cvt_pk_bf16(s[4 * 33], s[5 * 33]); o.w = cvt_pk_bf16(s[6 * 33], s[7 * 33]);
        *(u32x4*)(WT + (size_t)(rb + n) * K + k0 + 8 * c) = o; }
    asm volatile("s_waitcnt lgkmcnt(0)" ::: "memory");
}

__device__ __forceinline__ float wave_sum(float v) {
#pragma unroll
    for (int o = 1; o < 64; o <<= 1) v += __shfl_xor(v, o);
    return v;
}
__device__ __forceinline__ void rms_phase(const float* X, const float* g, const float* mod  , bf16_t* H, int gw, int NGW, int lane) {
    for (int b = 0; b < BATCH; ++b) {
        f32x4 mul[4], sh[4];
#pragma unroll
        for (int j = 0; j < 4; ++j) { const int col = 4 * lane + 256 * j; const f32x4 gg = *(const f32x4*)(g + col), sc = *(const f32x4*)(mod + b * 3072 + 1024 + col);
            sh[j] = *(const f32x4*)(mod + b * 3072 + col); mul[j] = gg * (sc + 1.0f); }
        for (int r = gw; r < SEQ; r += NGW) {
            const size_t m = (size_t)b * SEQ + r;
            const f32x4* xr = (const f32x4*)(X + m * D) + lane;
            f32x4 v[4]; float s = 0.f;
#pragma unroll
            for (int j = 0; j < 4; ++j) { v[j] = xr[64 * j]; s += (v[j].x * v[j].x + v[j].y * v[j].y) + (v[j].z * v[j].z + v[j].w * v[j].w); }
            const float rstd = __builtin_amdgcn_rsqf(wave_sum(s) * (1.f / D) + EPS);
            u32x2* o8 = (u32x2*)(H + m * D) + lane;
#pragma unroll
            for (int j = 0; j < 4; ++j) { const f32x4 o = v[j] * rstd * mul[j] + sh[j]; u32x2 w; w.x = cvt_pk_bf16(o.x, o.y); w.y = cvt_pk_bf16(o.z, o.w); o8[64 * j] = w; }
        }
    }
}

__device__ __forceinline__ void mixer_phase(LAS unsigned char* lds, const bf16_t* U, const bf16_t* Gt, const bf16_t* UZ, const bf16_t* V, const float* conv_w, const float* sg_norm,
                                            const float* sg_w, const float* sg_b, bf16_t* Y, int vcu, int G) {
    const int tid = threadIdx.x, lane = tid & 63, w = __builtin_amdgcn_readfirstlane(tid >> 6), fr = lane & 15, fq = lane >> 4;
    constexpr int PT = 136;
    LAS bf16_t* VNT = (LAS bf16_t*)lds;
    LAS bf16_t* WL = (LAS bf16_t*)(lds + 128 * PT * 2);
    LAS float* SG = (LAS float*)lds;
    for (int unit = vcu; unit < BATCH * 64 * 8; unit += G) {
        const int g = unit & 7, cch = (unit >> 3) & 63, b = unit >> 9; const size_t r0 = (size_t)b * SEQ + cch * 128;
        { const int c8 = tid & 15, rg = tid >> 4, ch = 128 * g + 8 * c8; const size_t row = r0 + 4 * rg;
          float cw[3][8];
#pragma unroll
          for (int k = 0; k < 3; ++k) { const f32x4 a = *(const f32x4*)(conv_w + k * D + ch), bq = *(const f32x4*)(conv_w + k * D + ch + 4);
              cw[k][0] = a.x; cw[k][1] = a.y; cw[k][2] = a.z; cw[k][3] = a.w; cw[k][4] = bq.x; cw[k][5] = bq.y; cw[k][6] = bq.z; cw[k][7] = bq.w; }
          u32x4 ur[6];
          const bool halo0 = (cch == 0 && rg == 0);
#pragma unroll
          for (int i = 0; i < 6; ++i) { if (i < 2 && halo0) ur[i] = (u32x4){0u, 0u, 0u, 0u}; else ur[i] = *(const u32x4*)(U + (row + i - 2) * D + ch); }
#pragma unroll
          for (int i = 0; i < 4; ++i) { const u32x4 gv = *(const u32x4*)(Gt + (row + i) * D + ch); float o[8];
#pragma unroll
              for (int p = 0; p < 4; ++p) { const unsigned u0 = ur[i][p], u1 = ur[i + 1][p], u2 = ur[i + 2][p];
                  o[2 * p] = bf_lo(gv[p]) * (cw[0][2 * p] * bf_lo(u0) + cw[1][2 * p] * bf_lo(u1) + cw[2][2 * p] * bf_lo(u2));
                  o[2 * p + 1] = bf_hi(gv[p]) * (cw[0][2 * p + 1] * bf_hi(u0) + cw[1][2 * p + 1] * bf_hi(u1) + cw[2][2 * p + 1] * bf_hi(u2)); }
              u32x4 wv; wv.x = cvt_pk_bf16(o[0], o[1]); wv.y = cvt_pk_bf16(o[2], o[3]); wv.z = cvt_pk_bf16(o[4], o[5]); wv.w = cvt_pk_bf16(o[6], o[7]);
              *(u32x4*)(Y + (row + i) * 2048 + ch) = wv; }
        }
        { const int s = tid >> 2, qd = tid & 3; const bf16_t* vp = V + (r0 + s) * D + 128 * g + 32 * qd;
          float v[32]; float ss = 0.f;
#pragma unroll
          for (int i = 0; i < 4; ++i) { const u32x4 t = *(const u32x4*)(vp + 8 * i);
#pragma unroll
              for (int p = 0; p < 4; ++p) { v[8 * i + 2 * p] = bf_lo(t[p]); v[8 * i + 2 * p + 1] = bf_hi(t[p]); } }
#pragma unroll
          for (int i = 0; i < 32; ++i) ss += v[i] * v[i];
          ss += __shfl_xor(ss, 1); ss += __shfl_xor(ss, 2);
          const float rs = __builtin_amdgcn_rsqf(ss * (1.0f / 128.0f) + EPS);
          const float* nw = sg_norm + g * 128 + 32 * qd;
#pragma unroll
          for (int i = 0; i < 32; i += 2) { const unsigned pk = cvt_pk_bf16(v[i] * rs * nw[i], v[i + 1] * rs * nw[i + 1]);
              VNT[(32 * qd + i) * PT + s] = (bf16_t)(pk & 0xffffu); VNT[(32 * qd + i + 1) * PT + s] = (bf16_t)(pk >> 16); }
          const int t = tid >> 2, sq = tid & 3; const float* wp = sg_w + ((size_t)g * 128 + t) * 128 + 32 * sq;
#pragma unroll
          for (int i = 0; i < 4; ++i) { f32x4 a = *(const f32x4*)(wp + 8 * i), bq = *(const f32x4*)(wp + 8 * i + 4); const int s0 = 32 * sq + 8 * i;
              float e[8] = {a.x, a.y, a.z, a.w, bq.x, bq.y, bq.z, bq.w};
#pragma unroll
              for (int p = 0; p < 8; ++p) if (s0 + p > t) e[p] = 0.f;
              u32x4 wv; wv.x = cvt_pk_bf16(e[0], e[1]); wv.y = cvt_pk_bf16(e[2], e[3]); wv.z = cvt_pk_bf16(e[4], e[5]); wv.w = cvt_pk_bf16(e[6], e[7]);
              *(LAS u32x4*)(WL + t * PT + s0) = wv; }
        }
        __syncthreads();
        f32x4 acc[8];
#pragma unroll
        for (int tt = 0; tt < 8; ++tt) acc[tt] = (f32x4){0.f, 0.f, 0.f, 0.f};
#pragma unroll
        for (int ks = 0; ks < 4; ++ks) { const bf16x8 a = *(const LAS bf16x8*)(VNT + (16 * w + fr) * PT + 32 * ks + 8 * fq);
#pragma unroll
            for (int tt = 2 * ks; tt < 8; ++tt) { const bf16x8 bw = *(const LAS bf16x8*)(WL + (16 * tt + fr) * PT + 32 * ks + 8 * fq);
                acc[tt] = __builtin_amdgcn_mfma_f32_16x16x32_bf16(a, bw, acc[tt], 0, 0, 0); } }
        __syncthreads();
#pragma unroll
        for (int tt = 0; tt < 8; ++tt) { const int t = 16 * tt + fr; const float bb = sg_b[g * 128 + t];
            *(LAS f32x4*)(SG + t * 132 + 16 * w + 4 * fq) = acc[tt] + bb; }
        __syncthreads();
        { const int rr = tid >> 2, dq = tid & 3; const bf16_t* up = UZ + (r0 + rr) * D + 128 * g + 32 * dq; bf16_t* yp = Y + (r0 + rr) * 2048 + 1024 + 128 * g + 32 * dq;
#pragma unroll
          for (int i = 0; i < 4; ++i) { const u32x4 uz = *(const u32x4*)(up + 8 * i); const f32x4 s0 = *(const LAS f32x4*)(SG + rr * 132 + 32 * dq + 8 * i), s1 = *(const LAS f32x4*)(SG + rr * 132 + 32 * dq + 8 * i + 4);
              u32x4 wv; wv.x = cvt_pk_bf16(bf_lo(uz.x) * s0.x, bf_hi(uz.x) * s0.y); wv.y = cvt_pk_bf16(bf_lo(uz.y) * s0.z, bf_hi(uz.y) * s0.w);
              wv.z = cvt_pk_bf16(bf_lo(uz.z) * s1.x, bf_hi(uz.z) * s1.y); wv.w = cvt_pk_bf16(bf_lo(uz.w) * s1.z, bf_hi(uz.w) * s1.w);
              *(u32x4*)(yp + 8 * i) = wv; }
        }
        __syncthreads();
    }
}

__device__ __forceinline__ int crow(int i, int hi) { return (i & 3) + 8 * (i >> 2) + 4 * hi; }
__device__ __forceinline__ void attn_phase(const bf16_t* Q, const bf16_t* Kb, const bf16_t* VT, const bf16_t* Zs, bf16_t* OZ, int gw, int NGW, int lane) {
    const int ql = lane & 31, hi = lane >> 5;
    constexpr float STOP = -150.0f;
    for (int wu = gw; wu < BATCH * 16 * (SEQ / 32); wu += NGW) {
        const int qb = wu & 255, h = (wu >> 8) & 15, b = wu >> 12;
        const size_t rowbase = (size_t)b * SEQ; const int q0 = 32 * qb;
        bf16x8 qf[4];
        { const bf16_t* qp = Q + (rowbase + q0 + ql) * D + h * 64 + 8 * hi;
#pragma unroll
          for (int kk = 0; kk < 4; ++kk) qf[kk] = *(const bf16x8*)(qp + 16 * kk); }
        f32x16 o0, o1;
#pragma unroll
        for (int i = 0; i < 16; ++i) { o0[i] = 0.f; o1[i] = 0.f; }
        float carry = 0.f;
        bf16x8 kf[4];
        { const bf16_t* kp = Kb + (rowbase + q0 + ql) * D + h * 64 + 8 * hi;
#pragma unroll
          for (int kk = 0; kk < 4; ++kk) kf[kk] = *(const bf16x8*)(kp + 16 * kk); }
        for (int kt = qb; kt >= 0; --kt) {
            const int key0 = 32 * kt;
            u32x2 vf[2][2][2];
            { const bf16_t* vp = VT + (size_t)(h * 64 + ql) * M + rowbase + key0 + 4 * hi;
#pragma unroll
              for (int dh = 0; dh < 2; ++dh)
#pragma unroll
                  for (int s = 0; s < 2; ++s) { vf[dh][s][0] = *(const u32x2*)(vp + (size_t)dh * 32 * M + 16 * s); vf[dh][s][1] = *(const u32x2*)(vp + (size_t)dh * 32 * M + 16 * s + 8); } }
            bf16x8 kn[4];
            { const int kt2 = kt > 0 ? kt - 1 : 0; const bf16_t* kp = Kb + (rowbase + 32 * kt2 + ql) * D + h * 64 + 8 * hi;
#pragma unroll
              for (int kk = 0; kk < 4; ++kk) kn[kk] = *(const bf16x8*)(kp + 16 * kk); }
            f32x16 S;
#pragma unroll
            for (int i = 0; i < 16; ++i) S[i] = 0.f;
#pragma unroll
            for (int kk = 0; kk < 4; ++kk) S = __builtin_amdgcn_mfma_f32_32x32x16_bf16(kf[kk], qf[kk], S, 0, 0, 0);
            float lb[16], l1[16];
            const bool diag = (kt == qb);
#pragma unroll
            for (int i = 0; i < 16; ++i) { const float z = S[i]; const float e = fast_exp2(-fabsf(z)); const float L0 = fast_log2(1.0f + e);
                float lbv = fminf(z, 0.f) - L0; float l1v = lbv - z;
                if (diag) { const bool valid = crow(i, hi) < ql; l1v = valid ? l1v : 0.f; lbv = valid ? lbv : -1e30f; }
                lb[i] = lbv; l1[i] = l1v; }
            float gs[4], pg[4];
#pragma unroll
            for (int gi = 0; gi < 4; ++gi) { gs[gi] = (l1[4 * gi] + l1[4 * gi + 1]) + (l1[4 * gi + 2] + l1[4 * gi + 3]); pg[gi] = __shfl_xor(gs[gi], 32); }
            float run = carry; float wv[16];
#pragma unroll
            for (int gi = 3; gi >= 0; --gi) { const float base = run + (hi == 0 ? pg[gi] : 0.f);
                const float s3 = base, s2 = s3 + l1[4 * gi + 3], s1 = s2 + l1[4 * gi + 2], s0 = s1 + l1[4 * gi + 1];
                wv[4 * gi + 3] = fast_exp2(lb[4 * gi + 3] + s3); wv[4 * gi + 2] = fast_exp2(lb[4 * gi + 2] + s2);
                wv[4 * gi + 1] = fast_exp2(lb[4 * gi + 1] + s1); wv[4 * gi] = fast_exp2(lb[4 * gi] + s0);
                run += gs[gi] + pg[gi]; }
            carry = run;
#pragma unroll
            for (int s = 0; s < 2; ++s) { u32x4 pk; pk.x = cvt_pk_bf16(wv[8 * s], wv[8 * s + 1]); pk.y = cvt_pk_bf16(wv[8 * s + 2], wv[8 * s + 3]); pk.z = cvt_pk_bf16(wv[8 * s + 4], wv[8 * s + 5]); pk.w = cvt_pk_bf16(wv[8 * s + 6], wv[8 * s + 7]);
                const bf16x8 pf = __builtin_bit_cast(bf16x8, pk);
                { u32x4 a; a.x = vf[0][s][0].x; a.y = vf[0][s][0].y; a.z = vf[0][s][1].x; a.w = vf[0][s][1].y; o0 = __builtin_amdgcn_mfma_f32_32x32x16_bf16(__builtin_bit_cast(bf16x8, a), pf, o0, 0, 0, 0); }
                { u32x4 a; a.x = vf[1][s][0].x; a.y = vf[1][s][0].y; a.z = vf[1][s][1].x; a.w = vf[1][s][1].y; o1 = __builtin_amdgcn_mfma_f32_32x32x16_bf16(__builtin_bit_cast(bf16x8, a), pf, o1, 0, 0, 0); } }
#pragma unroll
            for (int kk = 0; kk < 4; ++kk) kf[kk] = kn[kk];
            if (__all(carry < STOP)) break;
        }
        const bf16_t* zp = Zs + (rowbase + q0 + ql) * D + h * 64 + 4 * hi; bf16_t* op = OZ + (rowbase + q0 + ql) * D + h * 64 + 4 * hi;
#pragma unroll
        for (int g4 = 0; g4 < 4; ++g4) {
            { const u32x2 zz = *(const u32x2*)(zp + 8 * g4); u32x2 w; w.x = cvt_pk_bf16(o0[4 * g4] * bf_lo(zz.x), o0[4 * g4 + 1] * bf_hi(zz.x)); w.y = cvt_pk_bf16(o0[4 * g4 + 2] * bf_lo(zz.y), o0[4 * g4 + 3] * bf_hi(zz.y)); *(u32x2*)(op + 8 * g4) = w; }
            { const u32x2 zz = *(const u32x2*)(zp + 32 + 8 * g4); u32x2 w; w.x = cvt_pk_bf16(o1[4 * g4] * bf_lo(zz.x), o1[4 * g4 + 1] * bf_hi(zz.x)); w.y = cvt_pk_bf16(o1[4 * g4 + 2] * bf_lo(zz.y), o1[4 * g4 + 3] * bf_hi(zz.y)); *(u32x2*)(op + 32 + 8 * g4) = w; }
        }
    }
}

constexpr int N_PHASES = 9;
__global__ void __launch_bounds__(NTHR, 2) hybrid_fwd(Args a) {
    extern __shared__ __attribute__((aligned(16))) unsigned char lds_raw[];
    LAS unsigned char* lds = (LAS unsigned char*)lds_raw;
    const int tid = threadIdx.x, lane = tid & 63, wave = __builtin_amdgcn_readfirstlane(tid >> 6);
    const int G = gridDim.x, bx = blockIdx.x;
    const int vcu = (G % 8 == 0) ? (bx % 8) * (G / 8) + bx / 8 : bx;
    const int gw = vcu * NWAVES + wave, NGW = G * NWAVES;
    unsigned char* ws = a.ws;
    float* MOD = (float*)(ws + WS_MOD);
    bf16_t* WAB = (bf16_t*)(ws + WS_WAB); bf16_t* WOAB = (bf16_t*)(ws + WS_WOAB); bf16_t* WC = (bf16_t*)(ws + WS_WC); bf16_t* WOC = (bf16_t*)(ws + WS_WOC);
    bf16_t* H0 = (bf16_t*)(ws + WS_H0); bf16_t* Y = (bf16_t*)(ws + WS_Y);
    bf16_t* Ub = (bf16_t*)(ws + WS_U); bf16_t* Gb = (bf16_t*)(ws + WS_G); bf16_t* UZb = (bf16_t*)(ws + WS_UZ); bf16_t* Vb = (bf16_t*)(ws + WS_V);
    float* X1 = (float*)(ws + WS_X1); bf16_t* H1 = (bf16_t*)(ws + WS_H1);
    bf16_t* Qb = (bf16_t*)(ws + WS_Q); bf16_t* Kb = (bf16_t*)(ws + WS_K); bf16_t* Zb = (bf16_t*)(ws + WS_Z); bf16_t* VTb = (bf16_t*)(ws + WS_VT); bf16_t* OZb = (bf16_t*)(ws + WS_OZ);
    const int lo = a.ph_lo, hi = a.ph_hi;
#define IN(k) (lo <= (k) && (k) < hi)
#define SEAM(k) do { if (IN(k) && IN((k) + 1)) { asm volatile("s_waitcnt vmcnt(0)" ::: "memory"); __syncthreads(); cg::this_grid().sync(); \
        __builtin_amdgcn_fence(__ATOMIC_ACQUIRE, "agent"); asm volatile("s_waitcnt vmcnt(0)" ::: "memory"); __syncthreads(); } } while (0)

    if (IN(0)) {
        for (int task = bx; task < 192; task += G) {
            LAS float* sc_l = (LAS float*)lds; LAS float* red = sc_l + 2048;
            for (int i = tid; i < BATCH * D; i += NTHR) { const float v = a.c[i]; sc_l[i] = v / (1.0f + __expf(-v)); }
            __syncthreads();
            const int l = task / 96, n0 = (task % 96) * 32, kc = wave * 2 + (lane >> 5), n = n0 + (lane & 31);
            const float* W = a.ada_w + (size_t)l * D * 3072 + (size_t)(kc * 64) * 3072 + n;
            float a0 = 0.f, a1 = 0.f;
#pragma unroll 16
            for (int k = 0; k < 64; ++k) { const float wv = W[(size_t)k * 3072]; a0 += sc_l[kc * 64 + k] * wv; a1 += sc_l[D + kc * 64 + k] * wv; }
            red[(kc * 2 + 0) * 32 + (lane & 31)] = a0; red[(kc * 2 + 1) * 32 + (lane & 31)] = a1;
            __syncthreads();
            if (tid < 64) { const int b = tid >> 5, nn = tid & 31; float s = 0.f;
#pragma unroll
                for (int k = 0; k < 16; ++k) s += red[(k * 2 + b) * 32 + nn];
                MOD[(l * 2 + b) * 3072 + n0 + nn] = s + a.ada_b[l * 3072 + n0 + nn]; }
            __syncthreads();
        }
        LAS float* scr = (LAS float*)(lds + wave * 16384);
        constexpr int I_AB = (D / 64) * (IN_AB / 32), I_OAB = (2048 / 64) * (D / 32), I_C = (D / 64) * (IN_C / 32), I_OC = (D / 64) * (D / 32);
        for (int it = gw; it < I_AB + I_OAB + I_C + I_OC; it += NGW) {
            int r = it;
            if (r < I_AB) { p0_transpose_item<1>(a.w_in_ab, D, IN_AB, WAB, scr, r, lane); continue; } r -= I_AB;
            if (r < I_OAB) { p0_transpose_item<0>(a.w_out_ab, 2048, D, WOAB, scr, r, lane); continue; } r -= I_OAB;
            if (r < I_C) { p0_transpose_item<2>(a.w_in_c, D, IN_C, WC, scr, r, lane); continue; } r -= I_C;
            p0_transpose_item<0>(a.w_out_c, D, D, WOC, scr, r, lane);
        }
    }
    SEAM(0);
    if (IN(1)) rms_phase(a.x, a.ln_g, MOD, H0, gw, NGW, lane);
    SEAM(1);
    if (IN(2)) { pg8::Sched2 S; S.init(H0, WAB, M, IN_AB, nullptr, nullptr, 0, 0, D, G, bx);
        pg8::EpiP1 E{Ub}; pg8::gemm_phase<pg8::EpiP1, true, true>(lds, S, E); }
    SEAM(2);
    if (IN(3)) mixer_phase(lds, Ub, Gb, UZb, Vb, a.conv_w, a.sg_norm, a.sg_w, a.sg_b, Y, vcu, G);
    SEAM(3);
    if (IN(4)) { pg8::Sched2 S; S.init(Y, WOAB, M, D, nullptr, nullptr, 0, 0, 2048, G, bx);
        pg8::EpiRes E{a.x, X1, MOD + 2048}; pg8::gemm_phase<pg8::EpiRes, true, true>(lds, S, E); }
    SEAM(4);
    if (IN(5)) rms_phase(X1, a.ln_g + D, MOD + 2 * 3072, H1, gw, NGW, lane);
    SEAM(5);
    if (IN(6)) { pg8::Sched2 S; S.init(H1, WC, M, 3072, WC + (size_t)3072 * D, H1, D, M, D, G, bx);
        pg8::EpiP5 E{Qb, VTb, a.q_norm, a.k_norm}; pg8::gemm_phase<pg8::EpiP5, true, true>(lds, S, E); }
    SEAM(6);
    if (IN(7)) attn_phase(Qb, Kb, VTb, Zb, OZb, gw, NGW, lane);
    SEAM(7);
    if (IN(8)) { pg8::Sched2 S; S.init(OZb, WOC, M, D, nullptr, nullptr, 0, 0, D, G, bx);
        pg8::EpiRes E{X1, a.out, MOD + 2 * 3072 + 2048}; pg8::gemm_phase<pg8::EpiRes, true, true>(lds, S, E); }
#undef IN
#undef SEAM
}

extern "C" void kernel_launch(void* const* d_in, const int* in_sizes, int n_in, void* d_out, int out_size, void* d_ws, size_t ws_size, hipStream_t stream) {
    static int grid = 0;
    if (grid == 0) {
        if (n_in != 15 || in_sizes[0] != M * D || out_size != M * D || ws_size < WS_END) { fprintf(stderr, "kernel_launch: unexpected problem geometry (n_in %d, ws %zu)\n", n_in, ws_size); grid = -1; return; }
        int dev = 0, cus = 0, per_cu = 0;
        (void)hipGetDevice(&dev); (void)hipDeviceGetAttribute(&cus, hipDeviceAttributeMultiprocessorCount, dev);
        if (hipFuncSetAttribute((const void*)hybrid_fwd, hipFuncAttributeMaxDynamicSharedMemorySize, LDS_BYTES) != hipSuccess) { fprintf(stderr, "kernel_launch: hipFuncSetAttribute failed\n"); grid = -1; return; }
        if (hipOccupancyMaxActiveBlocksPerMultiprocessor(&per_cu, (const void*)hybrid_fwd, NTHR, LDS_BYTES) != hipSuccess || per_cu < 1) { fprintf(stderr, "kernel_launch: occupancy query says %d\n", per_cu); per_cu = 1; }
        (void)hipGetLastError();
        grid = cus * per_cu;
    }
    if (grid < 0) return;
    Args a{};
    a.x = (const float*)d_in[0]; a.c = (const float*)d_in[1]; a.ln_g = (const float*)d_in[2]; a.ada_w = (const float*)d_in[3]; a.ada_b = (const float*)d_in[4];
    a.w_in_ab = (const float*)d_in[5]; a.conv_w = (const float*)d_in[6]; a.sg_norm = (const float*)d_in[7]; a.sg_w = (const float*)d_in[8]; a.sg_b = (const float*)d_in[9];
    a.w_out_ab = (const float*)d_in[10]; a.w_in_c = (const float*)d_in[11]; a.q_norm = (const float*)d_in[12]; a.k_norm = (const float*)d_in[13]; a.w_out_c = (const float*)d_in[14];
    a.out = (float*)d_out; a.ws = (unsigned char*)d_ws;
#if MK_MULTI
    for (int p = 0; p < N_PHASES; ++p) { a.ph_lo = p; a.ph_hi = p + 1; hipLaunchKernelGGL(hybrid_fwd, dim3(grid), dim3(NTHR), LDS_BYTES, stream, a); }
#else
    a.ph_lo = 0; a.ph_hi = N_PHASES;
    void* args[] = {&a};
    hipError_t e = hipLaunchCooperativeKernel((const void*)hybrid_fwd, dim3(grid), dim3(NTHR), args, LDS_BYTES, stream);
    if (e != hipSuccess) fprintf(stderr, "kernel_launch: cooperative launch failed: %s (grid %d)\n", hipGetErrorString(e), grid);
#endif
}
```

```cpp
#include <hip/hip_runtime.h>
#include <hip/hip_cooperative_groups.h>
#include <cstdio>
#include <cstdint>
namespace cg = cooperative_groups;

#ifndef MK_MULTI
#define MK_MULTI 0
#endif

#define LAS __attribute__((address_space(3)))
typedef unsigned short bf16_t;
typedef short bf16x8 __attribute__((ext_vector_type(8)));
typedef float f32x4 __attribute__((ext_vector_type(4)));
typedef float f32x16 __attribute__((ext_vector_type(16)));
typedef unsigned u32x4 __attribute__((ext_vector_type(4)));
typedef unsigned u32x2 __attribute__((ext_vector_type(2)));

constexpr int BATCH = 2, SEQ = 8192, D = 1024, M = BATCH * SEQ;
constexpr int IN_AB = 7168, IN_C = 4096;
constexpr float EPS = 1e-6f;
constexpr int NWAVES = 8, NTHR = 512;
constexpr float LOG2E = 1.4426950408889634f;

constexpr size_t MiB = 1u << 20;
constexpr size_t WS_CTL = 0, CTL_ZERO_BYTES = 64 * 1024;
constexpr size_t WS_MOD = 1 * MiB;
constexpr size_t WS_WAB = 2 * MiB;
constexpr size_t WS_WOAB = 16 * MiB;
constexpr size_t WS_WC = 20 * MiB;
constexpr size_t WS_WOC = 28 * MiB;
constexpr size_t WS_U = 32 * MiB, WS_G = 64 * MiB, WS_UZ = 96 * MiB, WS_V = 128 * MiB;
constexpr size_t WS_H0 = 160 * MiB;
constexpr size_t WS_Y = 160 * MiB;
constexpr size_t WS_X1 = 32 * MiB;
constexpr size_t WS_H1 = 96 * MiB;
constexpr size_t WS_Q = 128 * MiB, WS_K = 160 * MiB, WS_Z = 192 * MiB, WS_VT = 224 * MiB;
constexpr size_t WS_OZ = 96 * MiB;
constexpr size_t WS_END = 256 * MiB;
static_assert(WS_G - WS_U == (size_t)M * D * 2 && WS_UZ - WS_G == (size_t)M * D * 2 && WS_V - WS_UZ == (size_t)M * D * 2 && WS_K - WS_Q == (size_t)M * D * 2 && WS_Z - WS_K == (size_t)M * D * 2, "contiguous activations");

constexpr int LDS_BYTES = 147456;

typedef float f32x2_t __attribute__((ext_vector_type(2))); typedef __bf16 bf16x2_t __attribute__((ext_vector_type(2)));
__device__ __forceinline__ unsigned cvt_pk_bf16(float lo, float hi) { f32x2_t v = {lo, hi}; bf16x2_t b = __builtin_convertvector(v, bf16x2_t); return __builtin_bit_cast(unsigned, b); }
__device__ __forceinline__ float bf_lo(unsigned u) { return __uint_as_float(u << 16); }
__device__ __forceinline__ float bf_hi(unsigned u) { return __uint_as_float(u & 0xffff0000u); }
__device__ __forceinline__ float fast_exp2(float x) { return __builtin_amdgcn_exp2f(x); }
__device__ __forceinline__ float fast_log2(float x) { return __builtin_amdgcn_logf(x); }
__device__ __forceinline__ float fast_rcp(float x) { return __builtin_amdgcn_rcpf(x); }
__device__ __forceinline__ float silu_f(float v) { return v * fast_rcp(1.0f + fast_exp2(-LOG2E * v)); }

namespace pg8 {
constexpr int BM = 256, BK = 64, HALF = 128, HTB = HALF * BK * 2, STAGE_BYTES = 8 * HTB, NXCD = 8, WGM = 8;
__host__ __device__ __forceinline__ int lds_byte(int r, int c) { const int st = (r >> 4) * 2 + (c >> 5), rr = r & 15, cc = c & 31, ob = rr * 64 + cc * 2; return st * 1024 + (ob ^ (((ob >> 9) & 1) << 5)); }
__host__ __device__ __forceinline__ void stage_rc(int b, int& R, int& C) { const int st = b / 1024, sb = b % 1024, swz = sb ^ (((sb >> 9) & 1) << 5); R = (st >> 1) * 16 + swz / 64; C = (st & 1) * 32 + (swz % 64) / 2; }
__host__ __device__ __forceinline__ int perm32(int rho) { const int n = rho >> 4, i = rho & 15; return 8 * (i >> 2) + 4 * n + (i & 3); }

struct Unit { int pm, pn, sel; };
struct Sched2 {
    const bf16_t *A0, *B0, *A1, *B1; int nM0, nN0, nwg0, nM1, nN1, nwg1, G, c, K;
    __device__ void init(const bf16_t* a0, const bf16_t* b0, int m0, int n0, const bf16_t* a1, const bf16_t* b1, int m1, int n1, int K_, int G_, int c_) {
        A0 = a0; B0 = b0; nM0 = m0 / BM; nN0 = n0 / BM; nwg0 = nM0 * nN0; A1 = a1; B1 = b1; nM1 = m1 / BM; nN1 = n1 / BM; nwg1 = nM1 * nN1; K = K_; G = G_; c = c_; }
    __device__ static void map(int wgid, int nM, int nN, int& pm, int& pn) {
        const int nwg = nM * nN; { const int q = nwg / NXCD, r = nwg % NXCD, xcd = wgid % NXCD, off = wgid / NXCD; wgid = (xcd < r ? xcd * (q + 1) : r * (q + 1) + (xcd - r) * q) + off; }
        const int nig = WGM * nN, gid = wgid / nig, fm = gid * WGM, gsz = (nM - fm) < WGM ? (nM - fm) : WGM;
        pm = fm + ((wgid % nig) % gsz); pn = (wgid % nig) / gsz; }
    __device__ bool next(int i, Unit& u) const {
        const int L = i * G + c;
        if (L < nwg0) { map(L, nM0, nN0, u.pm, u.pn); u.sel = 0; return true; }
        if (L < nwg0 + nwg1) { map(L - nwg0, nM1, nN1, u.pm, u.pn); u.sel = 1; return true; }
        return false; }
    __device__ __forceinline__ const char* baseA(const Unit& u) const { return (const char*)(u.sel ? A1 : A0) + (size_t)u.pm * BM * K * 2; }
    __device__ __forceinline__ const char* baseB(const Unit& u) const { return (const char*)(u.sel ? B1 : B0) + (size_t)u.pn * BM * K * 2; }
};

template <class Epi, bool ALIGN_EPI, bool SP2>
__device__ __forceinline__ void gemm_phase(LAS unsigned char* lds, const Sched2& S, const Epi& E) {
    const int tid = threadIdx.x, wid = __builtin_amdgcn_readfirstlane(tid >> 6), lane = tid & 63, wr = wid >> 2, wc = wid & 3, fr = lane & 15, fq = lane >> 4;
    const int K = S.K, nt = K / BK;
    unsigned voffA[2], voffB[2];
#pragma unroll
    for (int i = 0; i < 2; ++i) { int R, C; stage_rc(tid * 16 + i * 8192, R, C); const int Rb = Epi::PERM ? ((R & ~31) + perm32(R & 31)) : R;
        voffA[i] = (unsigned)(R * K + C) * 2u; voffB[i] = (unsigned)(Rb * K + C) * 2u; }
    const size_t kstep = (size_t)(BK * 2);
    const size_t hstep = (size_t)HALF * K * 2;
    const unsigned ldsw = (unsigned)wid * 1024u;
    const int aoff = lds_byte(wr * 64 + fr, fq * 8), boff = lds_byte(wc * 32 + fr, fq * 8);
#define PG8_SA(b, h) (((b) * 2 + (h)) * HTB)
#define PG8_SB(b, h) ((4 + (b) * 2 + (h)) * HTB)
#define PG8_STAGE(bufoff, gbase, voff) do { _Pragma("unroll") for (int _i = 0; _i < 2; ++_i) \
        __builtin_amdgcn_global_load_lds((const unsigned*)((const char*)(gbase) + (voff)[_i]), (LAS unsigned*)(lds + (bufoff) + ldsw + _i * 8192), 16, 0, 0); } while (0)
#define PG8_LDA(dst, b, h) do { _Pragma("unroll") for (int m = 0; m < 4; ++m) _Pragma("unroll") for (int k = 0; k < 2; ++k) dst[m][k] = *(const LAS bf16x8*)(lds + PG8_SA(b, h) + aoff + m * 2048 + k * 1024); } while (0)
#define PG8_LDB(dst, b, h) do { _Pragma("unroll") for (int n = 0; n < 2; ++n) _Pragma("unroll") for (int k = 0; k < 2; ++k) dst[n][k] = *(const LAS bf16x8*)(lds + PG8_SB(b, h) + boff + n * 2048 + k * 1024); } while (0)
#define PG8_MMA(ai, bj, At, Bt) do { __builtin_amdgcn_s_setprio(1); _Pragma("unroll") for (int m = 0; m < 4; ++m) _Pragma("unroll") for (int n = 0; n < 2; ++n) _Pragma("unroll") for (int k = 0; k < 2; ++k) \
        acc[ai][bj][m][n] = __builtin_amdgcn_mfma_f32_16x16x32_bf16(Bt[n][k], At[m][k], acc[ai][bj][m][n], 0, 0, 0); __builtin_amdgcn_s_setprio(0); } while (0)
#define PG8_WAIT_V(n) asm volatile("s_waitcnt vmcnt(" #n ")" ::: "memory")
#define PG8_WAIT_L(n) asm volatile("s_waitcnt lgkmcnt(" #n ")" ::: "memory")
#define PG8_BAR __builtin_amdgcn_s_barrier()
#define PG8_SCHED __builtin_amdgcn_sched_barrier(0)
    Unit cur, nxt; int ui = 0;
    if (!S.next(0, cur)) return;
    f32x4 acc[2][2][4][2];
#pragma unroll
    for (int a = 0; a < 2; ++a)
#pragma unroll
        for (int b = 0; b < 2; ++b)
#pragma unroll
            for (int m = 0; m < 4; ++m)
#pragma unroll
                for (int n = 0; n < 2; ++n) acc[a][b][m][n] = (f32x4){0.f, 0.f, 0.f, 0.f};
    bf16x8 At[4][2], B0[2][2], B1[2][2];
    const char* cA = S.baseA(cur); const char* cB = S.baseB(cur);
    if constexpr (SP2) {
        PG8_STAGE(PG8_SB(0, 0), cB, voffB); PG8_STAGE(PG8_SB(0, 1), cB + hstep, voffB); PG8_STAGE(PG8_SA(0, 0), cA, voffA); PG8_STAGE(PG8_SA(0, 1), cA + hstep, voffA);
        if (wr == 1) PG8_BAR;
        PG8_WAIT_V(2); PG8_BAR;
        PG8_STAGE(PG8_SB(1, 0), cB + kstep, voffB); PG8_STAGE(PG8_SA(1, 0), cA + kstep, voffA); PG8_STAGE(PG8_SB(1, 1), cB + hstep + kstep, voffB);
        PG8_WAIT_V(6); PG8_BAR;
    } else {
        PG8_STAGE(PG8_SB(0, 0), cB, voffB); PG8_STAGE(PG8_SA(0, 0), cA, voffA); PG8_STAGE(PG8_SB(0, 1), cB + hstep, voffB); PG8_STAGE(PG8_SA(0, 1), cA + hstep, voffA);
        if (wr == 1) PG8_BAR;
        PG8_WAIT_V(4); PG8_BAR;
        PG8_STAGE(PG8_SB(1, 0), cB + kstep, voffB); PG8_STAGE(PG8_SA(1, 0), cA + kstep, voffA); PG8_STAGE(PG8_SB(1, 1), cB + hstep + kstep, voffB);
        PG8_WAIT_V(6); PG8_BAR;
    }
    for (;;) {
        const bool has_next = S.next(ui + 1, nxt);
        const char* nA = has_next ? S.baseA(nxt) : cA; const char* nB = has_next ? S.baseB(nxt) : cB;
        for (int t = 0; t < nt; t += 2) {
            const bool last = (t == nt - 2);
            const char* a1 = cA + (size_t)(t + 1) * kstep;
            const char* a2 = last ? nA : cA + (size_t)(t + 2) * kstep; const char* b2 = last ? nB : cB + (size_t)(t + 2) * kstep;
            const char* a3 = a2 + kstep; const char* b3 = b2 + kstep;
            if constexpr (SP2) {
            PG8_LDB(B0, 0, 0); PG8_LDB(B1, 0, 1); PG8_SCHED; PG8_LDA(At, 0, 0); PG8_STAGE(PG8_SA(1, 1), a1 + hstep, voffA);
            PG8_WAIT_V(8); PG8_WAIT_L(0); PG8_BAR; PG8_MMA(0, 0, At, B0); PG8_MMA(0, 1, At, B1); PG8_BAR; PG8_SCHED;
            PG8_LDA(At, 0, 1); PG8_STAGE(PG8_SB(0, 0), b2, voffB); PG8_STAGE(PG8_SB(0, 1), b2 + hstep, voffB); PG8_STAGE(PG8_SA(0, 0), a2, voffA);
            PG8_WAIT_V(8); PG8_WAIT_L(0); PG8_BAR; PG8_MMA(1, 0, At, B0); PG8_MMA(1, 1, At, B1); PG8_BAR; PG8_SCHED;
            PG8_LDB(B0, 1, 0); PG8_LDB(B1, 1, 1); PG8_SCHED; PG8_LDA(At, 1, 0); PG8_STAGE(PG8_SA(0, 1), a2 + hstep, voffA);
            PG8_WAIT_V(8); PG8_WAIT_L(0); PG8_BAR; PG8_MMA(0, 0, At, B0); PG8_MMA(0, 1, At, B1); PG8_BAR; PG8_SCHED;
            PG8_LDA(At, 1, 1); PG8_STAGE(PG8_SB(1, 0), b3, voffB); PG8_STAGE(PG8_SB(1, 1), b3 + hstep, voffB); PG8_STAGE(PG8_SA(1, 0), a3, voffA);
            PG8_WAIT_V(8); PG8_WAIT_L(0); PG8_BAR; PG8_MMA(1, 0, At, B0); PG8_MMA(1, 1, At, B1); PG8_BAR; PG8_SCHED;
            } else {
            PG8_LDB(B0, 0, 0); PG8_SCHED; PG8_LDA(At, 0, 0); PG8_STAGE(PG8_SA(1, 1), a1 + hstep, voffA);
            PG8_WAIT_L(8); PG8_BAR; PG8_WAIT_L(0); PG8_MMA(0, 0, At, B0); PG8_BAR; PG8_SCHED;
            PG8_LDB(B1, 0, 1); PG8_STAGE(PG8_SB(0, 0), b2, voffB);
            PG8_BAR; PG8_WAIT_L(0); PG8_MMA(0, 1, At, B1); PG8_BAR;
            PG8_LDA(At, 0, 1); PG8_STAGE(PG8_SA(0, 0), a2, voffA);
            PG8_BAR; PG8_WAIT_L(0); PG8_MMA(1, 0, At, B0); PG8_BAR; PG8_SCHED;
            PG8_STAGE(PG8_SB(0, 1), b2 + hstep, voffB);
            PG8_WAIT_V(6); PG8_BAR; PG8_MMA(1, 1, At, B1); PG8_BAR;
            PG8_LDB(B0, 1, 0); PG8_SCHED; PG8_LDA(At, 1, 0); PG8_STAGE(PG8_SA(0, 1), a2 + hstep, voffA);
            PG8_WAIT_L(8); PG8_BAR; PG8_WAIT_L(0); PG8_MMA(0, 0, At, B0); PG8_BAR; PG8_SCHED;
            PG8_LDB(B1, 1, 1); PG8_STAGE(PG8_SB(1, 0), b3, voffB);
            PG8_BAR; PG8_WAIT_L(0); PG8_MMA(0, 1, At, B1); PG8_BAR;
            PG8_LDA(At, 1, 1); PG8_STAGE(PG8_SA(1, 0), a3, voffA);
            PG8_BAR; PG8_WAIT_L(0); PG8_MMA(1, 0, At, B0); PG8_BAR; PG8_SCHED;
            PG8_STAGE(PG8_SB(1, 1), b3 + hstep, voffB);
            PG8_WAIT_V(6); PG8_BAR; PG8_MMA(1, 1, At, B1); PG8_BAR;
            }
        }
        if constexpr (ALIGN_EPI) { if (wr == 0) PG8_BAR; }
        E(acc, cur, wr, wc, fr, fq);
        if (!has_next) break;
#pragma unroll
        for (int a = 0; a < 2; ++a)
#pragma unroll
            for (int b = 0; b < 2; ++b)
#pragma unroll
                for (int m = 0; m < 4; ++m)
#pragma unroll
                    for (int n = 0; n < 2; ++n) acc[a][b][m][n] = (f32x4){0.f, 0.f, 0.f, 0.f};
        cur = nxt; cA = nA; cB = nB; ++ui;
        if constexpr (ALIGN_EPI) { if (wr == 1) PG8_BAR; }
    }
    PG8_WAIT_V(0);
    if constexpr (!ALIGN_EPI) { if (wr == 0) PG8_BAR; }
    PG8_BAR;
#undef PG8_SA
#undef PG8_SB
#undef PG8_STAGE
#undef PG8_LDA
#undef PG8_LDB
#undef PG8_MMA
#undef PG8_WAIT_V
#undef PG8_WAIT_L
#undef PG8_BAR
#undef PG8_SCHED
}

struct EpiP1 {
    static constexpr bool PERM = true;
    bf16_t* U;
    __device__ __forceinline__ void operator()(const f32x4 (&acc)[2][2][4][2], const Unit& u, int wr, int wc, int fr, int fq) const {
        const int row0 = u.pm * BM + wr * 64 + fr;
        bf16_t* O = U + (size_t)(u.pn >> 3) * ((size_t)M * D);
        if (u.pn < 24) {
            const bool act = u.pn >= 8;
            const int col0 = (u.pn & 7) * 128 + wc * 32 + 8 * fq;
#pragma unroll
            for (int ai = 0; ai < 2; ++ai)
#pragma unroll
                for (int m = 0; m < 4; ++m) { bf16_t* rowp = O + (size_t)(row0 + ai * HALF + m * 16) * D + col0;
                    f32x4 a0 = acc[ai][0][m][0], a1 = acc[ai][0][m][1], b0 = acc[ai][1][m][0], b1 = acc[ai][1][m][1];
                    if (act) {
#pragma unroll
                        for (int j = 0; j < 4; ++j) { b0[j] = silu_f(b0[j]); b1[j] = silu_f(b1[j]); } }
                    a0 = a0 * b0; a1 = a1 * b1;
                    u32x4 w; w.x = cvt_pk_bf16(a0[0], a0[1]); w.y = cvt_pk_bf16(a0[2], a0[3]); w.z = cvt_pk_bf16(a1[0], a1[1]); w.w = cvt_pk_bf16(a1[2], a1[3]);
                    *(u32x4*)rowp = w; }
        } else {
            const int col0 = (u.pn - 24) * 256 + wc * 32 + 8 * fq;
#pragma unroll
            for (int ai = 0; ai < 2; ++ai)
#pragma unroll
                for (int m = 0; m < 4; ++m) { bf16_t* rowp = O + (size_t)(row0 + ai * HALF + m * 16) * D + col0;
#pragma unroll
                    for (int bj = 0; bj < 2; ++bj) { const f32x4 v0 = acc[ai][bj][m][0], v1 = acc[ai][bj][m][1];
                        u32x4 w; w.x = cvt_pk_bf16(v0[0], v0[1]); w.y = cvt_pk_bf16(v0[2], v0[3]); w.z = cvt_pk_bf16(v1[0], v1[1]); w.w = cvt_pk_bf16(v1[2], v1[3]);
                        *(u32x4*)(rowp + bj * HALF) = w; } }
        }
    }
};
struct EpiP5 {
    static constexpr bool PERM = true;
    bf16_t *Q, *VT; const float *qn, *kn;
    __device__ __forceinline__ void operator()(const f32x4 (&acc)[2][2][4][2], const Unit& u, int wr, int wc, int fr, int fq) const {
        const int row0 = u.pm * BM + wr * 64 + fr;
        if (u.sel == 1) {
            const int col0 = u.pn * BM + wc * 32 + 8 * fq;
#pragma unroll
            for (int ai = 0; ai < 2; ++ai)
#pragma unroll
                for (int m = 0; m < 4; ++m) { bf16_t* rowp = VT + (size_t)(row0 + ai * HALF + m * 16) * M + col0;
#pragma unroll
                    for (int bj = 0; bj < 2; ++bj) { const f32x4 v0 = acc[ai][bj][m][0], v1 = acc[ai][bj][m][1];
                        u32x4 w; w.x = cvt_pk_bf16(v0[0], v0[1]); w.y = cvt_pk_bf16(v0[2], v0[3]); w.z = cvt_pk_bf16(v1[0], v1[1]); w.w = cvt_pk_bf16(v1[2], v1[3]);
                        *(u32x4*)(rowp + bj * HALF) = w; } }
        } else if (u.pn >= 8) {
            const int col0 = (u.pn - 8) * BM + wc * 32 + 8 * fq;
#pragma unroll
            for (int ai = 0; ai < 2; ++ai)
#pragma unroll
                for (int m = 0; m < 4; ++m) { bf16_t* rowp = Q + 2 * (size_t)M * D + (size_t)(row0 + ai * HALF + m * 16) * D + col0;
#pragma unroll
                    for (int bj = 0; bj < 2; ++bj) { f32x4 v0 = acc[ai][bj][m][0], v1 = acc[ai][bj][m][1];
#pragma unroll
                        for (int j = 0; j < 4; ++j) { v0[j] = silu_f(v0[j]); v1[j] = silu_f(v1[j]); }
                        u32x4 w; w.x = cvt_pk_bf16(v0[0], v0[1]); w.y = cvt_pk_bf16(v0[2], v0[3]); w.z = cvt_pk_bf16(v1[0], v1[1]); w.w = cvt_pk_bf16(v1[2], v1[3]);
                        *(u32x4*)(rowp + bj * HALF) = w; } }
        } else {
            const bool isq = u.pn < 4; bf16_t* O = Q + (size_t)(u.pn >> 2) * ((size_t)M * D); const float* nw = qn; if (!isq) nw = kn; const float sc = isq ? (LOG2E * 0.125f) : 1.0f;
            const int col0 = (u.pn & 3) * BM + 64 * wc + 8 * fq;
            f32x4 w4[2][2];
#pragma unroll
            for (int bj = 0; bj < 2; ++bj)
#pragma unroll
                for (int n = 0; n < 2; ++n) w4[bj][n] = *(const f32x4*)(nw + 32 * bj + 8 * fq + 4 * n);
#pragma unroll
            for (int ai = 0; ai < 2; ++ai)
#pragma unroll
                for (int m = 0; m < 4; ++m) {
                    float ss = 0.f;
#pragma unroll
                    for (int bj = 0; bj < 2; ++bj)
#pragma unroll
                        for (int n = 0; n < 2; ++n) { const f32x4 v = acc[ai][bj][m][n]; ss += (v[0] * v[0] + v[1] * v[1]) + (v[2] * v[2] + v[3] * v[3]); }
                    ss += __shfl_xor(ss, 16); ss += __shfl_xor(ss, 32);
                    const float rs = __builtin_amdgcn_rsqf(ss * (1.0f / 64.0f) + EPS) * sc;
                    bf16_t* rowp = O + (size_t)(row0 + ai * HALF + m * 16) * D + col0;
#pragma unroll
                    for (int bj = 0; bj < 2; ++bj) { const f32x4 v0 = acc[ai][bj][m][0] * rs * w4[bj][0], v1 = acc[ai][bj][m][1] * rs * w4[bj][1];
                        u32x4 w; w.x = cvt_pk_bf16(v0[0], v0[1]); w.y = cvt_pk_bf16(v0[2], v0[3]); w.z = cvt_pk_bf16(v1[0], v1[1]); w.w = cvt_pk_bf16(v1[2], v1[3]);
                        *(u32x4*)(rowp + 32 * bj) = w; } }
        }
    }
};
struct EpiRes {
    static constexpr bool PERM = false;
    const float* base; float* out; const float* gate;
    __device__ __forceinline__ void operator()(const f32x4 (&acc)[2][2][4][2], const Unit& u, int wr, int wc, int fr, int fq) const {
        const int row0 = u.pm * BM + wr * 64 + fr, col0 = u.pn * BM + wc * 32 + 4 * fq;
        const float* gp = gate + ((u.pm * BM) / SEQ) * 3072 + col0;
        f32x4 gv[2][2];
#pragma unroll
        for (int bj = 0; bj < 2; ++bj)
#pragma unroll
            for (int n = 0; n < 2; ++n) gv[bj][n] = *(const f32x4*)(gp + bj * HALF + n * 16);
#pragma unroll
        for (int ai = 0; ai < 2; ++ai)
#pragma unroll
            for (int m = 0; m < 4; ++m) { const size_t off = (size_t)(row0 + ai * HALF + m * 16) * D + col0;
#pragma unroll
                for (int bj = 0; bj < 2; ++bj)
#pragma unroll
                    for (int n = 0; n < 2; ++n) { const f32x4 bs = *(const f32x4*)(base + off + bj * HALF + n * 16);
                        *(f32x4*)(out + off + bj * HALF + n * 16) = bs + gv[bj][n] * acc[ai][bj][m][n]; } }
    }
};
}

#define XB_TMO      128
#define XB_XCNT(j)  (256  + 64 * (j))
#define XB_XSUB(j)  (1280 + 64 * (j))
#define XB_XGEN(j)  (2304 + 64 * (j))
#define XB_TOP      3328
#define XB_TOPGEN   3392
#define XCD_BAR_WORDS 3456
#define XB_SPIN_CAP (1u << 18)
__device__ __forceinline__ unsigned xb_ld(unsigned* p)              { return __hip_atomic_load(p, __ATOMIC_RELAXED, __HIP_MEMORY_SCOPE_AGENT); }
__device__ __forceinline__ unsigned xb_add(unsigned* p, unsigned v) { return __hip_atomic_fetch_add(p, v, __ATOMIC_RELAXED, __HIP_MEMORY_SCOPE_AGENT); }
__device__ __forceinline__ unsigned xb_xcc_id() { return (unsigned)__builtin_amdgcn_s_getreg((3 << 11) | 20) & 0xFu; }
#define XB_SPIN(cond, bar) do { unsigned _sp = 0; while (cond) { __builtin_amdgcn_s_sleep(1); \
    if ((++_sp & 255u) == 0u) { if (xb_ld(&(bar)[XB_TMO])) break; if (_sp > XB_SPIN_CAP) { atomicAdd(&(bar)[XB_TMO], 1u); break; } } } } while (0)
struct XcdBarrier { unsigned* bar; unsigned x; volatile LAS unsigned* st; };
__device__ __forceinline__ XcdBarrier xcd_barrier_post(unsigned* bar, volatile LAS unsigned* st) {
    XcdBarrier b; b.bar = bar; b.x = xb_xcc_id(); b.st = st;
    if (threadIdx.x == 0) (void)xb_add(&bar[XB_XCNT(b.x)], 1u);
    return b;
}
__device__ __forceinline__ void xcd_barrier_complete(unsigned* bar, unsigned x, unsigned& nloc, unsigned& nx) {
    const unsigned G = gridDim.x * gridDim.y * gridDim.z;
    unsigned sum, cnt, mine, sp = 0u;
    for (;;) {
        sum = 0u; cnt = 0u; mine = 0u;
#pragma unroll
        for (unsigned j = 0; j < 16; ++j) { const unsigned c = xb_ld(&bar[XB_XCNT(j)]); sum += c; cnt += (c > 0u) ? 1u : 0u; mine = (j == x) ? c : mine; }
        if (sum == G) break;
        __builtin_amdgcn_s_sleep(1);
        if ((++sp & 255u) == 0u) { if (xb_ld(&bar[XB_TMO])) break; if (sp > XB_SPIN_CAP) { atomicAdd(&bar[XB_TMO], 1u); break; } }
    }
    nloc = mine > 0u ? mine : 1u; nx = cnt > 0u ? cnt : 1u;
}
__device__ __forceinline__ void xcd_barrier(const XcdBarrier& b) {
    asm volatile("s_waitcnt vmcnt(0)" ::: "memory");
    __syncthreads();
    if (threadIdx.x == 0) {
        unsigned* bar = b.bar;
        __builtin_amdgcn_s_waitcnt(0);
        unsigned nloc = b.st[0], nx = b.st[1];
        if (nloc == 0u) { xcd_barrier_complete(bar, b.x, nloc, nx); b.st[0] = nloc; b.st[1] = nx; }
        const unsigned old = xb_add(&bar[XB_XSUB(b.x)], 1u);
        const unsigned gen = old / nloc;
        if (old + 1u == (gen + 1u) * nloc) {
            __builtin_amdgcn_fence(__ATOMIC_RELEASE, "agent");
            asm volatile("s_waitcnt vmcnt(0)" ::: "memory");
            const unsigned og = xb_add(&bar[XB_TOP], 1u);
            const unsigned tg = og / nx;
            if (og + 1u == (tg + 1u) * nx) xb_add(&bar[XB_TOPGEN], 1u);
            else XB_SPIN(xb_ld(&bar[XB_TOPGEN]) == tg, bar);
            __builtin_amdgcn_fence(__ATOMIC_ACQUIRE, "agent");
            xb_add(&bar[XB_XGEN(b.x)], 1u);
            asm volatile("s_waitcnt vmcnt(0)" ::: "memory");
        } else {
            XB_SPIN(xb_ld(&bar[XB_XGEN(b.x)]) == gen, bar);
            __builtin_amdgcn_fence(__ATOMIC_ACQUIRE, "agent");
            asm volatile("s_waitcnt vmcnt(0)" ::: "memory");
        }
    }
    __syncthreads();
}

struct Args {
    const float *x, *c, *ln_g, *ada_w, *ada_b, *w_in_ab, *conv_w, *sg_norm, *sg_w, *sg_b, *w_out_ab, *w_in_c, *q_norm, *k_norm, *w_out_c;
    float* out; unsigned char* ws; int ph_lo, ph_hi;
};

__device__ __forceinline__ int ab_row(int c) {
    const int seg = c >> 10, cc = c & 1023, t = cc >> 7, r = cc & 127;
    switch (seg) {
        case 1: return 256 * t + r;
        case 2: return 256 * t + 128 + r;
        case 0: return 256 * (8 + t) + r;
        case 3: return 256 * (8 + t) + 128 + r;
        case 4: return 256 * (16 + t) + r;
        case 6: return 256 * (16 + t) + 128 + r;
        default: return 256 * 24 + cc;
    }
}
__device__ __forceinline__ int c_row(int c) {
    const int seg = c >> 10, cc = c & 1023;
    if (seg == 2) return 3072 + cc;
    if (seg == 3) return 2048 + cc;
    const int tile = cc >> 8, ct = cc & 255, hh = ct >> 6, bj = (ct >> 5) & 1, i = ct & 31;
    return seg * 1024 + tile * 256 + 128 * bj + 32 * hh + i;
}
template <int MODE>
__device__ __forceinline__ void p0_transpose_item(const float* W, int K, int N, bf16_t* WT, LAS float* scr, int item, int lane) {
    const int nblk = N / 32, kb = item / nblk, nb = item % nblk, k0 = 64 * kb, n0 = 32 * nb;
    const int rb = MODE == 1 ? ab_row(n0) : (MODE == 2 ? c_row(n0) : n0);
#pragma unroll 8
    for (int i = 0; i < 32; ++i) { const int kk = 2 * i + (lane >> 5); scr[kk * 33 + (lane & 31)] = W[(size_t)(k0 + kk) * N + n0 + (lane & 31)]; }
    asm volatile("s_waitcnt lgkmcnt(0)" ::: "memory");
    const int c = lane & 7;
#pragma unroll
    for (int j = 0; j < 4; ++j) { const int n = (lane >> 3) + 8 * j; const LAS float* s = scr + (8 * c) * 33 + n;
        u32x4 o; o.x = cvt_pk_bf16(s[0 * 33], s[1 * 33]); o.y = cvt_pk_bf16(s[2 * 33], s[3 * 33]); o.z = cvt_pk_bf16(s[4 * 33], s[5 * 33]); o.w = cvt_pk_bf16(s[6 * 33], s[7 * 33]);
        *(u32x4*)(WT + (size_t)(rb + n) * K + k0 + 8 * c) = o; }
    asm volatile("s_waitcnt lgkmcnt(0)" ::: "memory");
}

__device__ __forceinline__ float wave_sum(float v) {
#pragma unroll
    for (int o = 1; o < 64; o <<= 1) v += __shfl_xor(v, o);
    return v;
}
__device__ __forceinline__ void rms_phase(const float* X, const float* g, const float* mod  , bf16_t* H, int gw, int NGW, int lane) {
    for (int b = 0; b < BATCH; ++b) {
        f32x4 mul[4], sh[4];
#pragma unroll
        for (int j = 0; j < 4; ++j) { const int col = 4 * lane + 256 * j; const f32x4 gg = *(const f32x4*)(g + col), sc = *(const f32x4*)(mod + b * 3072 + 1024 + col);
            sh[j] = *(const f32x4*)(mod + b * 3072 + col); mul[j] = gg * (sc + 1.0f); }
        for (int r = gw; r < SEQ; r += NGW) {
            const size_t m = (size_t)b * SEQ + r;
            const f32x4* xr = (const f32x4*)(X + m * D) + lane;
            f32x4 v[4]; float s = 0.f;
#pragma unroll
            for (int j = 0; j < 4; ++j) { v[j] = xr[64 * j]; s += (v[j].x * v[j].x + v[j].y * v[j].y) + (v[j].z * v[j].z + v[j].w * v[j].w); }
            const float rstd = __builtin_amdgcn_rsqf(wave_sum(s) * (1.f / D) + EPS);
            u32x2* o8 = (u32x2*)(H + m * D) + lane;
#pragma unroll
            for (int j = 0; j < 4; ++j) { const f32x4 o = v[j] * rstd * mul[j] + sh[j]; u32x2 w; w.x = cvt_pk_bf16(o.x, o.y); w.y = cvt_pk_bf16(o.z, o.w); o8[64 * j] = w; }
        }
    }
}

__device__ __forceinline__ void mixer_phase(LAS unsigned char* lds, const bf16_t* U, const bf16_t* Gt, const bf16_t* UZ, const bf16_t* V, const float* conv_w, const float* sg_norm,
                                            const float* sg_w, const float* sg_b, bf16_t* Y, int vcu, int G) {
    const int tid = threadIdx.x, lane = tid & 63, w = __builtin_amdgcn_readfirstlane(tid >> 6), fr = lane & 15, fq = lane >> 4;
    constexpr int PT = 136;
    LAS bf16_t* VNT = (LAS bf16_t*)lds;
    LAS bf16_t* WL = (LAS bf16_t*)(lds + 128 * PT * 2);
    LAS float* SG = (LAS float*)lds;
    for (int unit = vcu; unit < BATCH * 64 * 8; unit += G) {
        const int g = unit & 7, cch = (unit >> 3) & 63, b = unit >> 9; const size_t r0 = (size_t)b * SEQ + cch * 128;
        { const int c8 = tid & 15, rg = tid >> 4, ch = 128 * g + 8 * c8; const size_t row = r0 + 4 * rg;
          float cw[3][8];
#pragma unroll
          for (int k = 0; k < 3; ++k) { const f32x4 a = *(const f32x4*)(conv_w + k * D + ch), bq = *(const f32x4*)(conv_w + k * D + ch + 4);
              cw[k][0] = a.x; cw[k][1] = a.y; cw[k][2] = a.z; cw[k][3] = a.w; cw[k][4] = bq.x; cw[k][5] = bq.y; cw[k][6] = bq.z; cw[k][7] = bq.w; }
          u32x4 ur[6];
          const bool halo0 = (cch == 0 && rg == 0);
#pragma unroll
          for (int i = 0; i < 6; ++i) { if (i < 2 && halo0) ur[i] = (u32x4){0u, 0u, 0u, 0u}; else ur[i] = *(const u32x4*)(U + (row + i - 2) * D + ch); }
#pragma unroll
          for (int i = 0; i < 4; ++i) { const u32x4 gv = *(const u32x4*)(Gt + (row + i) * D + ch); float o[8];
#pragma unroll
              for (int p = 0; p < 4; ++p) { const unsigned u0 = ur[i][p], u1 = ur[i + 1][p], u2 = ur[i + 2][p];
                  o[2 * p] = bf_lo(gv[p]) * (cw[0][2 * p] * bf_lo(u0) + cw[1][2 * p] * bf_lo(u1) + cw[2][2 * p] * bf_lo(u2));
                  o[2 * p + 1] = bf_hi(gv[p]) * (cw[0][2 * p + 1] * bf_hi(u0) + cw[1][2 * p + 1] * bf_hi(u1) + cw[2][2 * p + 1] * bf_hi(u2)); }
              u32x4 wv; wv.x = cvt_pk_bf16(o[0], o[1]); wv.y = cvt_pk_bf16(o[2], o[3]); wv.z = cvt_pk_bf16(o[4], o[5]); wv.w = cvt_pk_bf16(o[6], o[7]);
              *(u32x4*)(Y + (row + i) * 2048 + ch) = wv; }
        }
        { const int s = tid >> 2, qd = tid & 3; const bf16_t* vp = V + (r0 + s) * D + 128 * g + 32 * qd;
          float v[32]; float ss = 0.f;
#pragma unroll
          for (int i = 0; i < 4; ++i) { const u32x4 t = *(const u32x4*)(vp + 8 * i);
#pragma unroll
              for (int p = 0; p < 4; ++p) { v[8 * i + 2 * p] = bf_lo(t[p]); v[8 * i + 2 * p + 1] = bf_hi(t[p]); } }
#pragma unroll
          for (int i = 0; i < 32; ++i) ss += v[i] * v[i];
          ss += __shfl_xor(ss, 1); ss += __shfl_xor(ss, 2);
          const float rs = __builtin_amdgcn_rsqf(ss * (1.0f / 128.0f) + EPS);
          const float* nw = sg_norm + g * 128 + 32 * qd;
#pragma unroll
          for (int i = 0; i < 32; i += 2) { const unsigned pk = cvt_pk_bf16(v[i] * rs * nw[i], v[i + 1] * rs * nw[i + 1]);
              VNT[(32 * qd + i) * PT + s] = (bf16_t)(pk & 0xffffu); VNT[(32 * qd + i + 1) * PT + s] = (bf16_t)(pk >> 16); }
          const int t = tid >> 2, sq = tid & 3; const float* wp = sg_w + ((size_t)g * 128 + t) * 128 + 32 * sq;
#pragma unroll
          for (int i = 0; i < 4; ++i) { f32x4 a = *(const f32x4*)(wp + 8 * i), bq = *(const f32x4*)(wp + 8 * i + 4); const int s0 = 32 * sq + 8 * i;
              float e[8] = {a.x, a.y, a.z, a.w, bq.x, bq.y, bq.z, bq.w};
#pragma unroll
              for (int p = 0; p < 8; ++p) if (s0 + p > t) e[p] = 0.f;
              u32x4 wv; wv.x = cvt_pk_bf16(e[0], e[1]); wv.y = cvt_pk_bf16(e[2], e[3]); wv.z = cvt_pk_bf16(e[4], e[5]); wv.w = cvt_pk_bf16(e[6], e[7]);
              *(LAS u32x4*)(WL + t * PT + s0) = wv; }
        }
        __syncthreads();
        f32x4 acc[8];
#pragma unroll
        for (int tt = 0; tt < 8; ++tt) acc[tt] = (f32x4){0.f, 0.f, 0.f, 0.f};
#pragma unroll
        for (int ks = 0; ks < 4; ++ks) { const bf16x8 a = *(const LAS bf16x8*)(VNT + (16 * w + fr) * PT + 32 * ks + 8 * fq);
#pragma unroll
            for (int tt = 2 * ks; tt < 8; ++tt) { const bf16x8 bw = *(const LAS bf16x8*)(WL + (16 * tt + fr) * PT + 32 * ks + 8 * fq);
                acc[tt] = __builtin_amdgcn_mfma_f32_16x16x32_bf16(a, bw, acc[tt], 0, 0, 0); } }
        __syncthreads();
#pragma unroll
        for (int tt = 0; tt < 8; ++tt) { const int t = 16 * tt + fr; const float bb = sg_b[g * 128 + t];
            *(LAS f32x4*)(SG + t * 132 + 16 * w + 4 * fq) = acc[tt] + bb; }
        __syncthreads();
        { const int rr = tid >> 2, dq = tid & 3; const bf16_t* up = UZ + (r0 + rr) * D + 128 * g + 32 * dq; bf16_t* yp = Y + (r0 + rr) * 2048 + 1024 + 128 * g + 32 * dq;
#pragma unroll
          for (int i = 0; i < 4; ++i) { const u32x4 uz = *(const u32x4*)(up + 8 * i); const f32x4 s0 = *(const LAS f32x4*)(SG + rr * 132 + 32 * dq + 8 * i), s1 = *(const LAS f32x4*)(SG + rr * 132 + 32 * dq + 8 * i + 4);
              u32x4 wv; wv.x = cvt_pk_bf16(bf_lo(uz.x) * s0.x, bf_hi(uz.x) * s0.y); wv.y = cvt_pk_bf16(bf_lo(uz.y) * s0.z, bf_hi(uz.y) * s0.w);
              wv.z = cvt_pk_bf16(bf_lo(uz.z) * s1.x, bf_hi(uz.z) * s1.y); wv.w = cvt_pk_bf16(bf_lo(uz.w) * s1.z, bf_hi(uz.w) * s1.w);
              *(u32x4*)(yp + 8 * i) = wv; }
        }
        __syncthreads();
    }
}

__device__ __forceinline__ int crow(int i, int hi) { return (i & 3) + 8 * (i >> 2) + 4 * hi; }
__device__ __forceinline__ void attn_phase(const bf16_t* Q, const bf16_t* Kb, const bf16_t* VT, const bf16_t* Zs, bf16_t* OZ, int gw, int NGW, int lane) {
    const int ql = lane & 31, hi = lane >> 5;
    constexpr float STOP = -150.0f;
    for (int wu = gw; wu < BATCH * 16 * (SEQ / 32); wu += NGW) {
        const int qb = wu & 255, h = (wu >> 8) & 15, b = wu >> 12;
        const size_t rowbase = (size_t)b * SEQ; const int q0 = 32 * qb;
        bf16x8 qf[4];
        { const bf16_t* qp = Q + (rowbase + q0 + ql) * D + h * 64 + 8 * hi;
#pragma unroll
          for (int kk = 0; kk < 4; ++kk) qf[kk] = *(const bf16x8*)(qp + 16 * kk); }
        f32x16 o0, o1;
#pragma unroll
        for (int i = 0; i < 16; ++i) { o0[i] = 0.f; o1[i] = 0.f; }
        float carry = 0.f;
        bf16x8 kf[4];
        { const bf16_t* kp = Kb + (rowbase + q0 + ql) * D + h * 64 + 8 * hi;
#pragma unroll
          for (int kk = 0; kk < 4; ++kk) kf[kk] = *(const bf16x8*)(kp + 16 * kk); }
        for (int kt = qb; kt >= 0; --kt) {
            const int key0 = 32 * kt;
            u32x2 vf[2][2][2];
            { const bf16_t* vp = VT + (size_t)(h * 64 + ql) * M + rowbase + key0 + 4 * hi;
#pragma unroll
              for (int dh = 0; dh < 2; ++dh)
#pragma unroll
                  for (int s = 0; s < 2; ++s) { vf[dh][s][0] = *(const u32x2*)(vp + (size_t)dh * 32 * M + 16 * s); vf[dh][s][1] = *(const u32x2*)(vp + (size_t)dh * 32 * M + 16 * s + 8); } }
            bf16x8 kn[4];
            { const int kt2 = kt > 0 ? kt - 1 : 0; const bf16_t* kp = Kb + (rowbase + 32 * kt2 + ql) * D + h * 64 + 8 * hi;
#pragma unroll
              for (int kk = 0; kk < 4; ++kk) kn[kk] = *(const bf16x8*)(kp + 16 * kk); }
            f32x16 S;
#pragma unroll
            for (int i = 0; i < 16; ++i) S[i] = 0.f;
#pragma unroll
            for (int kk = 0; kk < 4; ++kk) S = __builtin_amdgcn_mfma_f32_32x32x16_bf16(kf[kk], qf[kk], S, 0, 0, 0);
            float lb[16], l1[16];
            const bool diag = (kt == qb);
#pragma unroll
            for (int i = 0; i < 16; ++i) { const float z = S[i]; const float e = fast_exp2(-fabsf(z)); const float L0 = fast_log2(1.0f + e);
                float lbv = fminf(z, 0.f) - L0; float l1v = lbv - z;
                if (diag) { const bool valid = crow(i, hi) < ql; l1v = valid ? l1v : 0.f; lbv = valid ? lbv : -1e30f; }
                lb[i] = lbv; l1[i] = l1v; }
            float gs[4], pg[4];
#pragma unroll
            for (int gi = 0; gi < 4; ++gi) { gs[gi] = (l1[4 * gi] + l1[4 * gi + 1]) + (l1[4 * gi + 2] + l1[4 * gi + 3]); pg[gi] = __shfl_xor(gs[gi], 32); }
            float run = carry; float wv[16];
#pragma unroll
            for (int gi = 3; gi >= 0; --gi) { const float base = run + (hi == 0 ? pg[gi] : 0.f);
                const float s3 = base, s2 = s3 + l1[4 * gi + 3], s1 = s2 + l1[4 * gi + 2], s0 = s1 + l1[4 * gi + 1];
                wv[4 * gi + 3] = fast_exp2(lb[4 * gi + 3] + s3); wv[4 * gi + 2] = fast_exp2(lb[4 * gi + 2] + s2);
                wv[4 * gi + 1] = fast_exp2(lb[4 * gi + 1] + s1); wv[4 * gi] = fast_exp2(lb[4 * gi] + s0);
                run += gs[gi] + pg[gi]; }
            carry = run;
#pragma unroll
            for (int s = 0; s < 2; ++s) { u32x4 pk; pk.x = cvt_pk_bf16(wv[8 * s], wv[8 * s + 1]); pk.y = cvt_pk_bf16(wv[8 * s + 2], wv[8 * s + 3]); pk.z = cvt_pk_bf16(wv[8 * s + 4], wv[8 * s + 5]); pk.w = cvt_pk_bf16(wv[8 * s + 6], wv[8 * s + 7]);
                const bf16x8 pf = __builtin_bit_cast(bf16x8, pk);
                { u32x4 a; a.x = vf[0][s][0].x; a.y = vf[0][s][0].y; a.z = vf[0][s][1].x; a.w = vf[0][s][1].y; o0 = __builtin_amdgcn_mfma_f32_32x32x16_bf16(__builtin_bit_cast(bf16x8, a), pf, o0, 0, 0, 0); }
                { u32x4 a; a.x = vf[1][s][0].x; a.y = vf[1][s][0].y; a.z = vf[1][s][1].x; a.w = vf[1][s][1].y; o1 = __builtin_amdgcn_mfma_f32_32x32x16_bf16(__builtin_bit_cast(bf16x8, a), pf, o1, 0, 0, 0); } }
#pragma unroll
            for (int kk = 0; kk < 4; ++kk) kf[kk] = kn[kk];
            if (__all(carry < STOP)) break;
        }
        const bf16_t* zp = Zs + (rowbase + q0 + ql) * D + h * 64 + 4 * hi; bf16_t* op = OZ + (rowbase + q0 + ql) * D + h * 64 + 4 * hi;
#pragma unroll
        for (int g4 = 0; g4 < 4; ++g4) {
            { const u32x2 zz = *(const u32x2*)(zp + 8 * g4); u32x2 w; w.x = cvt_pk_bf16(o0[4 * g4] * bf_lo(zz.x), o0[4 * g4 + 1] * bf_hi(zz.x)); w.y = cvt_pk_bf16(o0[4 * g4 + 2] * bf_lo(zz.y), o0[4 * g4 + 3] * bf_hi(zz.y)); *(u32x2*)(op + 8 * g4) = w; }
            { const u32x2 zz = *(const u32x2*)(zp + 32 + 8 * g4); u32x2 w; w.x = cvt_pk_bf16(o1[4 * g4] * bf_lo(zz.x), o1[4 * g4 + 1] * bf_hi(zz.x)); w.y = cvt_pk_bf16(o1[4 * g4 + 2] * bf_lo(zz.y), o1[4 * g4 + 3] * bf_hi(zz.y)); *(u32x2*)(op + 32 + 8 * g4) = w; }
        }
    }
}

constexpr int N_PHASES = 9;
__global__ void __launch_bounds__(NTHR, 2) hybrid_fwd(Args a) {
    extern __shared__ __attribute__((aligned(16))) unsigned char lds_raw[];
    LAS unsigned char* lds = (LAS unsigned char*)lds_raw;
    const int tid = threadIdx.x, lane = tid & 63, wave = __builtin_amdgcn_readfirstlane(tid >> 6);
    const int G = gridDim.x, bx = blockIdx.x;
    const int vcu = (G % 8 == 0) ? (bx % 8) * (G / 8) + bx / 8 : bx;
    const int gw = vcu * NWAVES + wave, NGW = G * NWAVES;
    unsigned char* ws = a.ws;
    float* MOD = (float*)(ws + WS_MOD);
    bf16_t* WAB = (bf16_t*)(ws + WS_WAB); bf16_t* WOAB = (bf16_t*)(ws + WS_WOAB); bf16_t* WC = (bf16_t*)(ws + WS_WC); bf16_t* WOC = (bf16_t*)(ws + WS_WOC);
    bf16_t* H0 = (bf16_t*)(ws + WS_H0); bf16_t* Y = (bf16_t*)(ws + WS_Y);
    bf16_t* Ub = (bf16_t*)(ws + WS_U); bf16_t* Gb = (bf16_t*)(ws + WS_G); bf16_t* UZb = (bf16_t*)(ws + WS_UZ); bf16_t* Vb = (bf16_t*)(ws + WS_V);
    float* X1 = (float*)(ws + WS_X1); bf16_t* H1 = (bf16_t*)(ws + WS_H1);
    bf16_t* Qb = (bf16_t*)(ws + WS_Q); bf16_t* Kb = (bf16_t*)(ws + WS_K); bf16_t* Zb = (bf16_t*)(ws + WS_Z); bf16_t* VTb = (bf16_t*)(ws + WS_VT); bf16_t* OZb = (bf16_t*)(ws + WS_OZ);
    const int lo = a.ph_lo, hi = a.ph_hi;
#define IN(k) (lo <= (k) && (k) < hi)
    volatile LAS unsigned* bst = (volatile LAS unsigned*)(lds + 131072 + 320);
    if (tid < 4) bst[tid] = 0u;
    __syncthreads();
    XcdBarrier xbar; xbar.bar = (unsigned*)(ws + WS_CTL); xbar.x = 0; xbar.st = bst;
    if (hi - lo > 1) xbar = xcd_barrier_post((unsigned*)(ws + WS_CTL), bst);
#define SEAM(k) do { if (IN(k) && IN((k) + 1)) { if ((k) == 0) { asm volatile("s_waitcnt vmcnt(0)" ::: "memory"); __syncthreads(); cg::this_grid().sync(); \
        __builtin_amdgcn_fence(__ATOMIC_ACQUIRE, "agent"); asm volatile("s_waitcnt vmcnt(0)" ::: "memory"); __syncthreads(); } else xcd_barrier(xbar); } } while (0)

    if (IN(0)) {
        for (int task = bx; task < 192; task += G) {
            LAS float* sc_l = (LAS float*)lds; LAS float* red = sc_l + 2048;
            for (int i = tid; i < BATCH * D; i += NTHR) { const float v = a.c[i]; sc_l[i] = v / (1.0f + __expf(-v)); }
            __syncthreads();
            const int l = task / 96, n0 = (task % 96) * 32, kc = wave * 2 + (lane >> 5), n = n0 + (lane & 31);
            const float* W = a.ada_w + (size_t)l * D * 3072 + (size_t)(kc * 64) * 3072 + n;
            float a0 = 0.f, a1 = 0.f;
#pragma unroll 16
            for (int k = 0; k < 64; ++k) { const float wv = W[(size_t)k * 3072]; a0 += sc_l[kc * 64 + k] * wv; a1 += sc_l[D + kc * 64 + k] * wv; }
            red[(kc * 2 + 0) * 32 + (lane & 31)] = a0; red[(kc * 2 + 1) * 32 + (lane & 31)] = a1;
            __syncthreads();
            if (tid < 64) { const int b = tid >> 5, nn = tid & 31; float s = 0.f;
#pragma unroll
                for (int k = 0; k < 16; ++k) s += red[(k * 2 + b) * 32 + nn];
                MOD[(l * 2 + b) * 3072 + n0 + nn] = s + a.ada_b[l * 3072 + n0 + nn]; }
            __syncthreads();
        }
        LAS float* scr = (LAS float*)(lds + wave * 16384);
        constexpr int I_AB = (D / 64) * (IN_AB / 32), I_OAB = (2048 / 64) * (D / 32), I_C = (D / 64) * (IN_C / 32), I_OC = (D / 64) * (D / 32);
        for (int it = gw; it < I_AB + I_OAB + I_C + I_OC; it += NGW) {
            int r = it;
            if (r < I_AB) { p0_transpose_item<1>(a.w_in_ab, D, IN_AB, WAB, scr, r, lane); continue; } r -= I_AB;
            if (r < I_OAB) { p0_transpose_item<0>(a.w_out_ab, 2048, D, WOAB, scr, r, lane); continue; } r -= I_OAB;
            if (r < I_C) { p0_transpose_item<2>(a.w_in_c, D, IN_C, WC, scr, r, lane); continue; } r -= I_C;
            p0_transpose_item<0>(a.w_out_c, D, D, WOC, scr, r, lane);
        }
    }
    SEAM(0);
    if (IN(1)) rms_phase(a.x, a.ln_g, MOD, H0, gw, NGW, lane);
    SEAM(1);
    if (IN(2)) { pg8::Sched2 S; S.init(H0, WAB, M, IN_AB, nullptr, nullptr, 0, 0, D, G, bx);
        pg8::EpiP1 E{Ub}; pg8::gemm_phase<pg8::EpiP1, true, true>(lds, S, E); }
    SEAM(2);
    if (IN(3)) mixer_phase(lds, Ub, Gb, UZb, Vb, a.conv_w, a.sg_norm, a.sg_w, a.sg_b, Y, vcu, G);
    SEAM(3);
    if (IN(4)) { pg8::Sched2 S; S.init(Y, WOAB, M, D, nullptr, nullptr, 0, 0, 2048, G, bx);
        pg8::EpiRes E{a.x, X1, MOD + 2048}; pg8::gemm_phase<pg8::EpiRes, true, true>(lds, S, E); }
    SEAM(4);
    if (IN(5)) rms_phase(X1, a.ln_g + D, MOD + 2 * 3072, H1, gw, NGW, lane);
    SEAM(5);
    if (IN(6)) { pg8::Sched2 S; S.init(H1, WC, M, 3072, WC + (size_t)3072 * D, H1, D, M, D, G, bx);
        pg8::EpiP5 E{Qb, VTb, a.q_norm, a.k_norm}; pg8::gemm_phase<pg8::EpiP5, true, true>(lds, S, E); }
    SEAM(6);
    if (IN(7)) attn_phase(Qb, Kb, VTb, Zb, OZb, gw, NGW, lane);
    SEAM(7);
    if (IN(8)) { pg8::Sched2 S; S.init(OZb, WOC, M, D, nullptr, nullptr, 0, 0, D, G, bx);
        pg8::EpiRes E{X1, a.out, MOD + 2 * 3072 + 2048}; pg8::gemm_phase<pg8::EpiRes, true, true>(lds, S, E); }
#undef IN
#undef SEAM
}

extern "C" void kernel_launch(void* const* d_in, const int* in_sizes, int n_in, void* d_out, int out_size, void* d_ws, size_t ws_size, hipStream_t stream) {
    static int grid = 0;
    if (grid == 0) {
        if (n_in != 15 || in_sizes[0] != M * D || out_size != M * D || ws_size < WS_END) { fprintf(stderr, "kernel_launch: unexpected problem geometry (n_in %d, ws %zu)\n", n_in, ws_size); grid = -1; return; }
        int dev = 0, cus = 0, per_cu = 0;
        (void)hipGetDevice(&dev); (void)hipDeviceGetAttribute(&cus, hipDeviceAttributeMultiprocessorCount, dev);
        if (hipFuncSetAttribute((const void*)hybrid_fwd, hipFuncAttributeMaxDynamicSharedMemorySize, LDS_BYTES) != hipSuccess) { fprintf(stderr, "kernel_launch: hipFuncSetAttribute failed\n"); grid = -1; return; }
        if (hipOccupancyMaxActiveBlocksPerMultiprocessor(&per_cu, (const void*)hybrid_fwd, NTHR, LDS_BYTES) != hipSuccess || per_cu < 1) { fprintf(stderr, "kernel_launch: occupancy query says %d\n", per_cu); per_cu = 1; }
        (void)hipGetLastError();
        grid = cus * per_cu;
    }
    if (grid < 0) return;
    Args a{};
    a.x = (const float*)d_in[0]; a.c = (const float*)d_in[1]; a.ln_g = (const float*)d_in[2]; a.ada_w = (const float*)d_in[3]; a.ada_b = (const float*)d_in[4];
    a.w_in_ab = (const float*)d_in[5]; a.conv_w = (const float*)d_in[6]; a.sg_norm = (const float*)d_in[7]; a.sg_w = (const float*)d_in[8]; a.sg_b = (const float*)d_in[9];
    a.w_out_ab = (const float*)d_in[10]; a.w_in_c = (const float*)d_in[11]; a.q_norm = (const float*)d_in[12]; a.k_norm = (const float*)d_in[13]; a.w_out_c = (const float*)d_in[14];
    a.out = (float*)d_out; a.ws = (unsigned char*)d_ws;
#if MK_MULTI
    for (int p = 0; p < N_PHASES; ++p) { a.ph_lo = p; a.ph_hi = p + 1; hipLaunchKernelGGL(hybrid_fwd, dim3(grid), dim3(NTHR), LDS_BYTES, stream, a); }
#else
    a.ph_lo = 0; a.ph_hi = N_PHASES;
    (void)hipMemsetAsync((char*)d_ws + WS_CTL, 0, CTL_ZERO_BYTES, stream);
    void* args[] = {&a};
    hipError_t e = hipLaunchCooperativeKernel((const void*)hybrid_fwd, dim3(grid), dim3(NTHR), args, LDS_BYTES, stream);
    if (e != hipSuccess) fprintf(stderr, "kernel_launch: cooperative launch failed: %s (grid %d)\n", hipGetErrorString(e), grid);
#endif
}
```

```cpp
#include <hip/hip_runtime.h>
#include <hip/hip_cooperative_groups.h>
#include <cstdio>
#include <cstdint>
namespace cg = cooperative_groups;

#ifndef MK_MULTI
#define MK_MULTI 0
#endif

#define LAS __attribute__((address_space(3)))
typedef unsigned short bf16_t;
typedef short bf16x8 __attribute__((ext_vector_type(8)));
typedef float f32x4 __attribute__((ext_vector_type(4)));
typedef float f32x16 __attribute__((ext_vector_type(16)));
typedef unsigned u32x4 __attribute__((ext_vector_type(4)));
typedef unsigned u32x2 __attribute__((ext_vector_type(2)));

constexpr int BATCH = 2, SEQ = 8192, D = 1024, M = BATCH * SEQ;
constexpr int IN_AB = 7168, IN_C = 4096;
constexpr float EPS = 1e-6f;
constexpr int NWAVES = 8, NTHR = 512;
constexpr float LOG2E = 1.4426950408889634f;

constexpr size_t MiB = 1u << 20;
constexpr size_t WS_CTL = 0, CTL_ZERO_BYTES = 64 * 1024;
constexpr size_t WS_MOD = 1 * MiB;
constexpr size_t WS_WAB = 2 * MiB;
constexpr size_t WS_WOAB = 16 * MiB;
constexpr size_t WS_WC = 20 * MiB;
constexpr size_t WS_WOC = 28 * MiB;
constexpr size_t WS_U = 32 * MiB, WS_G = 64 * MiB, WS_UZ = 96 * MiB, WS_V = 128 * MiB;
constexpr size_t WS_H0 = 160 * MiB;
constexpr size_t WS_Y = 160 * MiB;
constexpr size_t WS_X1 = 32 * MiB;
constexpr size_t WS_H1 = 96 * MiB;
constexpr size_t WS_Q = 128 * MiB, WS_K = 160 * MiB, WS_Z = 192 * MiB, WS_VT = 224 * MiB;
constexpr size_t WS_OZ = 96 * MiB;
constexpr size_t WS_END = 256 * MiB;
static_assert(WS_G - WS_U == (size_t)M * D * 2 && WS_UZ - WS_G == (size_t)M * D * 2 && WS_V - WS_UZ == (size_t)M * D * 2 && WS_K - WS_Q == (size_t)M * D * 2 && WS_Z - WS_K == (size_t)M * D * 2, "contiguous activations");

constexpr int LDS_BYTES = 147456;

typedef float f32x2_t __attribute__((ext_vector_type(2))); typedef __bf16 bf16x2_t __attribute__((ext_vector_type(2)));
__device__ __forceinline__ unsigned cvt_pk_bf16(float lo, float hi) { f32x2_t v = {lo, hi}; bf16x2_t b = __builtin_convertvector(v, bf16x2_t); return __builtin_bit_cast(unsigned, b); }
__device__ __forceinline__ float bf_lo(unsigned u) { return __uint_as_float(u << 16); }
__device__ __forceinline__ float bf_hi(unsigned u) { return __uint_as_float(u & 0xffff0000u); }
__device__ __forceinline__ float fast_exp2(float x) { return __builtin_amdgcn_exp2f(x); }
__device__ __forceinline__ float fast_log2(float x) { return __builtin_amdgcn_logf(x); }
__device__ __forceinline__ float fast_rcp(float x) { return __builtin_amdgcn_rcpf(x); }
__device__ __forceinline__ float silu_f(float v) { return v * fast_rcp(1.0f + fast_exp2(-LOG2E * v)); }

namespace pg8 {
constexpr int BM = 256, BK = 64, HALF = 128, HTB = HALF * BK * 2, STAGE_BYTES = 8 * HTB, NXCD = 8, WGM = 8;
__host__ __device__ __forceinline__ int lds_byte(int r, int c) { const int st = (r >> 4) * 2 + (c >> 5), rr = r & 15, cc = c & 31, ob = rr * 64 + cc * 2; return st * 1024 + (ob ^ (((ob >> 9) & 1) << 5)); }
__host__ __device__ __forceinline__ void stage_rc(int b, int& R, int& C) { const int st = b / 1024, sb = b % 1024, swz = sb ^ (((sb >> 9) & 1) << 5); R = (st >> 1) * 16 + swz / 64; C = (st & 1) * 32 + (swz % 64) / 2; }
__host__ __device__ __forceinline__ int perm32(int rho) { const int n = rho >> 4, i = rho & 15; return 8 * (i >> 2) + 4 * n + (i & 3); }

struct Unit { int pm, pn, sel; };
struct Sched2 {
    const bf16_t *A0, *B0, *A1, *B1; int nM0, nN0, nwg0, nM1, nN1, nwg1, G, c, K;
    __device__ void init(const bf16_t* a0, const bf16_t* b0, int m0, int n0, const bf16_t* a1, const bf16_t* b1, int m1, int n1, int K_, int G_, int c_) {
        A0 = a0; B0 = b0; nM0 = m0 / BM; nN0 = n0 / BM; nwg0 = nM0 * nN0; A1 = a1; B1 = b1; nM1 = m1 / BM; nN1 = n1 / BM; nwg1 = nM1 * nN1; K = K_; G = G_; c = c_; }
    __device__ static void map(int wgid, int nM, int nN, int& pm, int& pn) {
        const int nwg = nM * nN; { const int q = nwg / NXCD, r = nwg % NXCD, xcd = wgid % NXCD, off = wgid / NXCD; wgid = (xcd < r ? xcd * (q + 1) : r * (q + 1) + (xcd - r) * q) + off; }
        const int nig = WGM * nN, gid = wgid / nig, fm = gid * WGM, gsz = (nM - fm) < WGM ? (nM - fm) : WGM;
        pm = fm + ((wgid % nig) % gsz); pn = (wgid % nig) / gsz; }
    __device__ bool next(int i, Unit& u) const {
        const int L = i * G + c;
        if (L < nwg0) { map(L, nM0, nN0, u.pm, u.pn); u.sel = 0; return true; }
        if (L < nwg0 + nwg1) { map(L - nwg0, nM1, nN1, u.pm, u.pn); u.sel = 1; return true; }
        return false; }
    __device__ __forceinline__ const char* baseA(const Unit& u) const { return (const char*)(u.sel ? A1 : A0) + (size_t)u.pm * BM * K * 2; }
    __device__ __forceinline__ const char* baseB(const Unit& u) const { return (const char*)(u.sel ? B1 : B0) + (size_t)u.pn * BM * K * 2; }
};

template <class Epi, bool ALIGN_EPI, bool SP2>
__device__ __forceinline__ void gemm_phase(LAS unsigned char* lds, const Sched2& S, const Epi& E) {
    const int tid = threadIdx.x, wid = __builtin_amdgcn_readfirstlane(tid >> 6), lane = tid & 63, wr = wid >> 2, wc = wid & 3, fr = lane & 15, fq = lane >> 4;
    const int K = S.K, nt = K / BK;
    unsigned voffA[2], voffB[2];
#pragma unroll
    for (int i = 0; i < 2; ++i) { int R, C; stage_rc(tid * 16 + i * 8192, R, C); const int Rb = Epi::PERM ? ((R & ~31) + perm32(R & 31)) : R;
        voffA[i] = (unsigned)(R * K + C) * 2u; voffB[i] = (unsigned)(Rb * K + C) * 2u; }
    const size_t kstep = (size_t)(BK * 2);
    const size_t hstep = (size_t)HALF * K * 2;
    const unsigned ldsw = (unsigned)wid * 1024u;
    const int aoff = lds_byte(wr * 64 + fr, fq * 8), boff = lds_byte(wc * 32 + fr, fq * 8);
#define PG8_SA(b, h) (((b) * 2 + (h)) * HTB)
#define PG8_SB(b, h) ((4 + (b) * 2 + (h)) * HTB)
#define PG8_STAGE(bufoff, gbase, voff) do { _Pragma("unroll") for (int _i = 0; _i < 2; ++_i) \
        __builtin_amdgcn_global_load_lds((const unsigned*)((const char*)(gbase) + (voff)[_i]), (LAS unsigned*)(lds + (bufoff) + ldsw + _i * 8192), 16, 0, 0); } while (0)
#define PG8_LDA(dst, b, h) do { _Pragma("unroll") for (int m = 0; m < 4; ++m) _Pragma("unroll") for (int k = 0; k < 2; ++k) dst[m][k] = *(const LAS bf16x8*)(lds + PG8_SA(b, h) + aoff + m * 2048 + k * 1024); } while (0)
#define PG8_LDB(dst, b, h) do { _Pragma("unroll") for (int n = 0; n < 2; ++n) _Pragma("unroll") for (int k = 0; k < 2; ++k) dst[n][k] = *(const LAS bf16x8*)(lds + PG8_SB(b, h) + boff + n * 2048 + k * 1024); } while (0)
#define PG8_MMA(ai, bj, At, Bt) do { __builtin_amdgcn_s_setprio(1); _Pragma("unroll") for (int m = 0; m < 4; ++m) _Pragma("unroll") for (int n = 0; n < 2; ++n) _Pragma("unroll") for (int k = 0; k < 2; ++k) \
        acc[ai][bj][m][n] = __builtin_amdgcn_mfma_f32_16x16x32_bf16(Bt[n][k], At[m][k], acc[ai][bj][m][n], 0, 0, 0); __builtin_amdgcn_s_setprio(0); } while (0)
#define PG8_WAIT_V(n) asm volatile("s_waitcnt vmcnt(" #n ")" ::: "memory")
#define PG8_WAIT_L(n) asm volatile("s_waitcnt lgkmcnt(" #n ")" ::: "memory")
#define PG8_BAR __builtin_amdgcn_s_barrier()
#define PG8_SCHED __builtin_amdgcn_sched_barrier(0)
    Unit cur, nxt; int ui = 0;
    if (!S.next(0, cur)) return;
    f32x4 acc[2][2][4][2];
#pragma unroll
    for (int a = 0; a < 2; ++a)
#pragma unroll
        for (int b = 0; b < 2; ++b)
#pragma unroll
            for (int m = 0; m < 4; ++m)
#pragma unroll
                for (int n = 0; n < 2; ++n) acc[a][b][m][n] = (f32x4){0.f, 0.f, 0.f, 0.f};
    bf16x8 At[4][2], B0[2][2], B1[2][2];
    const char* cA = S.baseA(cur); const char* cB = S.baseB(cur);
    if constexpr (SP2) {
        PG8_STAGE(PG8_SB(0, 0), cB, voffB); PG8_STAGE(PG8_SB(0, 1), cB + hstep, voffB); PG8_STAGE(PG8_SA(0, 0), cA, voffA); PG8_STAGE(PG8_SA(0, 1), cA + hstep, voffA);
        if (wr == 1) PG8_BAR;
        PG8_WAIT_V(2); PG8_BAR;
        PG8_STAGE(PG8_SB(1, 0), cB + kstep, voffB); PG8_STAGE(PG8_SA(1, 0), cA + kstep, voffA); PG8_STAGE(PG8_SB(1, 1), cB + hstep + kstep, voffB);
        PG8_WAIT_V(6); PG8_BAR;
    } else {
        PG8_STAGE(PG8_SB(0, 0), cB, voffB); PG8_STAGE(PG8_SA(0, 0), cA, voffA); PG8_STAGE(PG8_SB(0, 1), cB + hstep, voffB); PG8_STAGE(PG8_SA(0, 1), cA + hstep, voffA);
        if (wr == 1) PG8_BAR;
        PG8_WAIT_V(4); PG8_BAR;
        PG8_STAGE(PG8_SB(1, 0), cB + kstep, voffB); PG8_STAGE(PG8_SA(1, 0), cA + kstep, voffA); PG8_STAGE(PG8_SB(1, 1), cB + hstep + kstep, voffB);
        PG8_WAIT_V(6); PG8_BAR;
    }
    for (;;) {
        const bool has_next = S.next(ui + 1, nxt);
        const char* nA = has_next ? S.baseA(nxt) : cA; const char* nB = has_next ? S.baseB(nxt) : cB;
        for (int t = 0; t < nt; t += 2) {
            const bool last = (t == nt - 2);
            const char* a1 = cA + (size_t)(t + 1) * kstep;
            const char* a2 = last ? nA : cA + (size_t)(t + 2) * kstep; const char* b2 = last ? nB : cB + (size_t)(t + 2) * kstep;
            const char* a3 = a2 + kstep; const char* b3 = b2 + kstep;
            if constexpr (SP2) {
            PG8_LDB(B0, 0, 0); PG8_LDB(B1, 0, 1); PG8_SCHED; PG8_LDA(At, 0, 0); PG8_STAGE(PG8_SA(1, 1), a1 + hstep, voffA);
            PG8_WAIT_V(8); PG8_WAIT_L(0); PG8_BAR; PG8_MMA(0, 0, At, B0); PG8_MMA(0, 1, At, B1); PG8_BAR; PG8_SCHED;
            PG8_LDA(At, 0, 1); PG8_STAGE(PG8_SB(0, 0), b2, voffB); PG8_STAGE(PG8_SB(0, 1), b2 + hstep, voffB); PG8_STAGE(PG8_SA(0, 0), a2, voffA);
            PG8_WAIT_V(8); PG8_WAIT_L(0); PG8_BAR; PG8_MMA(1, 0, At, B0); PG8_MMA(1, 1, At, B1); PG8_BAR; PG8_SCHED;
            PG8_LDB(B0, 1, 0); PG8_LDB(B1, 1, 1); PG8_SCHED; PG8_LDA(At, 1, 0); PG8_STAGE(PG8_SA(0, 1), a2 + hstep, voffA);
            PG8_WAIT_V(8); PG8_WAIT_L(0); PG8_BAR; PG8_MMA(0, 0, At, B0); PG8_MMA(0, 1, At, B1); PG8_BAR; PG8_SCHED;
            PG8_LDA(At, 1, 1); PG8_STAGE(PG8_SB(1, 0), b3, voffB); PG8_STAGE(PG8_SB(1, 1), b3 + hstep, voffB); PG8_STAGE(PG8_SA(1, 0), a3, voffA);
            PG8_WAIT_V(8); PG8_WAIT_L(0); PG8_BAR; PG8_MMA(1, 0, At, B0); PG8_MMA(1, 1, At, B1); PG8_BAR; PG8_SCHED;
            } else {
            PG8_LDB(B0, 0, 0); PG8_SCHED; PG8_LDA(At, 0, 0); PG8_STAGE(PG8_SA(1, 1), a1 + hstep, voffA);
            PG8_WAIT_L(8); PG8_BAR; PG8_WAIT_L(0); PG8_MMA(0, 0, At, B0); PG8_BAR; PG8_SCHED;
            PG8_LDB(B1, 0, 1); PG8_STAGE(PG8_SB(0, 0), b2, voffB);
            PG8_BAR; PG8_WAIT_L(0); PG8_MMA(0, 1, At, B1); PG8_BAR;
            PG8_LDA(At, 0, 1); PG8_STAGE(PG8_SA(0, 0), a2, voffA);
            PG8_BAR; PG8_WAIT_L(0); PG8_MMA(1, 0, At, B0); PG8_BAR; PG8_SCHED;
            PG8_STAGE(PG8_SB(0, 1), b2 + hstep, voffB);
            PG8_WAIT_V(6); PG8_BAR; PG8_MMA(1, 1, At, B1); PG8_BAR;
            PG8_LDB(B0, 1, 0); PG8_SCHED; PG8_LDA(At, 1, 0); PG8_STAGE(PG8_SA(0, 1), a2 + hstep, voffA);
            PG8_WAIT_L(8); PG8_BAR; PG8_WAIT_L(0); PG8_MMA(0, 0, At, B0); PG8_BAR; PG8_SCHED;
            PG8_LDB(B1, 1, 1); PG8_STAGE(PG8_SB(1, 0), b3, voffB);
            PG8_BAR; PG8_WAIT_L(0); PG8_MMA(0, 1, At, B1); PG8_BAR;
            PG8_LDA(At, 1, 1); PG8_STAGE(PG8_SA(1, 0), a3, voffA);
            PG8_BAR; PG8_WAIT_L(0); PG8_MMA(1, 0, At, B0); PG8_BAR; PG8_SCHED;
            PG8_STAGE(PG8_SB(1, 1), b3 + hstep, voffB);
            PG8_WAIT_V(6); PG8_BAR; PG8_MMA(1, 1, At, B1); PG8_BAR;
            }
        }
        if constexpr (ALIGN_EPI) { if (wr == 0) PG8_BAR; }
        E(acc, cur, wr, wc, fr, fq);
        if (!has_next) break;
#pragma unroll
        for (int a = 0; a < 2; ++a)
#pragma unroll
            for (int b = 0; b < 2; ++b)
#pragma unroll
                for (int m = 0; m < 4; ++m)
#pragma unroll
                    for (int n = 0; n < 2; ++n) acc[a][b][m][n] = (f32x4){0.f, 0.f, 0.f, 0.f};
        cur = nxt; cA = nA; cB = nB; ++ui;
        if constexpr (ALIGN_EPI) { if (wr == 1) PG8_BAR; }
    }
    PG8_WAIT_V(0);
    if constexpr (!ALIGN_EPI) { if (wr == 0) PG8_BAR; }
    PG8_BAR;
#undef PG8_SA
#undef PG8_SB
#undef PG8_STAGE
#undef PG8_LDA
#undef PG8_LDB
#undef PG8_MMA
#undef PG8_WAIT_V
#undef PG8_WAIT_L
#undef PG8_BAR
#undef PG8_SCHED
}

struct EpiP1 {
    static constexpr bool PERM = true;
    bf16_t* U;
    __device__ __forceinline__ void operator()(const f32x4 (&acc)[2][2][4][2], const Unit& u, int wr, int wc, int fr, int fq) const {
        const int row0 = u.pm * BM + wr * 64 + fr;
        bf16_t* O = U + (size_t)(u.pn >> 3) * ((size_t)M * D);
        if (u.pn < 24) {
            const bool act = u.pn >= 8;
            const int col0 = (u.pn & 7) * 128 + wc * 32 + 8 * fq;
#pragma unroll
            for (int ai = 0; ai < 2; ++ai)
#pragma unroll
                for (int m = 0; m < 4; ++m) { bf16_t* rowp = O + (size_t)(row0 + ai * HALF + m * 16) * D + col0;
                    f32x4 a0 = acc[ai][0][m][0], a1 = acc[ai][0][m][1], b0 = acc[ai][1][m][0], b1 = acc[ai][1][m][1];
                    if (act) {
#pragma unroll
                        for (int j = 0; j < 4; ++j) { b0[j] = silu_f(b0[j]); b1[j] = silu_f(b1[j]); } }
                    a0 = a0 * b0; a1 = a1 * b1;
                    u32x4 w; w.x = cvt_pk_bf16(a0[0], a0[1]); w.y = cvt_pk_bf16(a0[2], a0[3]); w.z = cvt_pk_bf16(a1[0], a1[1]); w.w = cvt_pk_bf16(a1[2], a1[3]);
                    *(u32x4*)rowp = w; }
        } else {
            const int col0 = (u.pn - 24) * 256 + wc * 32 + 8 * fq;
#pragma unroll
            for (int ai = 0; ai < 2; ++ai)
#pragma unroll
                for (int m = 0; m < 4; ++m) { bf16_t* rowp = O + (size_t)(row0 + ai * HALF + m * 16) * D + col0;
#pragma unroll
                    for (int bj = 0; bj < 2; ++bj) { const f32x4 v0 = acc[ai][bj][m][0], v1 = acc[ai][bj][m][1];
                        u32x4 w; w.x = cvt_pk_bf16(v0[0], v0[1]); w.y = cvt_pk_bf16(v0[2], v0[3]); w.z = cvt_pk_bf16(v1[0], v1[1]); w.w = cvt_pk_bf16(v1[2], v1[3]);
                        *(u32x4*)(rowp + bj * HALF) = w; } }
        }
    }
};
struct EpiP5 {
    static constexpr bool PERM = true;
    bf16_t *Q, *VT; const float *qn, *kn;
    __device__ __forceinline__ void operator()(const f32x4 (&acc)[2][2][4][2], const Unit& u, int wr, int wc, int fr, int fq) const {
        const int row0 = u.pm * BM + wr * 64 + fr;
        if (u.sel == 1) {
            const int col0 = u.pn * BM + wc * 32 + 8 * fq;
#pragma unroll
            for (int ai = 0; ai < 2; ++ai)
#pragma unroll
                for (int m = 0; m < 4; ++m) { bf16_t* rowp = VT + (size_t)(row0 + ai * HALF + m * 16) * M + col0;
#pragma unroll
                    for (int bj = 0; bj < 2; ++bj) { const f32x4 v0 = acc[ai][bj][m][0], v1 = acc[ai][bj][m][1];
                        u32x4 w; w.x = cvt_pk_bf16(v0[0], v0[1]); w.y = cvt_pk_bf16(v0[2], v0[3]); w.z = cvt_pk_bf16(v1[0], v1[1]); w.w = cvt_pk_bf16(v1[2], v1[3]);
                        *(u32x4*)(rowp + bj * HALF) = w; } }
        } else if (u.pn >= 8) {
            const int col0 = (u.pn - 8) * BM + wc * 32 + 8 * fq;
#pragma unroll
            for (int ai = 0; ai < 2; ++ai)
#pragma unroll
                for (int m = 0; m < 4; ++m) { bf16_t* rowp = Q + 2 * (size_t)M * D + (size_t)(row0 + ai * HALF + m * 16) * D + col0;
#pragma unroll
                    for (int bj = 0; bj < 2; ++bj) { f32x4 v0 = acc[ai][bj][m][0], v1 = acc[ai][bj][m][1];
#pragma unroll
                        for (int j = 0; j < 4; ++j) { v0[j] = silu_f(v0[j]); v1[j] = silu_f(v1[j]); }
                        u32x4 w; w.x = cvt_pk_bf16(v0[0], v0[1]); w.y = cvt_pk_bf16(v0[2], v0[3]); w.z = cvt_pk_bf16(v1[0], v1[1]); w.w = cvt_pk_bf16(v1[2], v1[3]);
                        *(u32x4*)(rowp + bj * HALF) = w; } }
        } else {
            const bool isq = u.pn < 4; bf16_t* O = Q + (size_t)(u.pn >> 2) * ((size_t)M * D); const float* nw = qn; if (!isq) nw = kn; const float sc = isq ? (LOG2E * 0.125f) : 1.0f;
            const int col0 = (u.pn & 3) * BM + 64 * wc + 8 * fq;
            f32x4 w4[2][2];
#pragma unroll
            for (int bj = 0; bj < 2; ++bj)
#pragma unroll
                for (int n = 0; n < 2; ++n) w4[bj][n] = *(const f32x4*)(nw + 32 * bj + 8 * fq + 4 * n);
#pragma unroll
            for (int ai = 0; ai < 2; ++ai)
#pragma unroll
                for (int m = 0; m < 4; ++m) {
                    float ss = 0.f;
#pragma unroll
                    for (int bj = 0; bj < 2; ++bj)
#pragma unroll
                        for (int n = 0; n < 2; ++n) { const f32x4 v = acc[ai][bj][m][n]; ss += (v[0] * v[0] + v[1] * v[1]) + (v[2] * v[2] + v[3] * v[3]); }
                    ss += __shfl_xor(ss, 16); ss += __shfl_xor(ss, 32);
                    const float rs = __builtin_amdgcn_rsqf(ss * (1.0f / 64.0f) + EPS) * sc;
                    bf16_t* rowp = O + (size_t)(row0 + ai * HALF + m * 16) * D + col0;
#pragma unroll
                    for (int bj = 0; bj < 2; ++bj) { const f32x4 v0 = acc[ai][bj][m][0] * rs * w4[bj][0], v1 = acc[ai][bj][m][1] * rs * w4[bj][1];
                        u32x4 w; w.x = cvt_pk_bf16(v0[0], v0[1]); w.y = cvt_pk_bf16(v0[2], v0[3]); w.z = cvt_pk_bf16(v1[0], v1[1]); w.w = cvt_pk_bf16(v1[2], v1[3]);
                        *(u32x4*)(rowp + 32 * bj) = w; } }
        }
    }
};
struct EpiRes {
    static constexpr bool PERM = false;
    const float* base; float* out; const float* gate;
    __device__ __forceinline__ void operator()(const f32x4 (&acc)[2][2][4][2], const Unit& u, int wr, int wc, int fr, int fq) const {
        const int row0 = u.pm * BM + wr * 64 + fr, col0 = u.pn * BM + wc * 32 + 4 * fq;
        const float* gp = gate + ((u.pm * BM) / SEQ) * 3072 + col0;
        f32x4 gv[2][2];
#pragma unroll
        for (int bj = 0; bj < 2; ++bj)
#pragma unroll
            for (int n = 0; n < 2; ++n) gv[bj][n] = *(const f32x4*)(gp + bj * HALF + n * 16);
#pragma unroll
        for (int ai = 0; ai < 2; ++ai)
#pragma unroll
            for (int m = 0; m < 4; ++m) { const size_t off = (size_t)(row0 + ai * HALF + m * 16) * D + col0;
#pragma unroll
                for (int bj = 0; bj < 2; ++bj)
#pragma unroll
                    for (int n = 0; n < 2; ++n) { const f32x4 bs = *(const f32x4*)(base + off + bj * HALF + n * 16);
                        *(f32x4*)(out + off + bj * HALF + n * 16) = bs + gv[bj][n] * acc[ai][bj][m][n]; } }
    }
};
}

#define XB_TMO      128
#define XB_XCNT(j)  (256  + 64 * (j))
#define XB_XSUB(j)  (1280 + 64 * (j))
#define XB_XGEN(j)  (2304 + 64 * (j))
#define XB_TOP      3328
#define XB_TOPGEN   3392
#define XCD_BAR_WORDS 3456
#define XB_SPIN_CAP (1u << 18)
__device__ __forceinline__ unsigned xb_ld(unsigned* p)              { return __hip_atomic_load(p, __ATOMIC_RELAXED, __HIP_MEMORY_SCOPE_AGENT); }
__device__ __forceinline__ unsigned xb_add(unsigned* p, unsigned v) { return __hip_atomic_fetch_add(p, v, __ATOMIC_RELAXED, __HIP_MEMORY_SCOPE_AGENT); }
__device__ __forceinline__ unsigned xb_xcc_id() { return (unsigned)__builtin_amdgcn_s_getreg((3 << 11) | 20) & 0xFu; }
#define XB_SPIN(cond, bar) do { unsigned _sp = 0; while (cond) { __builtin_amdgcn_s_sleep(1); \
    if ((++_sp & 255u) == 0u) { if (xb_ld(&(bar)[XB_TMO])) break; if (_sp > XB_SPIN_CAP) { atomicAdd(&(bar)[XB_TMO], 1u); break; } } } } while (0)
struct XcdBarrier { unsigned* bar; unsigned x; volatile LAS unsigned* st; };
__device__ __forceinline__ XcdBarrier xcd_barrier_post(unsigned* bar, volatile LAS unsigned* st) {
    XcdBarrier b; b.bar = bar; b.x = xb_xcc_id(); b.st = st;
    if (threadIdx.x == 0) (void)xb_add(&bar[XB_XCNT(b.x)], 1u);
    return b;
}
__device__ __forceinline__ void xcd_barrier_complete(unsigned* bar, unsigned x, unsigned& nloc, unsigned& nx) {
    const unsigned G = gridDim.x * gridDim.y * gridDim.z;
    unsigned sum, cnt, mine, sp = 0u;
    for (;;) {
        sum = 0u; cnt = 0u; mine = 0u;
#pragma unroll
        for (unsigned j = 0; j < 16; ++j) { const unsigned c = xb_ld(&bar[XB_XCNT(j)]); sum += c; cnt += (c > 0u) ? 1u : 0u; mine = (j == x) ? c : mine; }
        if (sum == G) break;
        __builtin_amdgcn_s_sleep(1);
        if ((++sp & 255u) == 0u) { if (xb_ld(&bar[XB_TMO])) break; if (sp > XB_SPIN_CAP) { atomicAdd(&bar[XB_TMO], 1u); break; } }
    }
    nloc = mine > 0u ? mine : 1u; nx = cnt > 0u ? cnt : 1u;
}
__device__ __forceinline__ void xcd_barrier(const XcdBarrier& b) {
    asm volatile("s_waitcnt vmcnt(0)" ::: "memory");
    __syncthreads();
    if (threadIdx.x == 0) {
        unsigned* bar = b.bar;
        __builtin_amdgcn_s_waitcnt(0);
        unsigned nloc = b.st[0], nx = b.st[1];
        if (nloc == 0u) { xcd_barrier_complete(bar, b.x, nloc, nx); b.st[0] = nloc; b.st[1] = nx; }
        const unsigned old = xb_add(&bar[XB_XSUB(b.x)], 1u);
        const unsigned gen = old / nloc;
        if (old + 1u == (gen + 1u) * nloc) {
            __builtin_amdgcn_fence(__ATOMIC_RELEASE, "agent");
            asm volatile("s_waitcnt vmcnt(0)" ::: "memory");
            const unsigned og = xb_add(&bar[XB_TOP], 1u);
            const unsigned tg = og / nx;
            if (og + 1u == (tg + 1u) * nx) xb_add(&bar[XB_TOPGEN], 1u);
            else XB_SPIN(xb_ld(&bar[XB_TOPGEN]) == tg, bar);
            __builtin_amdgcn_fence(__ATOMIC_ACQUIRE, "agent");
            xb_add(&bar[XB_XGEN(b.x)], 1u);
            asm volatile("s_waitcnt vmcnt(0)" ::: "memory");
        } else {
            XB_SPIN(xb_ld(&bar[XB_XGEN(b.x)]) == gen, bar);
            __builtin_amdgcn_fence(__ATOMIC_ACQUIRE, "agent");
            asm volatile("s_waitcnt vmcnt(0)" ::: "memory");
        }
    }
    __syncthreads();
}

struct Args {
    const float *x, *c, *ln_g, *ada_w, *ada_b, *w_in_ab, *conv_w, *sg_norm, *sg_w, *sg_b, *w_out_ab, *w_in_c, *q_norm, *k_norm, *w_out_c;
    float* out; unsigned char* ws; int ph_lo, ph_hi;
};

__device__ __forceinline__ int ab_row(int c) {
    const int seg = c >> 10, cc = c & 1023, t = cc >> 7, r = cc & 127;
    switch (seg) {
        case 1: return 256 * t + r;
        case 2: return 256 * t + 128 + r;
        case 0: return 256 * (8 + t) + r;
        case 3: return 256 * (8 + t) + 128 + r;
        case 4: return 256 * (16 + t) + r;
        case 6: return 256 * (16 + t) + 128 + r;
        default: return 256 * 24 + cc;
    }
}
__device__ __forceinline__ int c_row(int c) {
    const int seg = c >> 10, cc = c & 1023;
    if (seg == 2) return 3072 + cc;
    if (seg == 3) return 2048 + cc;
    const int tile = cc >> 8, ct = cc & 255, hh = ct >> 6, bj = (ct >> 5) & 1, i = ct & 31;
    return seg * 1024 + tile * 256 + 128 * bj + 32 * hh + i;
}
template <int MODE>
__device__ __forceinline__ void p0_transpose_item(const float* W, int K, int N, bf16_t* WT, LAS float* scr, int item, int lane) {
    const int nblk = N / 32, kb = item / nblk, nb = item % nblk, k0 = 64 * kb, n0 = 32 * nb;
    const int rb = MODE == 1 ? ab_row(n0) : (MODE == 2 ? c_row(n0) : n0);
#pragma unroll 8
    for (int i = 0; i < 32; ++i) { const int kk = 2 * i + (lane >> 5); scr[kk * 33 + (lane & 31)] = W[(size_t)(k0 + kk) * N + n0 + (lane & 31)]; }
    asm volatile("s_waitcnt lgkmcnt(0)" ::: "memory");
    const int c = lane & 7;
#pragma unroll
    for (int j = 0; j < 4; ++j) { const int n = (lane >> 3) + 8 * j; const LAS float* s = scr + (8 * c) * 33 + n;
        u32x4 o; o.x = cvt_pk_bf16(s[0 * 33], s[1 * 33]); o.y = cvt_pk_bf16(s[2 * 33], s[3 * 33]); o.z = cvt_pk_bf16(s[4 * 33], s[5 * 33]); o.w = cvt_pk_bf16(s[6 * 33], s[7 * 33]);
        *(u32x4*)(WT + (size_t)(rb + n) * K + k0 + 8 * c) = o; }
    asm volatile("s_waitcnt lgkmcnt(0)" ::: "memory");
}

__device__ __forceinline__ float wave_sum(float v) {
#pragma unroll
    for (int o = 1; o < 64; o <<= 1) v += __shfl_xor(v, o);
    return v;
}
__device__ __forceinline__ void rms_phase(const float* X, const float* g, const float* mod  , bf16_t* H, int gw, int NGW, int lane) {
    for (int b = 0; b < BATCH; ++b) {
        f32x4 mul[4], sh[4];
#pragma unroll
        for (int j = 0; j < 4; ++j) { const int col = 4 * lane + 256 * j; const f32x4 gg = *(const f32x4*)(g + col), sc = *(const f32x4*)(mod + b * 3072 + 1024 + col);
            sh[j] = *(const f32x4*)(mod + b * 3072 + col); mul[j] = gg * (sc + 1.0f); }
        for (int r = gw; r < SEQ; r += NGW) {
            const size_t m = (size_t)b * SEQ + r;
            const f32x4* xr = (const f32x4*)(X + m * D) + lane;
            f32x4 v[4]; float s = 0.f;
#pragma unroll
            for (int j = 0; j < 4; ++j) { v[j] = xr[64 * j]; s += (v[j].x * v[j].x + v[j].y * v[j].y) + (v[j].z * v[j].z + v[j].w * v[j].w); }
            const float rstd = __builtin_amdgcn_rsqf(wave_sum(s) * (1.f / D) + EPS);
            u32x2* o8 = (u32x2*)(H + m * D) + lane;
#pragma unroll
            for (int j = 0; j < 4; ++j) { const f32x4 o = v[j] * rstd * mul[j] + sh[j]; u32x2 w; w.x = cvt_pk_bf16(o.x, o.y); w.y = cvt_pk_bf16(o.z, o.w); o8[64 * j] = w; }
        }
    }
}

__device__ __forceinline__ void mixer_phase(LAS unsigned char* lds, const bf16_t* U, const bf16_t* Gt, const bf16_t* UZ, const bf16_t* V, const float* conv_w, const float* sg_norm,
                                            const float* sg_w, const float* sg_b, bf16_t* Y, int vcu, int G) {
    const int tid = threadIdx.x, lane = tid & 63, w = __builtin_amdgcn_readfirstlane(tid >> 6), fr = lane & 15, fq = lane >> 4;
    constexpr int PT = 136;
    LAS bf16_t* VNT = (LAS bf16_t*)lds;
    LAS bf16_t* WL = (LAS bf16_t*)(lds + 128 * PT * 2);
    LAS float* SG = (LAS float*)lds;
    for (int unit = vcu; unit < BATCH * 64 * 8; unit += G) {
        const int g = unit & 7, cch = (unit >> 3) & 63, b = unit >> 9; const size_t r0 = (size_t)b * SEQ + cch * 128;
        { const int c8 = tid & 15, rg = tid >> 4, ch = 128 * g + 8 * c8; const size_t row = r0 + 4 * rg;
          float cw[3][8];
#pragma unroll
          for (int k = 0; k < 3; ++k) { const f32x4 a = *(const f32x4*)(conv_w + k * D + ch), bq = *(const f32x4*)(conv_w + k * D + ch + 4);
              cw[k][0] = a.x; cw[k][1] = a.y; cw[k][2] = a.z; cw[k][3] = a.w; cw[k][4] = bq.x; cw[k][5] = bq.y; cw[k][6] = bq.z; cw[k][7] = bq.w; }
          u32x4 ur[6];
          const bool halo0 = (cch == 0 && rg == 0);
#pragma unroll
          for (int i = 0; i < 6; ++i) { if (i < 2 && halo0) ur[i] = (u32x4){0u, 0u, 0u, 0u}; else ur[i] = *(const u32x4*)(U + (row + i - 2) * D + ch); }
#pragma unroll
          for (int i = 0; i < 4; ++i) { const u32x4 gv = *(const u32x4*)(Gt + (row + i) * D + ch); float o[8];
#pragma unroll
              for (int p = 0; p < 4; ++p) { const unsigned u0 = ur[i][p], u1 = ur[i + 1][p], u2 = ur[i + 2][p];
                  o[2 * p] = bf_lo(gv[p]) * (cw[0][2 * p] * bf_lo(u0) + cw[1][2 * p] * bf_lo(u1) + cw[2][2 * p] * bf_lo(u2));
                  o[2 * p + 1] = bf_hi(gv[p]) * (cw[0][2 * p + 1] * bf_hi(u0) + cw[1][2 * p + 1] * bf_hi(u1) + cw[2][2 * p + 1] * bf_hi(u2)); }
              u32x4 wv; wv.x = cvt_pk_bf16(o[0], o[1]); wv.y = cvt_pk_bf16(o[2], o[3]); wv.z = cvt_pk_bf16(o[4], o[5]); wv.w = cvt_pk_bf16(o[6], o[7]);
              *(u32x4*)(Y + (row + i) * 2048 + ch) = wv; }
        }
        { const int s = tid >> 2, qd = tid & 3; const bf16_t* vp = V + (r0 + s) * D + 128 * g + 32 * qd;
          float v[32]; float ss = 0.f;
#pragma unroll
          for (int i = 0; i < 4; ++i) { const u32x4 t = *(const u32x4*)(vp + 8 * i);
#pragma unroll
              for (int p = 0; p < 4; ++p) { v[8 * i + 2 * p] = bf_lo(t[p]); v[8 * i + 2 * p + 1] = bf_hi(t[p]); } }
#pragma unroll
          for (int i = 0; i < 32; ++i) ss += v[i] * v[i];
          ss += __shfl_xor(ss, 1); ss += __shfl_xor(ss, 2);
          const float rs = __builtin_amdgcn_rsqf(ss * (1.0f / 128.0f) + EPS);
          const float* nw = sg_norm + g * 128 + 32 * qd;
#pragma unroll
          for (int i = 0; i < 32; i += 2) { const unsigned pk = cvt_pk_bf16(v[i] * rs * nw[i], v[i + 1] * rs * nw[i + 1]);
              VNT[(32 * qd + i) * PT + s] = (bf16_t)(pk & 0xffffu); VNT[(32 * qd + i + 1) * PT + s] = (bf16_t)(pk >> 16); }
          const int t = tid >> 2, sq = tid & 3; const float* wp = sg_w + ((size_t)g * 128 + t) * 128 + 32 * sq;
#pragma unroll
          for (int i = 0; i < 4; ++i) { f32x4 a = *(const f32x4*)(wp + 8 * i), bq = *(const f32x4*)(wp + 8 * i + 4); const int s0 = 32 * sq + 8 * i;
              float e[8] = {a.x, a.y, a.z, a.w, bq.x, bq.y, bq.z, bq.w};
#pragma unroll
              for (int p = 0; p < 8; ++p) if (s0 + p > t) e[p] = 0.f;
              u32x4 wv; wv.x = cvt_pk_bf16(e[0], e[1]); wv.y = cvt_pk_bf16(e[2], e[3]); wv.z = cvt_pk_bf16(e[4], e[5]); wv.w = cvt_pk_bf16(e[6], e[7]);
              *(LAS u32x4*)(WL + t * PT + s0) = wv; }
        }
        __syncthreads();
        f32x4 acc[8];
#pragma unroll
        for (int tt = 0; tt < 8; ++tt) acc[tt] = (f32x4){0.f, 0.f, 0.f, 0.f};
#pragma unroll
        for (int ks = 0; ks < 4; ++ks) { const bf16x8 a = *(const LAS bf16x8*)(VNT + (16 * w + fr) * PT + 32 * ks + 8 * fq);
#pragma unroll
            for (int tt = 2 * ks; tt < 8; ++tt) { const bf16x8 bw = *(const LAS bf16x8*)(WL + (16 * tt + fr) * PT + 32 * ks + 8 * fq);
                acc[tt] = __builtin_amdgcn_mfma_f32_16x16x32_bf16(a, bw, acc[tt], 0, 0, 0); } }
        __syncthreads();
#pragma unroll
        for (int tt = 0; tt < 8; ++tt) { const int t = 16 * tt + fr; const float bb = sg_b[g * 128 + t];
            *(LAS f32x4*)(SG + t * 132 + 16 * w + 4 * fq) = acc[tt] + bb; }
        __syncthreads();
        { const int rr = tid >> 2, dq = tid & 3; const bf16_t* up = UZ + (r0 + rr) * D + 128 * g + 32 * dq; bf16_t* yp = Y + (r0 + rr) * 2048 + 1024 + 128 * g + 32 * dq;
#pragma unroll
          for (int i = 0; i < 4; ++i) { const u32x4 uz = *(const u32x4*)(up + 8 * i); const f32x4 s0 = *(const LAS f32x4*)(SG + rr * 132 + 32 * dq + 8 * i), s1 = *(const LAS f32x4*)(SG + rr * 132 + 32 * dq + 8 * i + 4);
              u32x4 wv; wv.x = cvt_pk_bf16(bf_lo(uz.x) * s0.x, bf_hi(uz.x) * s0.y); wv.y = cvt_pk_bf16(bf_lo(uz.y) * s0.z, bf_hi(uz.y) * s0.w);
              wv.z = cvt_pk_bf16(bf_lo(uz.z) * s1.x, bf_hi(uz.z) * s1.y); wv.w = cvt_pk_bf16(bf_lo(uz.w) * s1.z, bf_hi(uz.w) * s1.w);
              *(u32x4*)(yp + 8 * i) = wv; }
        }
        __syncthreads();
    }
}

__device__ __forceinline__ int crow(int i, int hi) { return (i & 3) + 8 * (i >> 2) + 4 * hi; }
__device__ __forceinline__ void attn_load_k(bf16x8 (&kf)[4], bool in_lds, LAS unsigned char* KL, int kl0, const bf16_t* kg, int ql, int hi) {
    if (in_lds) { const int r = kl0 + ql; LAS unsigned char* rp = KL + r * 128; const int sw = (r >> 1) & 7;
#pragma unroll
        for (int kk = 0; kk < 4; ++kk) kf[kk] = *(const LAS bf16x8*)(rp + (((2 * kk + hi) ^ sw) << 4));
    } else {
#pragma unroll
        for (int kk = 0; kk < 4; ++kk) kf[kk] = *(const bf16x8*)(kg + 16 * kk);
    }
}
__device__ __forceinline__ void attn_phase(LAS unsigned char* lds, const bf16_t* Q, const bf16_t* Kb, const bf16_t* VT, const bf16_t* Zs, bf16_t* OZ, int vcu, int G) {
    const int tid = threadIdx.x, lane = tid & 63, w = __builtin_amdgcn_readfirstlane(tid >> 6), ql = lane & 31, hi = lane >> 5;
    constexpr float STOP = 5.421010862427522e-20f;
    LAS unsigned char* KL = lds;
    LAS unsigned char* VL = lds + 65536;
    for (int unit = vcu; unit < BATCH * 16 * (SEQ / 256); unit += G) {
        const int qblk = unit & 31, h = (unit >> 5) & 15, b = unit >> 9;
        const size_t rowbase = (size_t)b * SEQ; const int q0b = 256 * qblk, kw0 = q0b >= 256 ? q0b - 256 : 0, nk = q0b + 256 - kw0;
#pragma unroll
        for (int i = 0; i < 8; ++i) { const int idx = tid + NTHR * i, r = idx >> 3, c = idx & 7;
            if (r < nk) { const u32x4 v = *(const u32x4*)(Kb + (rowbase + kw0 + r) * D + h * 64 + 8 * c); *(LAS u32x4*)(KL + r * 128 + ((c ^ ((r >> 1) & 7)) << 4)) = v; } }
#pragma unroll
        for (int i = 0; i < 8; ++i) { const int idx = tid + NTHR * i, d = idx >> 6, ch = idx & 63;
            if (8 * ch < nk) { u32x4 v = *(const u32x4*)(VT + (size_t)(h * 64 + d) * M + rowbase + kw0 + 8 * ch); const int gp = (2 * ch) ^ (d & 31);
                if (d & 1) { const u32x4 t = v; v.x = t.z; v.y = t.w; v.z = t.x; v.w = t.y; }
                *(LAS u32x4*)(VL + d * 1024 + ((gp & ~1) << 3)) = v; } }
        __syncthreads();
        const int qb = 8 * qblk + w, q0 = 32 * qb;
        bf16x8 qf[4];
        { const bf16_t* qp = Q + (rowbase + q0 + ql) * D + h * 64 + 8 * hi;
#pragma unroll
          for (int kk = 0; kk < 4; ++kk) qf[kk] = *(const bf16x8*)(qp + 16 * kk); }
        f32x16 o0, o1;
#pragma unroll
        for (int i = 0; i < 16; ++i) { o0[i] = 0.f; o1[i] = 0.f; }
        float carry = 1.f;
        bf16x8 kf[4];
        attn_load_k(kf, true, KL, q0 - kw0, nullptr, ql, hi);
        for (int kt = qb; kt >= 0; --kt) {
            const int key0 = 32 * kt; const bool in_lds = key0 >= kw0;
            u32x2 vf[2][2][2];
            if (in_lds) { const int g0 = ((key0 - kw0) >> 2) + hi;
#pragma unroll
                for (int dh = 0; dh < 2; ++dh) { LAS unsigned char* rp = VL + (32 * dh + ql) * 1024;
#pragma unroll
                    for (int s = 0; s < 2; ++s) { vf[dh][s][0] = *(const LAS u32x2*)(rp + (((g0 + 4 * s) ^ ql) << 3)); vf[dh][s][1] = *(const LAS u32x2*)(rp + (((g0 + 4 * s + 2) ^ ql) << 3)); } }
            } else { const bf16_t* vp = VT + (size_t)(h * 64 + ql) * M + rowbase + key0 + 4 * hi;
#pragma unroll
                for (int dh = 0; dh < 2; ++dh)
#pragma unroll
                    for (int s = 0; s < 2; ++s) { vf[dh][s][0] = *(const u32x2*)(vp + (size_t)dh * 32 * M + 16 * s); vf[dh][s][1] = *(const u32x2*)(vp + (size_t)dh * 32 * M + 16 * s + 8); } }
            bf16x8 kn[4];
            { const int kt2 = kt > 0 ? kt - 1 : 0; attn_load_k(kn, 32 * kt2 >= kw0, KL, 32 * kt2 - kw0, Kb + (rowbase + 32 * kt2 + ql) * D + h * 64 + 8 * hi, ql, hi); }
            f32x16 S;
#pragma unroll
            for (int i = 0; i < 16; ++i) S[i] = 0.f;
#pragma unroll
            for (int kk = 0; kk < 4; ++kk) S = __builtin_amdgcn_mfma_f32_32x32x16_bf16(kf[kk], qf[kk], S, 0, 0, 0);
            float be[16], om[16];
            const bool diag = (kt == qb);
#pragma unroll
            for (int i = 0; i < 16; ++i) { const float zc = __builtin_fmaxf(S[i], -126.0f); const float E = fast_exp2(-zc); float bv = fast_rcp(1.0f + E); float ov = E * bv;
                if (diag) { const bool valid = crow(i, hi) < ql; bv = valid ? bv : 0.f; ov = valid ? ov : 1.f; }
                be[i] = bv; om[i] = ov; }
            float gs[4], pg[4];
#pragma unroll
            for (int gi = 0; gi < 4; ++gi) { gs[gi] = (om[4 * gi] * om[4 * gi + 1]) * (om[4 * gi + 2] * om[4 * gi + 3]); pg[gi] = __shfl_xor(gs[gi], 32); }
            float run = carry; float wv[16];
#pragma unroll
            for (int gi = 3; gi >= 0; --gi) { const float base = hi == 0 ? run * pg[gi] : run;
                const float s3 = base, s2 = s3 * om[4 * gi + 3], s1 = s2 * om[4 * gi + 2], s0 = s1 * om[4 * gi + 1];
                wv[4 * gi + 3] = be[4 * gi + 3] * s3; wv[4 * gi + 2] = be[4 * gi + 2] * s2; wv[4 * gi + 1] = be[4 * gi + 1] * s1; wv[4 * gi] = be[4 * gi] * s0;
                run *= gs[gi] * pg[gi]; }
            carry = run;
#pragma unroll
            for (int s = 0; s < 2; ++s) { u32x4 pk; pk.x = cvt_pk_bf16(wv[8 * s], wv[8 * s + 1]); pk.y = cvt_pk_bf16(wv[8 * s + 2], wv[8 * s + 3]); pk.z = cvt_pk_bf16(wv[8 * s + 4], wv[8 * s + 5]); pk.w = cvt_pk_bf16(wv[8 * s + 6], wv[8 * s + 7]);
                const bf16x8 pf = __builtin_bit_cast(bf16x8, pk);
                { u32x4 a; a.x = vf[0][s][0].x; a.y = vf[0][s][0].y; a.z = vf[0][s][1].x; a.w = vf[0][s][1].y; o0 = __builtin_amdgcn_mfma_f32_32x32x16_bf16(__builtin_bit_cast(bf16x8, a), pf, o0, 0, 0, 0); }
                { u32x4 a; a.x = vf[1][s][0].x; a.y = vf[1][s][0].y; a.z = vf[1][s][1].x; a.w = vf[1][s][1].y; o1 = __builtin_amdgcn_mfma_f32_32x32x16_bf16(__builtin_bit_cast(bf16x8, a), pf, o1, 0, 0, 0); } }
#pragma unroll
            for (int kk = 0; kk < 4; ++kk) kf[kk] = kn[kk];
            if (__all(carry < STOP)) break;
        }
        const bf16_t* zp = Zs + (rowbase + q0 + ql) * D + h * 64 + 4 * hi; bf16_t* op = OZ + (rowbase + q0 + ql) * D + h * 64 + 4 * hi;
#pragma unroll
        for (int g4 = 0; g4 < 4; ++g4) {
            { const u32x2 zz = *(const u32x2*)(zp + 8 * g4); u32x2 wo; wo.x = cvt_pk_bf16(o0[4 * g4] * bf_lo(zz.x), o0[4 * g4 + 1] * bf_hi(zz.x)); wo.y = cvt_pk_bf16(o0[4 * g4 + 2] * bf_lo(zz.y), o0[4 * g4 + 3] * bf_hi(zz.y)); *(u32x2*)(op + 8 * g4) = wo; }
            { const u32x2 zz = *(const u32x2*)(zp + 32 + 8 * g4); u32x2 wo; wo.x = cvt_pk_bf16(o1[4 * g4] * bf_lo(zz.x), o1[4 * g4 + 1] * bf_hi(zz.x)); wo.y = cvt_pk_bf16(o1[4 * g4 + 2] * bf_lo(zz.y), o1[4 * g4 + 3] * bf_hi(zz.y)); *(u32x2*)(op + 32 + 8 * g4) = wo; }
        }
        __syncthreads();
    }
}

constexpr int N_PHASES = 9;
__global__ void __launch_bounds__(NTHR, 2) hybrid_fwd(Args a) {
    extern __shared__ __attribute__((aligned(16))) unsigned char lds_raw[];
    LAS unsigned char* lds = (LAS unsigned char*)lds_raw;
    const int tid = threadIdx.x, lane = tid & 63, wave = __builtin_amdgcn_readfirstlane(tid >> 6);
    const int G = gridDim.x, bx = blockIdx.x;
    const int vcu = (G % 8 == 0) ? (bx % 8) * (G / 8) + bx / 8 : bx;
    const int gw = vcu * NWAVES + wave, NGW = G * NWAVES;
    unsigned char* ws = a.ws;
    float* MOD = (float*)(ws + WS_MOD);
    bf16_t* WAB = (bf16_t*)(ws + WS_WAB); bf16_t* WOAB = (bf16_t*)(ws + WS_WOAB); bf16_t* WC = (bf16_t*)(ws + WS_WC); bf16_t* WOC = (bf16_t*)(ws + WS_WOC);
    bf16_t* H0 = (bf16_t*)(ws + WS_H0); bf16_t* Y = (bf16_t*)(ws + WS_Y);
    bf16_t* Ub = (bf16_t*)(ws + WS_U); bf16_t* Gb = (bf16_t*)(ws + WS_G); bf16_t* UZb = (bf16_t*)(ws + WS_UZ); bf16_t* Vb = (bf16_t*)(ws + WS_V);
    float* X1 = (float*)(ws + WS_X1); bf16_t* H1 = (bf16_t*)(ws + WS_H1);
    bf16_t* Qb = (bf16_t*)(ws + WS_Q); bf16_t* Kb = (bf16_t*)(ws + WS_K); bf16_t* Zb = (bf16_t*)(ws + WS_Z); bf16_t* VTb = (bf16_t*)(ws + WS_VT); bf16_t* OZb = (bf16_t*)(ws + WS_OZ);
    const int lo = a.ph_lo, hi = a.ph_hi;
#define IN(k) (lo <= (k) && (k) < hi)
    volatile LAS unsigned* bst = (volatile LAS unsigned*)(lds + 131072 + 320);
    if (tid < 4) bst[tid] = 0u;
    __syncthreads();
    XcdBarrier xbar; xbar.bar = (unsigned*)(ws + WS_CTL); xbar.x = 0; xbar.st = bst;
    if (hi - lo > 1) xbar = xcd_barrier_post((unsigned*)(ws + WS_CTL), bst);
#define SEAM(k) do { if (IN(k) && IN((k) + 1)) { if ((k) == 0) { asm volatile("s_waitcnt vmcnt(0)" ::: "memory"); __syncthreads(); cg::this_grid().sync(); \
        __builtin_amdgcn_fence(__ATOMIC_ACQUIRE, "agent"); asm volatile("s_waitcnt vmcnt(0)" ::: "memory"); __syncthreads(); } else xcd_barrier(xbar); } } while (0)

    if (IN(0)) {
        for (int task = bx; task < 192; task += G) {
            LAS float* sc_l = (LAS float*)lds; LAS float* red = sc_l + 2048;
            for (int i = tid; i < BATCH * D; i += NTHR) { const float v = a.c[i]; sc_l[i] = v / (1.0f + __expf(-v)); }
            __syncthreads();
            const int l = task / 96, n0 = (task % 96) * 32, kc = wave * 2 + (lane >> 5), n = n0 + (lane & 31);
            const float* W = a.ada_w + (size_t)l * D * 3072 + (size_t)(kc * 64) * 3072 + n;
            float a0 = 0.f, a1 = 0.f;
#pragma unroll 16
            for (int k = 0; k < 64; ++k) { const float wv = W[(size_t)k * 3072]; a0 += sc_l[kc * 64 + k] * wv; a1 += sc_l[D + kc * 64 + k] * wv; }
            red[(kc * 2 + 0) * 32 + (lane & 31)] = a0; red[(kc * 2 + 1) * 32 + (lane & 31)] = a1;
            __syncthreads();
            if (tid < 64) { const int b = tid >> 5, nn = tid & 31; float s = 0.f;
#pragma unroll
                for (int k = 0; k < 16; ++k) s += red[(k * 2 + b) * 32 + nn];
                MOD[(l * 2 + b) * 3072 + n0 + nn] = s + a.ada_b[l * 3072 + n0 + nn]; }
            __syncthreads();
        }
        LAS float* scr = (LAS float*)(lds + wave * 16384);
        constexpr int I_AB = (D / 64) * (IN_AB / 32), I_OAB = (2048 / 64) * (D / 32), I_C = (D / 64) * (IN_C / 32), I_OC = (D / 64) * (D / 32);
        for (int it = gw; it < I_AB + I_OAB + I_C + I_OC; it += NGW) {
            int r = it;
            if (r < I_AB) { p0_transpose_item<1>(a.w_in_ab, D, IN_AB, WAB, scr, r, lane); continue; } r -= I_AB;
            if (r < I_OAB) { p0_transpose_item<0>(a.w_out_ab, 2048, D, WOAB, scr, r, lane); continue; } r -= I_OAB;
            if (r < I_C) { p0_transpose_item<2>(a.w_in_c, D, IN_C, WC, scr, r, lane); continue; } r -= I_C;
            p0_transpose_item<0>(a.w_out_c, D, D, WOC, scr, r, lane);
        }
    }
    SEAM(0);
    if (IN(1)) rms_phase(a.x, a.ln_g, MOD, H0, gw, NGW, lane);
    SEAM(1);
    if (IN(2)) { pg8::Sched2 S; S.init(H0, WAB, M, IN_AB, nullptr, nullptr, 0, 0, D, G, bx);
        pg8::EpiP1 E{Ub}; pg8::gemm_phase<pg8::EpiP1, true, true>(lds, S, E); }
    SEAM(2);
    if (IN(3)) mixer_phase(lds, Ub, Gb, UZb, Vb, a.conv_w, a.sg_norm, a.sg_w, a.sg_b, Y, vcu, G);
    SEAM(3);
    if (IN(4)) { pg8::Sched2 S; S.init(Y, WOAB, M, D, nullptr, nullptr, 0, 0, 2048, G, bx);
        pg8::EpiRes E{a.x, X1, MOD + 2048}; pg8::gemm_phase<pg8::EpiRes, true, true>(lds, S, E); }
    SEAM(4);
    if (IN(5)) rms_phase(X1, a.ln_g + D, MOD + 2 * 3072, H1, gw, NGW, lane);
    SEAM(5);
    if (IN(6)) { pg8::Sched2 S; S.init(H1, WC, M, 3072, WC + (size_t)3072 * D, H1, D, M, D, G, bx);
        pg8::EpiP5 E{Qb, VTb, a.q_norm, a.k_norm}; pg8::gemm_phase<pg8::EpiP5, true, true>(lds, S, E); }
    SEAM(6);
    if (IN(7)) attn_phase(lds, Qb, Kb, VTb, Zb, OZb, vcu, G);
    SEAM(7);
    if (IN(8)) { pg8::Sched2 S; S.init(OZb, WOC, M, D, nullptr, nullptr, 0, 0, D, G, bx);
        pg8::EpiRes E{X1, a.out, MOD + 2 * 3072 + 2048}; pg8::gemm_phase<pg8::EpiRes, true, true>(lds, S, E); }
#undef IN
#undef SEAM
}

extern "C" void kernel_launch(void* const* d_in, const int* in_sizes, int n_in, void* d_out, int out_size, void* d_ws, size_t ws_size, hipStream_t stream) {
    static int grid = 0;
    if (grid == 0) {
        if (n_in != 15 || in_sizes[0] != M * D || out_size != M * D || ws_size < WS_END) { fprintf(stderr, "kernel_launch: unexpected problem geometry (n_in %d, ws %zu)\n", n_in, ws_size); grid = -1; return; }
        int dev = 0, cus = 0, per_cu = 0;
        (void)hipGetDevice(&dev); (void)hipDeviceGetAttribute(&cus, hipDeviceAttributeMultiprocessorCount, dev);
        if (hipFuncSetAttribute((const void*)hybrid_fwd, hipFuncAttributeMaxDynamicSharedMemorySize, LDS_BYTES) != hipSuccess) { fprintf(stderr, "kernel_launch: hipFuncSetAttribute failed\n"); grid = -1; return; }
        if (hipOccupancyMaxActiveBlocksPerMultiprocessor(&per_cu, (const void*)hybrid_fwd, NTHR, LDS_BYTES) != hipSuccess || per_cu < 1) { fprintf(stderr, "kernel_launch: occupancy query says %d\n", per_cu); per_cu = 1; }
        (void)hipGetLastError();
        grid = cus * per_cu;
    }
    if (grid < 0) return;
    Args a{};
    a.x = (const float*)d_in[0]; a.c = (const float*)d_in[1]; a.ln_g = (const float*)d_in[2]; a.ada_w = (const float*)d_in[3]; a.ada_b = (const float*)d_in[4];
    a.w_in_ab = (const float*)d_in[5]; a.conv_w = (const float*)d_in[6]; a.sg_norm = (const float*)d_in[7]; a.sg_w = (const float*)d_in[8]; a.sg_b = (const float*)d_in[9];
    a.w_out_ab = (const float*)d_in[10]; a.w_in_c = (const float*)d_in[11]; a.q_norm = (const float*)d_in[12]; a.k_norm = (const float*)d_in[13]; a.w_out_c = (const float*)d_in[14];
    a.out = (float*)d_out; a.ws = (unsigned char*)d_ws;
#if MK_MULTI
    for (int p = 0; p < N_PHASES; ++p) { a.ph_lo = p; a.ph_hi = p + 1; hipLaunchKernelGGL(hybrid_fwd, dim3(grid), dim3(NTHR), LDS_BYTES, stream, a); }
#else
    a.ph_lo = 0; a.ph_hi = N_PHASES;
    (void)hipMemsetAsync((char*)d_ws + WS_CTL, 0, CTL_ZERO_BYTES, stream);
    void* args[] = {&a};
    hipError_t e = hipLaunchCooperativeKernel((const void*)hybrid_fwd, dim3(grid), dim3(NTHR), args, LDS_BYTES, stream);
    if (e != hipSuccess) fprintf(stderr, "kernel_launch: cooperative launch failed: %s (grid %d)\n", hipGetErrorString(e), grid);
#endif
}
```

```cpp
#include <hip/hip_runtime.h>
#include <hip/hip_cooperative_groups.h>
#include <cstdio>
#include <cstdint>
namespace cg = cooperative_groups;

#ifndef MK_MULTI
#define MK_MULTI 0
#endif

#define LAS __attribute__((address_space(3)))
typedef unsigned short bf16_t;
typedef short bf16x8 __attribute__((ext_vector_type(8)));
typedef float f32x4 __attribute__((ext_vector_type(4)));
typedef float f32x16 __attribute__((ext_vector_type(16)));
typedef unsigned u32x4 __attribute__((ext_vector_type(4)));
typedef unsigned u32x2 __attribute__((ext_vector_type(2)));

constexpr int BATCH = 2, SEQ = 8192, D = 1024, M = BATCH * SEQ;
constexpr int IN_AB = 7168, IN_C = 4096;
constexpr float EPS = 1e-6f;
constexpr int NWAVES = 8, NTHR = 512;
constexpr float LOG2E = 1.4426950408889634f;

constexpr size_t MiB = 1u << 20;
constexpr size_t WS_CTL = 0, CTL_ZERO_BYTES = 64 * 1024;
constexpr size_t WS_MOD = 1 * MiB;
constexpr size_t WS_WAB = 2 * MiB;
constexpr size_t WS_WOAB = 16 * MiB;
constexpr size_t WS_WC = 20 * MiB;
constexpr size_t WS_WOC = 28 * MiB;
constexpr size_t WS_U = 32 * MiB, WS_G = 64 * MiB, WS_UZ = 96 * MiB, WS_V = 128 * MiB;
constexpr size_t WS_H0 = 160 * MiB;
constexpr size_t WS_Y = 160 * MiB;
constexpr size_t WS_X1 = 32 * MiB;
constexpr size_t WS_H1 = 96 * MiB;
constexpr size_t WS_Q = 128 * MiB, WS_K = 160 * MiB, WS_Z = 192 * MiB, WS_VT = 224 * MiB;
constexpr size_t WS_OZ = 96 * MiB;
constexpr size_t WS_END = 256 * MiB;
static_assert(WS_G - WS_U == (size_t)M * D * 2 && WS_UZ - WS_G == (size_t)M * D * 2 && WS_V - WS_UZ == (size_t)M * D * 2 && WS_K - WS_Q == (size_t)M * D * 2 && WS_Z - WS_K == (size_t)M * D * 2, "contiguous activations");

constexpr int LDS_BYTES = 147456;

typedef float f32x2_t __attribute__((ext_vector_type(2))); typedef __bf16 bf16x2_t __attribute__((ext_vector_type(2)));
__device__ __forceinline__ unsigned cvt_pk_bf16(float lo, float hi) { f32x2_t v = {lo, hi}; bf16x2_t b = __builtin_convertvector(v, bf16x2_t); return __builtin_bit_cast(unsigned, b); }
__device__ __forceinline__ float bf_lo(unsigned u) { return __uint_as_float(u << 16); }
__device__ __forceinline__ float bf_hi(unsigned u) { return __uint_as_float(u & 0xffff0000u); }
__device__ __forceinline__ float fast_exp2(float x) { return __builtin_amdgcn_exp2f(x); }
__device__ __forceinline__ float fast_log2(float x) { return __builtin_amdgcn_logf(x); }
__device__ __forceinline__ float fast_rcp(float x) { return __builtin_amdgcn_rcpf(x); }
__device__ __forceinline__ float silu_f(float v) { return v * fast_rcp(1.0f + fast_exp2(-LOG2E * v)); }

namespace pg8 {
constexpr int BM = 256, BK = 64, HALF = 128, HTB = HALF * BK * 2, STAGE_BYTES = 8 * HTB, NXCD = 8, WGM = 8;
__host__ __device__ __forceinline__ int lds_byte(int r, int c) { const int st = (r >> 4) * 2 + (c >> 5), rr = r & 15, cc = c & 31, ob = rr * 64 + cc * 2; return st * 1024 + (ob ^ (((ob >> 9) & 1) << 5)); }
__host__ __device__ __forceinline__ void stage_rc(int b, int& R, int& C) { const int st = b / 1024, sb = b % 1024, swz = sb ^ (((sb >> 9) & 1) << 5); R = (st >> 1) * 16 + swz / 64; C = (st & 1) * 32 + (swz % 64) / 2; }
__host__ __device__ __forceinline__ int perm32(int rho) { const int n = rho >> 4, i = rho & 15; return 8 * (i >> 2) + 4 * n + (i & 3); }

struct Unit { int pm, pn, sel; };
struct Sched2 {
    const bf16_t *A0, *B0, *A1, *B1; int nM0, nN0, nwg0, nM1, nN1, nwg1, G, c, K;
    __device__ void init(const bf16_t* a0, const bf16_t* b0, int m0, int n0, const bf16_t* a1, const bf16_t* b1, int m1, int n1, int K_, int G_, int c_) {
        A0 = a0; B0 = b0; nM0 = m0 / BM; nN0 = n0 / BM; nwg0 = nM0 * nN0; A1 = a1; B1 = b1; nM1 = m1 / BM; nN1 = n1 / BM; nwg1 = nM1 * nN1; K = K_; G = G_; c = c_; }
    __device__ static void map(int wgid, int nM, int nN, int& pm, int& pn) {
        const int nwg = nM * nN; { const int q = nwg / NXCD, r = nwg % NXCD, xcd = wgid % NXCD, off = wgid / NXCD; wgid = (xcd < r ? xcd * (q + 1) : r * (q + 1) + (xcd - r) * q) + off; }
        const int nig = WGM * nN, gid = wgid / nig, fm = gid * WGM, gsz = (nM - fm) < WGM ? (nM - fm) : WGM;
        pm = fm + ((wgid % nig) % gsz); pn = (wgid % nig) / gsz; }
    __device__ bool next(int i, Unit& u) const {
        const int L = i * G + c;
        if (L < nwg0) { map(L, nM0, nN0, u.pm, u.pn); u.sel = 0; return true; }
        if (L < nwg0 + nwg1) { map(L - nwg0, nM1, nN1, u.pm, u.pn); u.sel = 1; return true; }
        return false; }
    __device__ __forceinline__ const char* baseA(const Unit& u) const { return (const char*)(u.sel ? A1 : A0) + (size_t)u.pm * BM * K * 2; }
    __device__ __forceinline__ const char* baseB(const Unit& u) const { return (const char*)(u.sel ? B1 : B0) + (size_t)u.pn * BM * K * 2; }
};

template <class Epi, bool ALIGN_EPI, bool SP2>
__device__ __forceinline__ void gemm_phase(LAS unsigned char* lds, const Sched2& S, const Epi& E) {
    const int tid = threadIdx.x, wid = __builtin_amdgcn_readfirstlane(tid >> 6), lane = tid & 63, wr = wid >> 2, wc = wid & 3, fr = lane & 15, fq = lane >> 4;
    const int K = S.K, nt = K / BK;
    unsigned voffA[2], voffB[2];
#pragma unroll
    for (int i = 0; i < 2; ++i) { int R, C; stage_rc(tid * 16 + i * 8192, R, C); const int Rb = Epi::PERM ? ((R & ~31) + perm32(R & 31)) : R;
        voffA[i] = (unsigned)(R * K + C) * 2u; voffB[i] = (unsigned)(Rb * K + C) * 2u; }
    const size_t kstep = (size_t)(BK * 2);
    const size_t hstep = (size_t)HALF * K * 2;
    const unsigned ldsw = (unsigned)wid * 1024u;
    const int aoff = lds_byte(wr * 64 + fr, fq * 8), boff = lds_byte(wc * 32 + fr, fq * 8);
#define PG8_SA(b, h) (((b) * 2 + (h)) * HTB)
#define PG8_SB(b, h) ((4 + (b) * 2 + (h)) * HTB)
#define PG8_STAGE(bufoff, gbase, voff) do { _Pragma("unroll") for (int _i = 0; _i < 2; ++_i) \
        __builtin_amdgcn_global_load_lds((const unsigned*)((const char*)(gbase) + (voff)[_i]), (LAS unsigned*)(lds + (bufoff) + ldsw + _i * 8192), 16, 0, 0); } while (0)
#define PG8_LDA(dst, b, h) do { _Pragma("unroll") for (int m = 0; m < 4; ++m) _Pragma("unroll") for (int k = 0; k < 2; ++k) dst[m][k] = *(const LAS bf16x8*)(lds + PG8_SA(b, h) + aoff + m * 2048 + k * 1024); } while (0)
#define PG8_LDB(dst, b, h) do { _Pragma("unroll") for (int n = 0; n < 2; ++n) _Pragma("unroll") for (int k = 0; k < 2; ++k) dst[n][k] = *(const LAS bf16x8*)(lds + PG8_SB(b, h) + boff + n * 2048 + k * 1024); } while (0)
#define PG8_MMA(ai, bj, At, Bt) do { __builtin_amdgcn_s_setprio(1); _Pragma("unroll") for (int m = 0; m < 4; ++m) _Pragma("unroll") for (int n = 0; n < 2; ++n) _Pragma("unroll") for (int k = 0; k < 2; ++k) \
        acc[ai][bj][m][n] = __builtin_amdgcn_mfma_f32_16x16x32_bf16(Bt[n][k], At[m][k], acc[ai][bj][m][n], 0, 0, 0); __builtin_amdgcn_s_setprio(0); } while (0)
#define PG8_WAIT_V(n) asm volatile("s_waitcnt vmcnt(" #n ")" ::: "memory")
#define PG8_WAIT_L(n) asm volatile("s_waitcnt lgkmcnt(" #n ")" ::: "memory")
#define PG8_BAR __builtin_amdgcn_s_barrier()
#define PG8_SCHED __builtin_amdgcn_sched_barrier(0)
    Unit cur, nxt; int ui = 0;
    if (!S.next(0, cur)) return;
    f32x4 acc[2][2][4][2];
#pragma unroll
    for (int a = 0; a < 2; ++a)
#pragma unroll
        for (int b = 0; b < 2; ++b)
#pragma unroll
            for (int m = 0; m < 4; ++m)
#pragma unroll
                for (int n = 0; n < 2; ++n) acc[a][b][m][n] = (f32x4){0.f, 0.f, 0.f, 0.f};
    bf16x8 At[4][2], B0[2][2], B1[2][2];
    const char* cA = S.baseA(cur); const char* cB = S.baseB(cur);
    if constexpr (SP2) {
        PG8_STAGE(PG8_SB(0, 0), cB, voffB); PG8_STAGE(PG8_SB(0, 1), cB + hstep, voffB); PG8_STAGE(PG8_SA(0, 0), cA, voffA); PG8_STAGE(PG8_SA(0, 1), cA + hstep, voffA);
        if (wr == 1) PG8_BAR;
        PG8_WAIT_V(2); PG8_BAR;
        PG8_STAGE(PG8_SB(1, 0), cB + kstep, voffB); PG8_STAGE(PG8_SA(1, 0), cA + kstep, voffA); PG8_STAGE(PG8_SB(1, 1), cB + hstep + kstep, voffB);
        PG8_WAIT_V(6); PG8_BAR;
    } else {
        PG8_STAGE(PG8_SB(0, 0), cB, voffB); PG8_STAGE(PG8_SA(0, 0), cA, voffA); PG8_STAGE(PG8_SB(0, 1), cB + hstep, voffB); PG8_STAGE(PG8_SA(0, 1), cA + hstep, voffA);
        if (wr == 1) PG8_BAR;
        PG8_WAIT_V(4); PG8_BAR;
        PG8_STAGE(PG8_SB(1, 0), cB + kstep, voffB); PG8_STAGE(PG8_SA(1, 0), cA + kstep, voffA); PG8_STAGE(PG8_SB(1, 1), cB + hstep + kstep, voffB);
        PG8_WAIT_V(6); PG8_BAR;
    }
    for (;;) {
        const bool has_next = S.next(ui + 1, nxt);
        const char* nA = has_next ? S.baseA(nxt) : cA; const char* nB = has_next ? S.baseB(nxt) : cB;
        for (int t = 0; t < nt; t += 2) {
            const bool last = (t == nt - 2);
            const char* a1 = cA + (size_t)(t + 1) * kstep;
            const char* a2 = last ? nA : cA + (size_t)(t + 2) * kstep; const char* b2 = last ? nB : cB + (size_t)(t + 2) * kstep;
            const char* a3 = a2 + kstep; const char* b3 = b2 + kstep;
            if constexpr (SP2) {
            PG8_LDB(B0, 0, 0); PG8_LDB(B1, 0, 1); PG8_SCHED; PG8_LDA(At, 0, 0); PG8_STAGE(PG8_SA(1, 1), a1 + hstep, voffA);
            PG8_WAIT_V(8); PG8_WAIT_L(0); PG8_BAR; PG8_MMA(0, 0, At, B0); PG8_MMA(0, 1, At, B1); PG8_BAR; PG8_SCHED;
            PG8_LDA(At, 0, 1); PG8_STAGE(PG8_SB(0, 0), b2, voffB); PG8_STAGE(PG8_SB(0, 1), b2 + hstep, voffB); PG8_STAGE(PG8_SA(0, 0), a2, voffA);
            PG8_WAIT_V(8); PG8_WAIT_L(0); PG8_BAR; PG8_MMA(1, 0, At, B0); PG8_MMA(1, 1, At, B1); PG8_BAR; PG8_SCHED;
            PG8_LDB(B0, 1, 0); PG8_LDB(B1, 1, 1); PG8_SCHED; PG8_LDA(At, 1, 0); PG8_STAGE(PG8_SA(0, 1), a2 + hstep, voffA);
            PG8_WAIT_V(8); PG8_WAIT_L(0); PG8_BAR; PG8_MMA(0, 0, At, B0); PG8_MMA(0, 1, At, B1); PG8_BAR; PG8_SCHED;
            PG8_LDA(At, 1, 1); PG8_STAGE(PG8_SB(1, 0), b3, voffB); PG8_STAGE(PG8_SB(1, 1), b3 + hstep, voffB); PG8_STAGE(PG8_SA(1, 0), a3, voffA);
            PG8_WAIT_V(8); PG8_WAIT_L(0); PG8_BAR; PG8_MMA(1, 0, At, B0); PG8_MMA(1, 1, At, B1); PG8_BAR; PG8_SCHED;
            } else {
            PG8_LDB(B0, 0, 0); PG8_SCHED; PG8_LDA(At, 0, 0); PG8_STAGE(PG8_SA(1, 1), a1 + hstep, voffA);
            PG8_WAIT_L(8); PG8_BAR; PG8_WAIT_L(0); PG8_MMA(0, 0, At, B0); PG8_BAR; PG8_SCHED;
            PG8_LDB(B1, 0, 1); PG8_STAGE(PG8_SB(0, 0), b2, voffB);
            PG8_BAR; PG8_WAIT_L(0); PG8_MMA(0, 1, At, B1); PG8_BAR;
            PG8_LDA(At, 0, 1); PG8_STAGE(PG8_SA(0, 0), a2, voffA);
            PG8_BAR; PG8_WAIT_L(0); PG8_MMA(1, 0, At, B0); PG8_BAR; PG8_SCHED;
            PG8_STAGE(PG8_SB(0, 1), b2 + hstep, voffB);
            PG8_WAIT_V(6); PG8_BAR; PG8_MMA(1, 1, At, B1); PG8_BAR;
            PG8_LDB(B0, 1, 0); PG8_SCHED; PG8_LDA(At, 1, 0); PG8_STAGE(PG8_SA(0, 1), a2 + hstep, voffA);
            PG8_WAIT_L(8); PG8_BAR; PG8_WAIT_L(0); PG8_MMA(0, 0, At, B0); PG8_BAR; PG8_SCHED;
            PG8_LDB(B1, 1, 1); PG8_STAGE(PG8_SB(1, 0), b3, voffB);
            PG8_BAR; PG8_WAIT_L(0); PG8_MMA(0, 1, At, B1); PG8_BAR;
            PG8_LDA(At, 1, 1); PG8_STAGE(PG8_SA(1, 0), a3, voffA);
            PG8_BAR; PG8_WAIT_L(0); PG8_MMA(1, 0, At, B0); PG8_BAR; PG8_SCHED;
            PG8_STAGE(PG8_SB(1, 1), b3 + hstep, voffB);
            PG8_WAIT_V(6); PG8_BAR; PG8_MMA(1, 1, At, B1); PG8_BAR;
            }
        }
        if constexpr (ALIGN_EPI) { if (wr == 0) PG8_BAR; }
        E(acc, cur, wr, wc, fr, fq);
        if (!has_next) break;
#pragma unroll
        for (int a = 0; a < 2; ++a)
#pragma unroll
            for (int b = 0; b < 2; ++b)
#pragma unroll
                for (int m = 0; m < 4; ++m)
#pragma unroll
                    for (int n = 0; n < 2; ++n) acc[a][b][m][n] = (f32x4){0.f, 0.f, 0.f, 0.f};
        cur = nxt; cA = nA; cB = nB; ++ui;
        if constexpr (ALIGN_EPI) { if (wr == 1) PG8_BAR; }
    }
    PG8_WAIT_V(0);
    if constexpr (!ALIGN_EPI) { if (wr == 0) PG8_BAR; }
    PG8_BAR;
#undef PG8_SA
#undef PG8_SB
#undef PG8_STAGE
#undef PG8_LDA
#undef PG8_LDB
#undef PG8_MMA
#undef PG8_WAIT_V
#undef PG8_WAIT_L
#undef PG8_BAR
#undef PG8_SCHED
}

struct EpiP1 {
    static constexpr bool PERM = true;
    bf16_t* U;
    __device__ __forceinline__ void operator()(const f32x4 (&acc)[2][2][4][2], const Unit& u, int wr, int wc, int fr, int fq) const {
        const int row0 = u.pm * BM + wr * 64 + fr;
        bf16_t* O = U + (size_t)(u.pn >> 3) * ((size_t)M * D);
        if (u.pn < 24) {
            const bool act = u.pn >= 8;
            const int col0 = (u.pn & 7) * 128 + wc * 32 + 8 * fq;
#pragma unroll
            for (int ai = 0; ai < 2; ++ai)
#pragma unroll
                for (int m = 0; m < 4; ++m) { bf16_t* rowp = O + (size_t)(row0 + ai * HALF + m * 16) * D + col0;
                    f32x4 a0 = acc[ai][0][m][0], a1 = acc[ai][0][m][1], b0 = acc[ai][1][m][0], b1 = acc[ai][1][m][1];
                    if (act) {
#pragma unroll
                        for (int j = 0; j < 4; ++j) { b0[j] = silu_f(b0[j]); b1[j] = silu_f(b1[j]); } }
                    a0 = a0 * b0; a1 = a1 * b1;
                    u32x4 w; w.x = cvt_pk_bf16(a0[0], a0[1]); w.y = cvt_pk_bf16(a0[2], a0[3]); w.z = cvt_pk_bf16(a1[0], a1[1]); w.w = cvt_pk_bf16(a1[2], a1[3]);
                    *(u32x4*)rowp = w; }
        } else {
            const int col0 = (u.pn - 24) * 256 + wc * 32 + 8 * fq;
#pragma unroll
            for (int ai = 0; ai < 2; ++ai)
#pragma unroll
                for (int m = 0; m < 4; ++m) { bf16_t* rowp = O + (size_t)(row0 + ai * HALF + m * 16) * D + col0;
#pragma unroll
                    for (int bj = 0; bj < 2; ++bj) { const f32x4 v0 = acc[ai][bj][m][0], v1 = acc[ai][bj][m][1];
                        u32x4 w; w.x = cvt_pk_bf16(v0[0], v0[1]); w.y = cvt_pk_bf16(v0[2], v0[3]); w.z = cvt_pk_bf16(v1[0], v1[1]); w.w = cvt_pk_bf16(v1[2], v1[3]);
                        *(u32x4*)(rowp + bj * HALF) = w; } }
        }
    }
};
struct EpiP5 {
    static constexpr bool PERM = true;
    bf16_t *Q, *VT; const float *qn, *kn;
    __device__ __forceinline__ void operator()(const f32x4 (&acc)[2][2][4][2], const Unit& u, int wr, int wc, int fr, int fq) const {
        const int row0 = u.pm * BM + wr * 64 + fr;
        if (u.sel == 1) {
            const int col0 = u.pn * BM + wc * 32 + 8 * fq;
#pragma unroll
            for (int ai = 0; ai < 2; ++ai)
#pragma unroll
                for (int m = 0; m < 4; ++m) { bf16_t* rowp = VT + (size_t)(row0 + ai * HALF + m * 16) * M + col0;
#pragma unroll
                    for (int bj = 0; bj < 2; ++bj) { const f32x4 v0 = acc[ai][bj][m][0], v1 = acc[ai][bj][m][1];
                        u32x4 w; w.x = cvt_pk_bf16(v0[0], v0[1]); w.y = cvt_pk_bf16(v0[2], v0[3]); w.z = cvt_pk_bf16(v1[0], v1[1]); w.w = cvt_pk_bf16(v1[2], v1[3]);
                        *(u32x4*)(rowp + bj * HALF) = w; } }
        } else if (u.pn >= 8) {
            const int col0 = (u.pn - 8) * BM + wc * 32 + 8 * fq;
#pragma unroll
            for (int ai = 0; ai < 2; ++ai)
#pragma unroll
                for (int m = 0; m < 4; ++m) { bf16_t* rowp = Q + 2 * (size_t)M * D + (size_t)(row0 + ai * HALF + m * 16) * D + col0;
#pragma unroll
                    for (int bj = 0; bj < 2; ++bj) { f32x4 v0 = acc[ai][bj][m][0], v1 = acc[ai][bj][m][1];
#pragma unroll
                        for (int j = 0; j < 4; ++j) { v0[j] = silu_f(v0[j]); v1[j] = silu_f(v1[j]); }
                        u32x4 w; w.x = cvt_pk_bf16(v0[0], v0[1]); w.y = cvt_pk_bf16(v0[2], v0[3]); w.z = cvt_pk_bf16(v1[0], v1[1]); w.w = cvt_pk_bf16(v1[2], v1[3]);
                        *(u32x4*)(rowp + bj * HALF) = w; } }
        } else {
            const bool isq = u.pn < 4; bf16_t* O = Q + (size_t)(u.pn >> 2) * ((size_t)M * D); const float* nw = qn; if (!isq) nw = kn; const float sc = isq ? (LOG2E * 0.125f) : 1.0f;
            const int col0 = (u.pn & 3) * BM + 64 * wc + 8 * fq;
            f32x4 w4[2][2];
#pragma unroll
            for (int bj = 0; bj < 2; ++bj)
#pragma unroll
                for (int n = 0; n < 2; ++n) w4[bj][n] = *(const f32x4*)(nw + 32 * bj + 8 * fq + 4 * n);
#pragma unroll
            for (int ai = 0; ai < 2; ++ai)
#pragma unroll
                for (int m = 0; m < 4; ++m) {
                    float ss = 0.f;
#pragma unroll
                    for (int bj = 0; bj < 2; ++bj)
#pragma unroll
                        for (int n = 0; n < 2; ++n) { const f32x4 v = acc[ai][bj][m][n]; ss += (v[0] * v[0] + v[1] * v[1]) + (v[2] * v[2] + v[3] * v[3]); }
                    ss += __shfl_xor(ss, 16); ss += __shfl_xor(ss, 32);
                    const float rs = __builtin_amdgcn_rsqf(ss * (1.0f / 64.0f) + EPS) * sc;
                    bf16_t* rowp = O + (size_t)(row0 + ai * HALF + m * 16) * D + col0;
#pragma unroll
                    for (int bj = 0; bj < 2; ++bj) { const f32x4 v0 = acc[ai][bj][m][0] * rs * w4[bj][0], v1 = acc[ai][bj][m][1] * rs * w4[bj][1];
                        u32x4 w; w.x = cvt_pk_bf16(v0[0], v0[1]); w.y = cvt_pk_bf16(v0[2], v0[3]); w.z = cvt_pk_bf16(v1[0], v1[1]); w.w = cvt_pk_bf16(v1[2], v1[3]);
                        *(u32x4*)(rowp + 32 * bj) = w; } }
        }
    }
};
struct EpiRes {
    static constexpr bool PERM = false;
    const float* base; float* out; const float* gate;
    __device__ __forceinline__ void operator()(const f32x4 (&acc)[2][2][4][2], const Unit& u, int wr, int wc, int fr, int fq) const {
        const int row0 = u.pm * BM + wr * 64 + fr, col0 = u.pn * BM + wc * 32 + 4 * fq;
        const float* gp = gate + ((u.pm * BM) / SEQ) * 3072 + col0;
        f32x4 gv[2][2];
#pragma unroll
        for (int bj = 0; bj < 2; ++bj)
#pragma unroll
            for (int n = 0; n < 2; ++n) gv[bj][n] = *(const f32x4*)(gp + bj * HALF + n * 16);
#pragma unroll
        for (int ai = 0; ai < 2; ++ai)
#pragma unroll
            for (int m = 0; m < 4; ++m) { const size_t off = (size_t)(row0 + ai * HALF + m * 16) * D + col0;
#pragma unroll
                for (int bj = 0; bj < 2; ++bj)
#pragma unroll
                    for (int n = 0; n < 2; ++n) { const f32x4 bs = *(const f32x4*)(base + off + bj * HALF + n * 16);
                        *(f32x4*)(out + off + bj * HALF + n * 16) = bs + gv[bj][n] * acc[ai][bj][m][n]; } }
    }
};
}

#define XB_TMO      128
#define XB_XCNT(j)  (256  + 64 * (j))
#define XB_XSUB(j)  (1280 + 64 * (j))
#define XB_XGEN(j)  (2304 + 64 * (j))
#define XB_TOP      3328
#define XB_TOPGEN   3392
#define XCD_BAR_WORDS 3456
#define XB_SPIN_CAP (1u << 18)
__device__ __forceinline__ unsigned xb_ld(unsigned* p)              { return __hip_atomic_load(p, __ATOMIC_RELAXED, __HIP_MEMORY_SCOPE_AGENT); }
__device__ __forceinline__ unsigned xb_add(unsigned* p, unsigned v) { return __hip_atomic_fetch_add(p, v, __ATOMIC_RELAXED, __HIP_MEMORY_SCOPE_AGENT); }
__device__ __forceinline__ unsigned xb_xcc_id() { return (unsigned)__builtin_amdgcn_s_getreg((3 << 11) | 20) & 0xFu; }
#define XB_SPIN(cond, bar) do { unsigned _sp = 0; while (cond) { __builtin_amdgcn_s_sleep(1); \
    if ((++_sp & 255u) == 0u) { if (xb_ld(&(bar)[XB_TMO])) break; if (_sp > XB_SPIN_CAP) { atomicAdd(&(bar)[XB_TMO], 1u); break; } } } } while (0)
struct XcdBarrier { unsigned* bar; unsigned x; volatile LAS unsigned* st; };
__device__ __forceinline__ XcdBarrier xcd_barrier_post(unsigned* bar, volatile LAS unsigned* st) {
    XcdBarrier b; b.bar = bar; b.x = xb_xcc_id(); b.st = st;
    if (threadIdx.x == 0) (void)xb_add(&bar[XB_XCNT(b.x)], 1u);
    return b;
}
__device__ __forceinline__ void xcd_barrier_complete(unsigned* bar, unsigned x, unsigned& nloc, unsigned& nx) {
    const unsigned G = gridDim.x * gridDim.y * gridDim.z;
    unsigned sum, cnt, mine, sp = 0u;
    for (;;) {
        sum = 0u; cnt = 0u; mine = 0u;
#pragma unroll
        for (unsigned j = 0; j < 16; ++j) { const unsigned c = xb_ld(&bar[XB_XCNT(j)]); sum += c; cnt += (c > 0u) ? 1u : 0u; mine = (j == x) ? c : mine; }
        if (sum == G) break;
        __builtin_amdgcn_s_sleep(1);
        if ((++sp & 255u) == 0u) { if (xb_ld(&bar[XB_TMO])) break; if (sp > XB_SPIN_CAP) { atomicAdd(&bar[XB_TMO], 1u); break; } }
    }
    nloc = mine > 0u ? mine : 1u; nx = cnt > 0u ? cnt : 1u;
}
__device__ __forceinline__ void xcd_barrier(const XcdBarrier& b) {
    asm volatile("s_waitcnt vmcnt(0)" ::: "memory");
    __syncthreads();
    if (threadIdx.x == 0) {
        unsigned* bar = b.bar;
        __builtin_amdgcn_s_waitcnt(0);
        unsigned nloc = b.st[0], nx = b.st[1];
        if (nloc == 0u) { xcd_barrier_complete(bar, b.x, nloc, nx); b.st[0] = nloc; b.st[1] = nx; }
        const unsigned old = xb_add(&bar[XB_XSUB(b.x)], 1u);
        const unsigned gen = old / nloc;
        if (old + 1u == (gen + 1u) * nloc) {
            __builtin_amdgcn_fence(__ATOMIC_RELEASE, "agent");
            asm volatile("s_waitcnt vmcnt(0)" ::: "memory");
            const unsigned og = xb_add(&bar[XB_TOP], 1u);
            const unsigned tg = og / nx;
            if (og + 1u == (tg + 1u) * nx) xb_add(&bar[XB_TOPGEN], 1u);
            else XB_SPIN(xb_ld(&bar[XB_TOPGEN]) == tg, bar);
            __builtin_amdgcn_fence(__ATOMIC_ACQUIRE, "agent");
            xb_add(&bar[XB_XGEN(b.x)], 1u);
            asm volatile("s_waitcnt vmcnt(0)" ::: "memory");
        } else {
            XB_SPIN(xb_ld(&bar[XB_XGEN(b.x)]) == gen, bar);
            __builtin_amdgcn_fence(__ATOMIC_ACQUIRE, "agent");
            asm volatile("s_waitcnt vmcnt(0)" ::: "memory");
        }
    }
    __syncthreads();
}

struct Args {
    const float *x, *c, *ln_g, *ada_w, *ada_b, *w_in_ab, *conv_w, *sg_norm, *sg_w, *sg_b, *w_out_ab, *w_in_c, *q_norm, *k_norm, *w_out_c;
    float* out; unsigned char* ws; int ph_lo, ph_hi;
};

__device__ __forceinline__ int ab_row(int c) {
    const int seg = c >> 10, cc = c & 1023, t = cc >> 7, r = cc & 127;
    switch (seg) {
        case 1: return 256 * t + r;
        case 2: return 256 * t + 128 + r;
        case 0: return 256 * (8 + t) + r;
        case 3: return 256 * (8 + t) + 128 + r;
        case 4: return 256 * (16 + t) + r;
        case 6: return 256 * (16 + t) + 128 + r;
        default: return 256 * 24 + cc;
    }
}
__device__ __forceinline__ int c_row(int c) {
    const int seg = c >> 10, cc = c & 1023;
    if (seg == 2) return 3072 + cc;
    if (seg == 3) return 2048 + cc;
    const int tile = cc >> 8, ct = cc & 255, hh = ct >> 6, bj = (ct >> 5) & 1, i = ct & 31;
    return seg * 1024 + tile * 256 + 128 * bj + 32 * hh + i;
}
template <int MODE>
__device__ __forceinline__ void p0_transpose_item(const float* W, int K, int N, bf16_t* WT, LAS float* scr, int item, int lane) {
    const int nblk = N / 32, kb = item / nblk, nb = item % nblk, k0 = 64 * kb, n0 = 32 * nb;
    const int rb = MODE == 1 ? ab_row(n0) : (MODE == 2 ? c_row(n0) : n0);
#pragma unroll 8
    for (int i = 0; i < 32; ++i) { const int kk = 2 * i + (lane >> 5); scr[kk * 33 + (lane & 31)] = W[(size_t)(k0 + kk) * N + n0 + (lane & 31)]; }
    asm volatile("s_waitcnt lgkmcnt(0)" ::: "memory");
    const int c = lane & 7;
#pragma unroll
    for (int j = 0; j < 4; ++j) { const int n = (lane >> 3) + 8 * j; const LAS float* s = scr + (8 * c) * 33 + n;
        u32x4 o; o.x = cvt_pk_bf16(s[0 * 33], s[1 * 33]); o.y = cvt_pk_bf16(s[2 * 33], s[3 * 33]); o.z = cvt_pk_bf16(s[4 * 33], s[5 * 33]); o.w = cvt_pk_bf16(s[6 * 33], s[7 * 33]);
        *(u32x4*)(WT + (size_t)(rb + n) * K + k0 + 8 * c) = o; }
    asm volatile("s_waitcnt lgkmcnt(0)" ::: "memory");
}

__device__ __forceinline__ float wave_sum(float v) {
#pragma unroll
    for (int o = 1; o < 64; o <<= 1) v += __shfl_xor(v, o);
    return v;
}
__device__ __forceinline__ void rms_phase(const float* X, const float* g, const float* mod  , bf16_t* H, int gw, int NGW, int lane) {
    for (int b = 0; b < BATCH; ++b) {
        f32x4 mul[4], sh[4];
#pragma unroll
        for (int j = 0; j < 4; ++j) { const int col = 4 * lane + 256 * j; const f32x4 gg = *(const f32x4*)(g + col), sc = *(const f32x4*)(mod + b * 3072 + 1024 + col);
            sh[j] = *(const f32x4*)(mod + b * 3072 + col); mul[j] = gg * (sc + 1.0f); }
        for (int r = gw; r < SEQ; r += NGW) {
            const size_t m = (size_t)b * SEQ + r;
            const f32x4* xr = (const f32x4*)(X + m * D) + lane;
            f32x4 v[4]; float s = 0.f;
#pragma unroll
            for (int j = 0; j < 4; ++j) { v[j] = xr[64 * j]; s += (v[j].x * v[j].x + v[j].y * v[j].y) + (v[j].z * v[j].z + v[j].w * v[j].w); }
            const float rstd = __builtin_amdgcn_rsqf(wave_sum(s) * (1.f / D) + EPS);
            u32x2* o8 = (u32x2*)(H + m * D) + lane;
#pragma unroll
            for (int j = 0; j < 4; ++j) { const f32x4 o = v[j] * rstd * mul[j] + sh[j]; u32x2 w; w.x = cvt_pk_bf16(o.x, o.y); w.y = cvt_pk_bf16(o.z, o.w); o8[64 * j] = w; }
        }
    }
}

__device__ __forceinline__ void mixer_phase(LAS unsigned char* lds, const bf16_t* U, const bf16_t* Gt, const bf16_t* UZ, const bf16_t* V, const float* conv_w, const float* sg_norm,
                                            const float* sg_w, const float* sg_b, bf16_t* Y, int vcu, int G) {
    const int tid = threadIdx.x, lane = tid & 63, w = __builtin_amdgcn_readfirstlane(tid >> 6), fr = lane & 15, fq = lane >> 4;
    constexpr int PT = 136;
    LAS bf16_t* VNT = (LAS bf16_t*)lds;
    LAS bf16_t* WL = (LAS bf16_t*)(lds + 128 * PT * 2);
    LAS float* SG = (LAS float*)lds;
    for (int unit = vcu; unit < BATCH * 64 * 8; unit += G) {
        const int g = unit & 7, cch = (unit >> 3) & 63, b = unit >> 9; const size_t r0 = (size_t)b * SEQ + cch * 128;
        { const int c8 = tid & 15, rg = tid >> 4, ch = 128 * g + 8 * c8; const size_t row = r0 + 4 * rg;
          float cw[3][8];
#pragma unroll
          for (int k = 0; k < 3; ++k) { const f32x4 a = *(const f32x4*)(conv_w + k * D + ch), bq = *(const f32x4*)(conv_w + k * D + ch + 4);
              cw[k][0] = a.x; cw[k][1] = a.y; cw[k][2] = a.z; cw[k][3] = a.w; cw[k][4] = bq.x; cw[k][5] = bq.y; cw[k][6] = bq.z; cw[k][7] = bq.w; }
          u32x4 ur[6];
          const bool halo0 = (cch == 0 && rg == 0);
#pragma unroll
          for (int i = 0; i < 6; ++i) { if (i < 2 && halo0) ur[i] = (u32x4){0u, 0u, 0u, 0u}; else ur[i] = *(const u32x4*)(U + (row + i - 2) * D + ch); }
#pragma unroll
          for (int i = 0; i < 4; ++i) { const u32x4 gv = *(const u32x4*)(Gt + (row + i) * D + ch); float o[8];
#pragma unroll
              for (int p = 0; p < 4; ++p) { const unsigned u0 = ur[i][p], u1 = ur[i + 1][p], u2 = ur[i + 2][p];
                  o[2 * p] = bf_lo(gv[p]) * (cw[0][2 * p] * bf_lo(u0) + cw[1][2 * p] * bf_lo(u1) + cw[2][2 * p] * bf_lo(u2));
                  o[2 * p + 1] = bf_hi(gv[p]) * (cw[0][2 * p + 1] * bf_hi(u0) + cw[1][2 * p + 1] * bf_hi(u1) + cw[2][2 * p + 1] * bf_hi(u2)); }
              u32x4 wv; wv.x = cvt_pk_bf16(o[0], o[1]); wv.y = cvt_pk_bf16(o[2], o[3]); wv.z = cvt_pk_bf16(o[4], o[5]); wv.w = cvt_pk_bf16(o[6], o[7]);
              *(u32x4*)(Y + (row + i) * 2048 + ch) = wv; }
        }
        { const int s = tid >> 2, qd = tid & 3; const bf16_t* vp = V + (r0 + s) * D + 128 * g + 32 * qd;
          float v[32]; float ss = 0.f;
#pragma unroll
          for (int i = 0; i < 4; ++i) { const u32x4 t = *(const u32x4*)(vp + 8 * i);
#pragma unroll
              for (int p = 0; p < 4; ++p) { v[8 * i + 2 * p] = bf_lo(t[p]); v[8 * i + 2 * p + 1] = bf_hi(t[p]); } }
#pragma unroll
          for (int i = 0; i < 32; ++i) ss += v[i] * v[i];
          ss += __shfl_xor(ss, 1); ss += __shfl_xor(ss, 2);
          const float rs = __builtin_amdgcn_rsqf(ss * (1.0f / 128.0f) + EPS);
          const float* nw = sg_norm + g * 128 + 32 * qd;
#pragma unroll
          for (int i = 0; i < 32; i += 2) { const unsigned pk = cvt_pk_bf16(v[i] * rs * nw[i], v[i + 1] * rs * nw[i + 1]);
              VNT[(32 * qd + i) * PT + s] = (bf16_t)(pk & 0xffffu); VNT[(32 * qd + i + 1) * PT + s] = (bf16_t)(pk >> 16); }
          const int t = tid >> 2, sq = tid & 3; const float* wp = sg_w + ((size_t)g * 128 + t) * 128 + 32 * sq;
#pragma unroll
          for (int i = 0; i < 4; ++i) { f32x4 a = *(const f32x4*)(wp + 8 * i), bq = *(const f32x4*)(wp + 8 * i + 4); const int s0 = 32 * sq + 8 * i;
              float e[8] = {a.x, a.y, a.z, a.w, bq.x, bq.y, bq.z, bq.w};
#pragma unroll
              for (int p = 0; p < 8; ++p) if (s0 + p > t) e[p] = 0.f;
              u32x4 wv; wv.x = cvt_pk_bf16(e[0], e[1]); wv.y = cvt_pk_bf16(e[2], e[3]); wv.z = cvt_pk_bf16(e[4], e[5]); wv.w = cvt_pk_bf16(e[6], e[7]);
              *(LAS u32x4*)(WL + t * PT + s0) = wv; }
        }
        __syncthreads();
        f32x4 acc[8];
#pragma unroll
        for (int tt = 0; tt < 8; ++tt) acc[tt] = (f32x4){0.f, 0.f, 0.f, 0.f};
#pragma unroll
        for (int ks = 0; ks < 4; ++ks) { const bf16x8 a = *(const LAS bf16x8*)(VNT + (16 * w + fr) * PT + 32 * ks + 8 * fq);
#pragma unroll
            for (int tt = 2 * ks; tt < 8; ++tt) { const bf16x8 bw = *(const LAS bf16x8*)(WL + (16 * tt + fr) * PT + 32 * ks + 8 * fq);
                acc[tt] = __builtin_amdgcn_mfma_f32_16x16x32_bf16(a, bw, acc[tt], 0, 0, 0); } }
        __syncthreads();
#pragma unroll
        for (int tt = 0; tt < 8; ++tt) { const int t = 16 * tt + fr; const float bb = sg_b[g * 128 + t];
            *(LAS f32x4*)(SG + t * 132 + 16 * w + 4 * fq) = acc[tt] + bb; }
        __syncthreads();
        { const int rr = tid >> 2, dq = tid & 3; const bf16_t* up = UZ + (r0 + rr) * D + 128 * g + 32 * dq; bf16_t* yp = Y + (r0 + rr) * 2048 + 1024 + 128 * g + 32 * dq;
#pragma unroll
          for (int i = 0; i < 4; ++i) { const u32x4 uz = *(const u32x4*)(up + 8 * i); const f32x4 s0 = *(const LAS f32x4*)(SG + rr * 132 + 32 * dq + 8 * i), s1 = *(const LAS f32x4*)(SG + rr * 132 + 32 * dq + 8 * i + 4);
              u32x4 wv; wv.x = cvt_pk_bf16(bf_lo(uz.x) * s0.x, bf_hi(uz.x) * s0.y); wv.y = cvt_pk_bf16(bf_lo(uz.y) * s0.z, bf_hi(uz.y) * s0.w);
              wv.z = cvt_pk_bf16(bf_lo(uz.z) * s1.x, bf_hi(uz.z) * s1.y); wv.w = cvt_pk_bf16(bf_lo(uz.w) * s1.z, bf_hi(uz.w) * s1.w);
              *(u32x4*)(yp + 8 * i) = wv; }
        }
        __syncthreads();
    }
}

__device__ __forceinline__ int crow(int i, int hi) { return (i & 3) + 8 * (i >> 2) + 4 * hi; }
__device__ __forceinline__ void attn_load_k(bf16x8 (&kf)[4], bool in_lds, LAS unsigned char* KL, int kl0, const bf16_t* kg, int ql, int hi) {
    if (in_lds) { const int r = kl0 + ql; LAS unsigned char* rp = KL + r * 128; const int sw = (r >> 1) & 7;
#pragma unroll
        for (int kk = 0; kk < 4; ++kk) kf[kk] = *(const LAS bf16x8*)(rp + (((2 * kk + hi) ^ sw) << 4));
    } else {
#pragma unroll
        for (int kk = 0; kk < 4; ++kk) kf[kk] = *(const bf16x8*)(kg + 16 * kk);
    }
}
__device__ __forceinline__ void attn_phase(LAS unsigned char* lds, const bf16_t* Q, const bf16_t* Kb, const bf16_t* VT, const bf16_t* Zs, bf16_t* OZ, int vcu, int G) {
    const int tid = threadIdx.x, lane = tid & 63, w = __builtin_amdgcn_readfirstlane(tid >> 6), ql = lane & 31, hi = lane >> 5;
    constexpr float STOP = 5.421010862427522e-20f;
    LAS unsigned char* KL = lds;
    LAS unsigned char* VL = lds + 65536;
    for (int unit = vcu; unit < BATCH * 16 * (SEQ / 256); unit += G) {
        const int qblk = unit & 31, h = (unit >> 5) & 15, b = unit >> 9;
        const size_t rowbase = (size_t)b * SEQ; const int q0b = 256 * qblk, kw0 = q0b >= 256 ? q0b - 256 : 0, nk = q0b + 256 - kw0;
#pragma unroll
        for (int i = 0; i < 8; ++i) { const int idx = tid + NTHR * i, r = idx >> 3, c = idx & 7;
            if (r < nk) { const u32x4 v = *(const u32x4*)(Kb + (rowbase + kw0 + r) * D + h * 64 + 8 * c); *(LAS u32x4*)(KL + r * 128 + ((c ^ ((r >> 1) & 7)) << 4)) = v; } }
#pragma unroll
        for (int i = 0; i < 8; ++i) { const int idx = tid + NTHR * i, d = idx >> 6, ch = idx & 63;
            if (8 * ch < nk) { u32x4 v = *(const u32x4*)(VT + (size_t)(h * 64 + d) * M + rowbase + kw0 + 8 * ch); const int gp = (2 * ch) ^ (d & 31);
                if (d & 1) { const u32x4 t = v; v.x = t.z; v.y = t.w; v.z = t.x; v.w = t.y; }
                *(LAS u32x4*)(VL + d * 1024 + ((gp & ~1) << 3)) = v; } }
        __syncthreads();
        const int qb = 8 * qblk + w, q0 = 32 * qb;
        bf16x8 qf[4];
        { const bf16_t* qp = Q + (rowbase + q0 + ql) * D + h * 64 + 8 * hi;
#pragma unroll
          for (int kk = 0; kk < 4; ++kk) qf[kk] = *(const bf16x8*)(qp + 16 * kk); }
        f32x16 o0, o1;
#pragma unroll
        for (int i = 0; i < 16; ++i) { o0[i] = 0.f; o1[i] = 0.f; }
        float carry = 1.f;
        bf16x8 kf[4];
        attn_load_k(kf, true, KL, q0 - kw0, nullptr, ql, hi);
        for (int kt = qb; kt >= 0; --kt) {
            const int key0 = 32 * kt; const bool in_lds = key0 >= kw0;
            u32x2 vf[2][2][2];
            if (in_lds) { const int g0 = ((key0 - kw0) >> 2) + hi;
#pragma unroll
                for (int dh = 0; dh < 2; ++dh) { LAS unsigned char* rp = VL + (32 * dh + ql) * 1024;
#pragma unroll
                    for (int s = 0; s < 2; ++s) { vf[dh][s][0] = *(const LAS u32x2*)(rp + (((g0 + 4 * s) ^ ql) << 3)); vf[dh][s][1] = *(const LAS u32x2*)(rp + (((g0 + 4 * s + 2) ^ ql) << 3)); } }
            } else { const bf16_t* vp = VT + (size_t)(h * 64 + ql) * M + rowbase + key0 + 4 * hi;
#pragma unroll
                for (int dh = 0; dh < 2; ++dh)
#pragma unroll
                    for (int s = 0; s < 2; ++s) { vf[dh][s][0] = *(const u32x2*)(vp + (size_t)dh * 32 * M + 16 * s); vf[dh][s][1] = *(const u32x2*)(vp + (size_t)dh * 32 * M + 16 * s + 8); } }
            bf16x8 kn[4];
            { const int kt2 = kt > 0 ? kt - 1 : 0; attn_load_k(kn, 32 * kt2 >= kw0, KL, 32 * kt2 - kw0, Kb + (rowbase + 32 * kt2 + ql) * D + h * 64 + 8 * hi, ql, hi); }
            f32x16 S;
#pragma unroll
            for (int i = 0; i < 16; ++i) S[i] = 0.f;
#pragma unroll
            for (int kk = 0; kk < 4; ++kk) S = __builtin_amdgcn_mfma_f32_32x32x16_bf16(kf[kk], qf[kk], S, 0, 0, 0);
            float be[16], om[16];
            const bool diag = (kt == qb);
#pragma unroll
            for (int i = 0; i < 16; ++i) { const float zc = __builtin_fmaxf(S[i], -126.0f); const float E = fast_exp2(-zc); float bv = fast_rcp(1.0f + E); float ov = E * bv;
                if (diag) { const bool valid = crow(i, hi) < ql; bv = valid ? bv : 0.f; ov = valid ? ov : 1.f; }
                be[i] = bv; om[i] = ov; }
            float gs[4], pg[4];
#pragma unroll
            for (int gi = 0; gi < 4; ++gi) { gs[gi] = (om[4 * gi] * om[4 * gi + 1]) * (om[4 * gi + 2] * om[4 * gi + 3]); pg[gi] = __shfl_xor(gs[gi], 32); }
            float run = carry; float wv[16];
#pragma unroll
            for (int gi = 3; gi >= 0; --gi) { const float base = hi == 0 ? run * pg[gi] : run;
                const float s3 = base, s2 = s3 * om[4 * gi + 3], s1 = s2 * om[4 * gi + 2], s0 = s1 * om[4 * gi + 1];
                wv[4 * gi + 3] = be[4 * gi + 3] * s3; wv[4 * gi + 2] = be[4 * gi + 2] * s2; wv[4 * gi + 1] = be[4 * gi + 1] * s1; wv[4 * gi] = be[4 * gi] * s0;
                run *= gs[gi] * pg[gi]; }
            carry = run;
#pragma unroll
            for (int s = 0; s < 2; ++s) { u32x4 pk; pk.x = cvt_pk_bf16(wv[8 * s], wv[8 * s + 1]); pk.y = cvt_pk_bf16(wv[8 * s + 2], wv[8 * s + 3]); pk.z = cvt_pk_bf16(wv[8 * s + 4], wv[8 * s + 5]); pk.w = cvt_pk_bf16(wv[8 * s + 6], wv[8 * s + 7]);
                const bf16x8 pf = __builtin_bit_cast(bf16x8, pk);
                { u32x4 a; a.x = vf[0][s][0].x; a.y = vf[0][s][0].y; a.z = vf[0][s][1].x; a.w = vf[0][s][1].y; o0 = __builtin_amdgcn_mfma_f32_32x32x16_bf16(__builtin_bit_cast(bf16x8, a), pf, o0, 0, 0, 0); }
                { u32x4 a; a.x = vf[1][s][0].x; a.y = vf[1][s][0].y; a.z = vf[1][s][1].x; a.w = vf[1][s][1].y; o1 = __builtin_amdgcn_mfma_f32_32x32x16_bf16(__builtin_bit_cast(bf16x8, a), pf, o1, 0, 0, 0); } }
#pragma unroll
            for (int kk = 0; kk < 4; ++kk) kf[kk] = kn[kk];
            if (__all(carry < STOP)) break;
        }
        const bf16_t* zp = Zs + (rowbase + q0 + ql) * D + h * 64 + 4 * hi; bf16_t* op = OZ + (rowbase + q0 + ql) * D + h * 64 + 4 * hi;
#pragma unroll
        for (int g4 = 0; g4 < 4; ++g4) {
            { const u32x2 zz = *(const u32x2*)(zp + 8 * g4); u32x2 wo; wo.x = cvt_pk_bf16(o0[4 * g4] * bf_lo(zz.x), o0[4 * g4 + 1] * bf_hi(zz.x)); wo.y = cvt_pk_bf16(o0[4 * g4 + 2] * bf_lo(zz.y), o0[4 * g4 + 3] * bf_hi(zz.y)); *(u32x2*)(op + 8 * g4) = wo; }
            { const u32x2 zz = *(const u32x2*)(zp + 32 + 8 * g4); u32x2 wo; wo.x = cvt_pk_bf16(o1[4 * g4] * bf_lo(zz.x), o1[4 * g4 + 1] * bf_hi(zz.x)); wo.y = cvt_pk_bf16(o1[4 * g4 + 2] * bf_lo(zz.y), o1[4 * g4 + 3] * bf_hi(zz.y)); *(u32x2*)(op + 32 + 8 * g4) = wo; }
        }
        __syncthreads();
    }
}

constexpr int N_PHASES = 9;
__global__ void __launch_bounds__(NTHR, 2) hybrid_fwd(Args a) {
    extern __shared__ __attribute__((aligned(16))) unsigned char lds_raw[];
    LAS unsigned char* lds = (LAS unsigned char*)lds_raw;
    const int tid = threadIdx.x, lane = tid & 63, wave = __builtin_amdgcn_readfirstlane(tid >> 6);
    const int G = gridDim.x, bx = blockIdx.x;
    const int vcu = (G % 8 == 0) ? (bx % 8) * (G / 8) + bx / 8 : bx;
    const int gw = vcu * NWAVES + wave, NGW = G * NWAVES;
    unsigned char* ws = a.ws;
    float* MOD = (float*)(ws + WS_MOD);
    bf16_t* WAB = (bf16_t*)(ws + WS_WAB); bf16_t* WOAB = (bf16_t*)(ws + WS_WOAB); bf16_t* WC = (bf16_t*)(ws + WS_WC); bf16_t* WOC = (bf16_t*)(ws + WS_WOC);
    bf16_t* H0 = (bf16_t*)(ws + WS_H0); bf16_t* Y = (bf16_t*)(ws + WS_Y);
    bf16_t* Ub = (bf16_t*)(ws + WS_U); bf16_t* Gb = (bf16_t*)(ws + WS_G); bf16_t* UZb = (bf16_t*)(ws + WS_UZ); bf16_t* Vb = (bf16_t*)(ws + WS_V);
    float* X1 = (float*)(ws + WS_X1); bf16_t* H1 = (bf16_t*)(ws + WS_H1);
    bf16_t* Qb = (bf16_t*)(ws + WS_Q); bf16_t* Kb = (bf16_t*)(ws + WS_K); bf16_t* Zb = (bf16_t*)(ws + WS_Z); bf16_t* VTb = (bf16_t*)(ws + WS_VT); bf16_t* OZb = (bf16_t*)(ws + WS_OZ);
    const int lo = a.ph_lo, hi = a.ph_hi;
#define IN(k) (lo <= (k) && (k) < hi)
    volatile LAS unsigned* bst = (volatile LAS unsigned*)(lds + 131072 + 320);
    if (tid < 4) bst[tid] = 0u;
    __syncthreads();
    XcdBarrier xbar; xbar.bar = (unsigned*)(ws + WS_CTL); xbar.x = 0; xbar.st = bst;
    if (hi - lo > 1) xbar = xcd_barrier_post((unsigned*)(ws + WS_CTL), bst);
#define SEAM(k) do { if (IN(k) && IN((k) + 1)) xcd_barrier(xbar); } while (0)

    if (IN(0)) {
        for (int task = bx; task < 192; task += G) {
            LAS float* sc_l = (LAS float*)lds; LAS float* red = sc_l + 2048;
            for (int i = tid; i < BATCH * D; i += NTHR) { const float v = a.c[i]; sc_l[i] = v / (1.0f + __expf(-v)); }
            __syncthreads();
            const int l = task / 96, n0 = (task % 96) * 32, kc = wave * 2 + (lane >> 5), n = n0 + (lane & 31);
            const float* W = a.ada_w + (size_t)l * D * 3072 + (size_t)(kc * 64) * 3072 + n;
            float a0 = 0.f, a1 = 0.f;
#pragma unroll 16
            for (int k = 0; k < 64; ++k) { const float wv = W[(size_t)k * 3072]; a0 += sc_l[kc * 64 + k] * wv; a1 += sc_l[D + kc * 64 + k] * wv; }
            red[(kc * 2 + 0) * 32 + (lane & 31)] = a0; red[(kc * 2 + 1) * 32 + (lane & 31)] = a1;
            __syncthreads();
            if (tid < 64) { const int b = tid >> 5, nn = tid & 31; float s = 0.f;
#pragma unroll
                for (int k = 0; k < 16; ++k) s += red[(k * 2 + b) * 32 + nn];
                MOD[(l * 2 + b) * 3072 + n0 + nn] = s + a.ada_b[l * 3072 + n0 + nn]; }
            __syncthreads();
        }
        LAS float* scr = (LAS float*)(lds + wave * 16384);
        constexpr int I_AB = (D / 64) * (IN_AB / 32), I_OAB = (2048 / 64) * (D / 32), I_C = (D / 64) * (IN_C / 32), I_OC = (D / 64) * (D / 32);
        for (int it = gw; it < I_AB + I_OAB + I_C + I_OC; it += NGW) {
            int r = it;
            if (r < I_AB) { p0_transpose_item<1>(a.w_in_ab, D, IN_AB, WAB, scr, r, lane); continue; } r -= I_AB;
            if (r < I_OAB) { p0_transpose_item<0>(a.w_out_ab, 2048, D, WOAB, scr, r, lane); continue; } r -= I_OAB;
            if (r < I_C) { p0_transpose_item<2>(a.w_in_c, D, IN_C, WC, scr, r, lane); continue; } r -= I_C;
            p0_transpose_item<0>(a.w_out_c, D, D, WOC, scr, r, lane);
        }
    }
    SEAM(0);
    if (IN(1)) rms_phase(a.x, a.ln_g, MOD, H0, gw, NGW, lane);
    SEAM(1);
    if (IN(2)) { pg8::Sched2 S; S.init(H0, WAB, M, IN_AB, nullptr, nullptr, 0, 0, D, G, bx);
        pg8::EpiP1 E{Ub}; pg8::gemm_phase<pg8::EpiP1, true, true>(lds, S, E); }
    SEAM(2);
    if (IN(3)) mixer_phase(lds, Ub, Gb, UZb, Vb, a.conv_w, a.sg_norm, a.sg_w, a.sg_b, Y, vcu, G);
    SEAM(3);
    if (IN(4)) { pg8::Sched2 S; S.init(Y, WOAB, M, D, nullptr, nullptr, 0, 0, 2048, G, bx);
        pg8::EpiRes E{a.x, X1, MOD + 2048}; pg8::gemm_phase<pg8::EpiRes, true, true>(lds, S, E); }
    SEAM(4);
    if (IN(5)) rms_phase(X1, a.ln_g + D, MOD + 2 * 3072, H1, gw, NGW, lane);
    SEAM(5);
    if (IN(6)) { pg8::Sched2 S; S.init(H1, WC, M, 3072, WC + (size_t)3072 * D, H1, D, M, D, G, bx);
        pg8::EpiP5 E{Qb, VTb, a.q_norm, a.k_norm}; pg8::gemm_phase<pg8::EpiP5, true, true>(lds, S, E); }
    SEAM(6);
    if (IN(7)) attn_phase(lds, Qb, Kb, VTb, Zb, OZb, vcu, G);
    SEAM(7);
    if (IN(8)) { pg8::Sched2 S; S.init(OZb, WOC, M, D, nullptr, nullptr, 0, 0, D, G, bx);
        pg8::EpiRes E{X1, a.out, MOD + 2 * 3072 + 2048}; pg8::gemm_phase<pg8::EpiRes, true, true>(lds, S, E); }
#undef IN
#undef SEAM
}

extern "C" void kernel_launch(void* const* d_in, const int* in_sizes, int n_in, void* d_out, int out_size, void* d_ws, size_t ws_size, hipStream_t stream) {
    static int grid = 0;
    if (grid == 0) {
        if (n_in != 15 || in_sizes[0] != M * D || out_size != M * D || ws_size < WS_END) { fprintf(stderr, "kernel_launch: unexpected problem geometry (n_in %d, ws %zu)\n", n_in, ws_size); grid = -1; return; }
        int dev = 0, cus = 0, per_cu = 0;
        (void)hipGetDevice(&dev); (void)hipDeviceGetAttribute(&cus, hipDeviceAttributeMultiprocessorCount, dev);
        if (hipFuncSetAttribute((const void*)hybrid_fwd, hipFuncAttributeMaxDynamicSharedMemorySize, LDS_BYTES) != hipSuccess) { fprintf(stderr, "kernel_launch: hipFuncSetAttribute failed\n"); grid = -1; return; }
        if (hipOccupancyMaxActiveBlocksPerMultiprocessor(&per_cu, (const void*)hybrid_fwd, NTHR, LDS_BYTES) != hipSuccess || per_cu < 1) { fprintf(stderr, "kernel_launch: occupancy query says %d\n", per_cu); per_cu = 1; }
        (void)hipGetLastError();
        grid = cus * per_cu;
    }
    if (grid < 0) return;
    Args a{};
    a.x = (const float*)d_in[0]; a.c = (const float*)d_in[1]; a.ln_g = (const float*)d_in[2]; a.ada_w = (const float*)d_in[3]; a.ada_b = (const float*)d_in[4];
    a.w_in_ab = (const float*)d_in[5]; a.conv_w = (const float*)d_in[6]; a.sg_norm = (const float*)d_in[7]; a.sg_w = (const float*)d_in[8]; a.sg_b = (const float*)d_in[9];
    a.w_out_ab = (const float*)d_in[10]; a.w_in_c = (const float*)d_in[11]; a.q_norm = (const float*)d_in[12]; a.k_norm = (const float*)d_in[13]; a.w_out_c = (const float*)d_in[14];
    a.out = (float*)d_out; a.ws = (unsigned char*)d_ws;
#if MK_MULTI
    for (int p = 0; p < N_PHASES; ++p) { a.ph_lo = p; a.ph_hi = p + 1; hipLaunchKernelGGL(hybrid_fwd, dim3(grid), dim3(NTHR), LDS_BYTES, stream, a); }
#else
    a.ph_lo = 0; a.ph_hi = N_PHASES;
    (void)hipMemsetAsync((char*)d_ws + WS_CTL, 0, CTL_ZERO_BYTES, stream);
    void* args[] = {&a};
    hipError_t e = hipLaunchCooperativeKernel((const void*)hybrid_fwd, dim3(grid), dim3(NTHR), args, LDS_BYTES, stream);
    if (e != hipSuccess) fprintf(stderr, "kernel_launch: cooperative launch failed: %s (grid %d)\n", hipGetErrorString(e), grid);
#endif
}
```

```cpp
#include <hip/hip_runtime.h>
#include <hip/hip_cooperative_groups.h>
#include <cstdio>
#include <cstdint>
namespace cg = cooperative_groups;

#ifndef MK_MULTI
#define MK_MULTI 0
#endif

#define LAS __attribute__((address_space(3)))
typedef unsigned short bf16_t;
typedef short bf16x8 __attribute__((ext_vector_type(8)));
typedef float f32x4 __attribute__((ext_vector_type(4)));
typedef float f32x16 __attribute__((ext_vector_type(16)));
typedef unsigned u32x4 __attribute__((ext_vector_type(4)));
typedef unsigned u32x2 __attribute__((ext_vector_type(2)));

constexpr int BATCH = 2, SEQ = 8192, D = 1024, M = BATCH * SEQ;
constexpr int IN_AB = 7168, IN_C = 4096;
constexpr float EPS = 1e-6f;
constexpr int NWAVES = 8, NTHR = 512;
constexpr float LOG2E = 1.4426950408889634f;

constexpr size_t MiB = 1u << 20;
constexpr size_t WS_CTL = 0, CTL_ZERO_BYTES = 64 * 1024;
constexpr size_t WS_MOD = 1 * MiB;
constexpr size_t WS_WAB = 2 * MiB;
constexpr size_t WS_WOAB = 16 * MiB;
constexpr size_t WS_WC = 20 * MiB;
constexpr size_t WS_WOC = 28 * MiB;
constexpr size_t WS_SSQ = 31 * MiB;
constexpr size_t WS_SW = 1 * MiB + 65536;
constexpr size_t WS_WTR = 30 * MiB;
constexpr size_t WS_U = 32 * MiB, WS_G = 64 * MiB, WS_UZ = 96 * MiB, WS_V = 128 * MiB;
constexpr size_t WS_H0 = 160 * MiB;
constexpr size_t WS_Y = 160 * MiB;
constexpr size_t WS_X1 = 32 * MiB;
constexpr size_t WS_H1 = 96 * MiB;
constexpr size_t WS_Q = 128 * MiB, WS_K = 160 * MiB, WS_Z = 192 * MiB, WS_VT = 224 * MiB;
constexpr size_t WS_OZ = 96 * MiB;
constexpr size_t WS_END = 256 * MiB;
static_assert(WS_G - WS_U == (size_t)M * D * 2 && WS_UZ - WS_G == (size_t)M * D * 2 && WS_V - WS_UZ == (size_t)M * D * 2 && WS_K - WS_Q == (size_t)M * D * 2 && WS_Z - WS_K == (size_t)M * D * 2, "contiguous activations");

constexpr int LDS_BYTES = 147456;

typedef float f32x2_t __attribute__((ext_vector_type(2))); typedef __bf16 bf16x2_t __attribute__((ext_vector_type(2)));
__device__ __forceinline__ unsigned cvt_pk_bf16(float lo, float hi) { f32x2_t v = {lo, hi}; bf16x2_t b = __builtin_convertvector(v, bf16x2_t); return __builtin_bit_cast(unsigned, b); }
__device__ __forceinline__ float bf_lo(unsigned u) { return __uint_as_float(u << 16); }
__device__ __forceinline__ float bf_hi(unsigned u) { return __uint_as_float(u & 0xffff0000u); }
__device__ __forceinline__ float fast_exp2(float x) { return __builtin_amdgcn_exp2f(x); }
__device__ __forceinline__ float fast_log2(float x) { return __builtin_amdgcn_logf(x); }
__device__ __forceinline__ float fast_rcp(float x) { return __builtin_amdgcn_rcpf(x); }
__device__ __forceinline__ float silu_f(float v) { return v * fast_rcp(1.0f + fast_exp2(-LOG2E * v)); }

namespace pg8 {
constexpr int BM = 256, BK = 64, HALF = 128, HTB = HALF * BK * 2, STAGE_BYTES = 8 * HTB, NXCD = 8, WGM = 8;
__host__ __device__ __forceinline__ int lds_byte(int r, int c) { const int st = (r >> 4) * 2 + (c >> 5), rr = r & 15, cc = c & 31, ob = rr * 64 + cc * 2; return st * 1024 + (ob ^ (((ob >> 9) & 1) << 5)); }
__host__ __device__ __forceinline__ void stage_rc(int b, int& R, int& C) { const int st = b / 1024, sb = b % 1024, swz = sb ^ (((sb >> 9) & 1) << 5); R = (st >> 1) * 16 + swz / 64; C = (st & 1) * 32 + (swz % 64) / 2; }
__host__ __device__ __forceinline__ int perm32(int rho) { const int n = rho >> 4, i = rho & 15; return 8 * (i >> 2) + 4 * n + (i & 3); }

struct Unit { int pm, pn, sel; };
struct Sched2 {
    const bf16_t *A0, *B0, *A1, *B1; int nM0, nN0, nwg0, nM1, nN1, nwg1, G, c, K;
    __device__ void init(const bf16_t* a0, const bf16_t* b0, int m0, int n0, const bf16_t* a1, const bf16_t* b1, int m1, int n1, int K_, int G_, int c_) {
        A0 = a0; B0 = b0; nM0 = m0 / BM; nN0 = n0 / BM; nwg0 = nM0 * nN0; A1 = a1; B1 = b1; nM1 = m1 / BM; nN1 = n1 / BM; nwg1 = nM1 * nN1; K = K_; G = G_; c = c_; }
    __device__ static void map(int wgid, int nM, int nN, int& pm, int& pn) {
        const int nwg = nM * nN; { const int q = nwg / NXCD, r = nwg % NXCD, xcd = wgid % NXCD, off = wgid / NXCD; wgid = (xcd < r ? xcd * (q + 1) : r * (q + 1) + (xcd - r) * q) + off; }
        const int nig = WGM * nN, gid = wgid / nig, fm = gid * WGM, gsz = (nM - fm) < WGM ? (nM - fm) : WGM;
        pm = fm + ((wgid % nig) % gsz); pn = (wgid % nig) / gsz; }
    __device__ bool next(int i, Unit& u) const {
        const int L = i * G + c;
        if (L < nwg0) { map(L, nM0, nN0, u.pm, u.pn); u.sel = 0; return true; }
        if (L < nwg0 + nwg1) { map(L - nwg0, nM1, nN1, u.pm, u.pn); u.sel = 1; return true; }
        return false; }
    __device__ __forceinline__ const char* baseA(const Unit& u) const { return (const char*)(u.sel ? A1 : A0) + (size_t)u.pm * BM * K * 2; }
    __device__ __forceinline__ const char* baseB(const Unit& u) const { return (const char*)(u.sel ? B1 : B0) + (size_t)u.pn * BM * K * 2; }
};

template <class Epi, bool ALIGN_EPI, bool SP2>
__device__ __forceinline__ void gemm_phase(LAS unsigned char* lds, const Sched2& S, const Epi& E) {
    const int tid = threadIdx.x, wid = __builtin_amdgcn_readfirstlane(tid >> 6), lane = tid & 63, wr = wid >> 2, wc = wid & 3, fr = lane & 15, fq = lane >> 4;
    const int K = S.K, nt = K / BK;
    unsigned voffA[2], voffB[2];
#pragma unroll
    for (int i = 0; i < 2; ++i) { int R, C; stage_rc(tid * 16 + i * 8192, R, C); const int Rb = Epi::PERM ? ((R & ~31) + perm32(R & 31)) : R;
        voffA[i] = (unsigned)(R * K + C) * 2u; voffB[i] = (unsigned)(Rb * K + C) * 2u; }
    const size_t kstep = (size_t)(BK * 2);
    const size_t hstep = (size_t)HALF * K * 2;
    const unsigned ldsw = (unsigned)wid * 1024u;
    const int aoff = lds_byte(wr * 64 + fr, fq * 8), boff = lds_byte(wc * 32 + fr, fq * 8);
#define PG8_SA(b, h) (((b) * 2 + (h)) * HTB)
#define PG8_SB(b, h) ((4 + (b) * 2 + (h)) * HTB)
#define PG8_STAGE(bufoff, gbase, voff) do { _Pragma("unroll") for (int _i = 0; _i < 2; ++_i) \
        __builtin_amdgcn_global_load_lds((const unsigned*)((const char*)(gbase) + (voff)[_i]), (LAS unsigned*)(lds + (bufoff) + ldsw + _i * 8192), 16, 0, 0); } while (0)
#define PG8_LDA(dst, b, h) do { _Pragma("unroll") for (int m = 0; m < 4; ++m) _Pragma("unroll") for (int k = 0; k < 2; ++k) dst[m][k] = *(const LAS bf16x8*)(lds + PG8_SA(b, h) + aoff + m * 2048 + k * 1024); } while (0)
#define PG8_LDB(dst, b, h) do { _Pragma("unroll") for (int n = 0; n < 2; ++n) _Pragma("unroll") for (int k = 0; k < 2; ++k) dst[n][k] = *(const LAS bf16x8*)(lds + PG8_SB(b, h) + boff + n * 2048 + k * 1024); } while (0)
#define PG8_MMA(ai, bj, At, Bt) do { __builtin_amdgcn_s_setprio(1); _Pragma("unroll") for (int m = 0; m < 4; ++m) _Pragma("unroll") for (int n = 0; n < 2; ++n) _Pragma("unroll") for (int k = 0; k < 2; ++k) \
        acc[ai][bj][m][n] = __builtin_amdgcn_mfma_f32_16x16x32_bf16(Bt[n][k], At[m][k], acc[ai][bj][m][n], 0, 0, 0); __builtin_amdgcn_s_setprio(0); } while (0)
#define PG8_WAIT_V(n) asm volatile("s_waitcnt vmcnt(" #n ")" ::: "memory")
#define PG8_WAIT_L(n) asm volatile("s_waitcnt lgkmcnt(" #n ")" ::: "memory")
#define PG8_BAR __builtin_amdgcn_s_barrier()
#define PG8_SCHED __builtin_amdgcn_sched_barrier(0)
    Unit cur, nxt; int ui = 0;
    if (!S.next(0, cur)) return;
    f32x4 acc[2][2][4][2];
#pragma unroll
    for (int a = 0; a < 2; ++a)
#pragma unroll
        for (int b = 0; b < 2; ++b)
#pragma unroll
            for (int m = 0; m < 4; ++m)
#pragma unroll
                for (int n = 0; n < 2; ++n) acc[a][b][m][n] = (f32x4){0.f, 0.f, 0.f, 0.f};
    bf16x8 At[4][2], B0[2][2], B1[2][2];
    const char* cA = S.baseA(cur); const char* cB = S.baseB(cur);
    if constexpr (SP2) {
        PG8_STAGE(PG8_SB(0, 0), cB, voffB); PG8_STAGE(PG8_SB(0, 1), cB + hstep, voffB); PG8_STAGE(PG8_SA(0, 0), cA, voffA); PG8_STAGE(PG8_SA(0, 1), cA + hstep, voffA);
        if (wr == 1) PG8_BAR;
        PG8_WAIT_V(2); PG8_BAR;
        PG8_STAGE(PG8_SB(1, 0), cB + kstep, voffB); PG8_STAGE(PG8_SA(1, 0), cA + kstep, voffA); PG8_STAGE(PG8_SB(1, 1), cB + hstep + kstep, voffB);
        PG8_WAIT_V(6); PG8_BAR;
    } else {
        PG8_STAGE(PG8_SB(0, 0), cB, voffB); PG8_STAGE(PG8_SA(0, 0), cA, voffA); PG8_STAGE(PG8_SB(0, 1), cB + hstep, voffB); PG8_STAGE(PG8_SA(0, 1), cA + hstep, voffA);
        if (wr == 1) PG8_BAR;
        PG8_WAIT_V(4); PG8_BAR;
        PG8_STAGE(PG8_SB(1, 0), cB + kstep, voffB); PG8_STAGE(PG8_SA(1, 0), cA + kstep, voffA); PG8_STAGE(PG8_SB(1, 1), cB + hstep + kstep, voffB);
        PG8_WAIT_V(6); PG8_BAR;
    }
    for (;;) {
        const bool has_next = S.next(ui + 1, nxt);
        const char* nA = has_next ? S.baseA(nxt) : cA; const char* nB = has_next ? S.baseB(nxt) : cB;
        for (int t = 0; t < nt; t += 2) {
            const bool last = (t == nt - 2);
            const char* a1 = cA + (size_t)(t + 1) * kstep;
            const char* a2 = last ? nA : cA + (size_t)(t + 2) * kstep; const char* b2 = last ? nB : cB + (size_t)(t + 2) * kstep;
            const char* a3 = a2 + kstep; const char* b3 = b2 + kstep;
            if constexpr (SP2) {
            PG8_LDB(B0, 0, 0); PG8_LDB(B1, 0, 1); PG8_SCHED; PG8_LDA(At, 0, 0); PG8_STAGE(PG8_SA(1, 1), a1 + hstep, voffA);
            PG8_WAIT_V(8); PG8_WAIT_L(0); PG8_BAR; PG8_MMA(0, 0, At, B0); PG8_MMA(0, 1, At, B1); PG8_BAR; PG8_SCHED;
            PG8_LDA(At, 0, 1); PG8_STAGE(PG8_SB(0, 0), b2, voffB); PG8_STAGE(PG8_SB(0, 1), b2 + hstep, voffB); PG8_STAGE(PG8_SA(0, 0), a2, voffA);
            PG8_WAIT_V(8); PG8_WAIT_L(0); PG8_BAR; PG8_MMA(1, 0, At, B0); PG8_MMA(1, 1, At, B1); PG8_BAR; PG8_SCHED;
            PG8_LDB(B0, 1, 0); PG8_LDB(B1, 1, 1); PG8_SCHED; PG8_LDA(At, 1, 0); PG8_STAGE(PG8_SA(0, 1), a2 + hstep, voffA);
            PG8_WAIT_V(8); PG8_WAIT_L(0); PG8_BAR; PG8_MMA(0, 0, At, B0); PG8_MMA(0, 1, At, B1); PG8_BAR; PG8_SCHED;
            PG8_LDA(At, 1, 1); PG8_STAGE(PG8_SB(1, 0), b3, voffB); PG8_STAGE(PG8_SB(1, 1), b3 + hstep, voffB); PG8_STAGE(PG8_SA(1, 0), a3, voffA);
            PG8_WAIT_V(8); PG8_WAIT_L(0); PG8_BAR; PG8_MMA(1, 0, At, B0); PG8_MMA(1, 1, At, B1); PG8_BAR; PG8_SCHED;
            } else {
            PG8_LDB(B0, 0, 0); PG8_SCHED; PG8_LDA(At, 0, 0); PG8_STAGE(PG8_SA(1, 1), a1 + hstep, voffA);
            PG8_WAIT_L(8); PG8_BAR; PG8_WAIT_L(0); PG8_MMA(0, 0, At, B0); PG8_BAR; PG8_SCHED;
            PG8_LDB(B1, 0, 1); PG8_STAGE(PG8_SB(0, 0), b2, voffB);
            PG8_BAR; PG8_WAIT_L(0); PG8_MMA(0, 1, At, B1); PG8_BAR;
            PG8_LDA(At, 0, 1); PG8_STAGE(PG8_SA(0, 0), a2, voffA);
            PG8_BAR; PG8_WAIT_L(0); PG8_MMA(1, 0, At, B0); PG8_BAR; PG8_SCHED;
            PG8_STAGE(PG8_SB(0, 1), b2 + hstep, voffB);
            PG8_WAIT_V(6); PG8_BAR; PG8_MMA(1, 1, At, B1); PG8_BAR;
            PG8_LDB(B0, 1, 0); PG8_SCHED; PG8_LDA(At, 1, 0); PG8_STAGE(PG8_SA(0, 1), a2 + hstep, voffA);
            PG8_WAIT_L(8); PG8_BAR; PG8_WAIT_L(0); PG8_MMA(0, 0, At, B0); PG8_BAR; PG8_SCHED;
            PG8_LDB(B1, 1, 1); PG8_STAGE(PG8_SB(1, 0), b3, voffB);
            PG8_BAR; PG8_WAIT_L(0); PG8_MMA(0, 1, At, B1); PG8_BAR;
            PG8_LDA(At, 1, 1); PG8_STAGE(PG8_SA(1, 0), a3, voffA);
            PG8_BAR; PG8_WAIT_L(0); PG8_MMA(1, 0, At, B0); PG8_BAR; PG8_SCHED;
            PG8_STAGE(PG8_SB(1, 1), b3 + hstep, voffB);
            PG8_WAIT_V(6); PG8_BAR; PG8_MMA(1, 1, At, B1); PG8_BAR;
            }
        }
        if constexpr (ALIGN_EPI) { if (wr == 0) PG8_BAR; }
        E(acc, cur, wr, wc, fr, fq);
        if (!has_next) break;
#pragma unroll
        for (int a = 0; a < 2; ++a)
#pragma unroll
            for (int b = 0; b < 2; ++b)
#pragma unroll
                for (int m = 0; m < 4; ++m)
#pragma unroll
                    for (int n = 0; n < 2; ++n) acc[a][b][m][n] = (f32x4){0.f, 0.f, 0.f, 0.f};
        cur = nxt; cA = nA; cB = nB; ++ui;
        if constexpr (ALIGN_EPI) { if (wr == 1) PG8_BAR; }
    }
    PG8_WAIT_V(0);
    if constexpr (!ALIGN_EPI) { if (wr == 0) PG8_BAR; }
    PG8_BAR;
#undef PG8_SA
#undef PG8_SB
#undef PG8_STAGE
#undef PG8_LDA
#undef PG8_LDB
#undef PG8_MMA
#undef PG8_WAIT_V
#undef PG8_WAIT_L
#undef PG8_BAR
#undef PG8_SCHED
}

struct EpiP1 {
    static constexpr bool PERM = true;
    bf16_t* U;
    __device__ __forceinline__ void operator()(const f32x4 (&acc)[2][2][4][2], const Unit& u, int wr, int wc, int fr, int fq) const {
        const int row0 = u.pm * BM + wr * 64 + fr;
        bf16_t* O = U + (size_t)(u.pn >> 3) * ((size_t)M * D);
        if (u.pn < 24) {
            const bool act = u.pn >= 8;
            const int col0 = (u.pn & 7) * 128 + wc * 32 + 8 * fq;
#pragma unroll
            for (int ai = 0; ai < 2; ++ai)
#pragma unroll
                for (int m = 0; m < 4; ++m) { bf16_t* rowp = O + (size_t)(row0 + ai * HALF + m * 16) * D + col0;
                    f32x4 a0 = acc[ai][0][m][0], a1 = acc[ai][0][m][1], b0 = acc[ai][1][m][0], b1 = acc[ai][1][m][1];
                    if (act) {
#pragma unroll
                        for (int j = 0; j < 4; ++j) { b0[j] = silu_f(b0[j]); b1[j] = silu_f(b1[j]); } }
                    a0 = a0 * b0; a1 = a1 * b1;
                    u32x4 w; w.x = cvt_pk_bf16(a0[0], a0[1]); w.y = cvt_pk_bf16(a0[2], a0[3]); w.z = cvt_pk_bf16(a1[0], a1[1]); w.w = cvt_pk_bf16(a1[2], a1[3]);
                    *(u32x4*)rowp = w; }
        } else {
            const int col0 = (u.pn - 24) * 256 + wc * 32 + 8 * fq;
#pragma unroll
            for (int ai = 0; ai < 2; ++ai)
#pragma unroll
                for (int m = 0; m < 4; ++m) { bf16_t* rowp = O + (size_t)(row0 + ai * HALF + m * 16) * D + col0;
#pragma unroll
                    for (int bj = 0; bj < 2; ++bj) { const f32x4 v0 = acc[ai][bj][m][0], v1 = acc[ai][bj][m][1];
                        u32x4 w; w.x = cvt_pk_bf16(v0[0], v0[1]); w.y = cvt_pk_bf16(v0[2], v0[3]); w.z = cvt_pk_bf16(v1[0], v1[1]); w.w = cvt_pk_bf16(v1[2], v1[3]);
                        *(u32x4*)(rowp + bj * HALF) = w; } }
        }
    }
};
struct EpiP5 {
    static constexpr bool PERM = true;
    bf16_t *Q, *VT; const float *qn, *kn;
    const float* ssq; const float* sw;
    __device__ __forceinline__ float rstd_of(int token, int part  ) const { const f32x4 p = *(const f32x4*)(ssq + (size_t)token * 16 + 4 * part); return (p[0] + p[1]) + (p[2] + p[3]); }
    __device__ __forceinline__ void operator()(const f32x4 (&acc)[2][2][4][2], const Unit& u, int wr, int wc, int fr, int fq) const {
        const int row0 = u.pm * BM + wr * 64 + fr;
        if (u.sel == 1) {
            const int col0 = u.pn * BM + wc * 32 + 8 * fq, bt = (u.pn * BM) / SEQ;
            float mine; { const int k = fr, tok = col0 + (k >> 3) * HALF + ((k >> 2) & 1) * 4 + (k & 3);
                const float t = (rstd_of(tok, 0) + rstd_of(tok, 1)) + (rstd_of(tok, 2) + rstd_of(tok, 3)); mine = __builtin_amdgcn_rsqf(t * (1.0f / D) + EPS); }
            f32x4 rs[2][2];
#pragma unroll
            for (int k = 0; k < 16; ++k) rs[k >> 3][(k >> 2) & 1][k & 3] = __shfl(mine, (fq << 4) | k);
#pragma unroll
            for (int ai = 0; ai < 2; ++ai)
#pragma unroll
                for (int m = 0; m < 4; ++m) { const int hd = row0 + ai * HALF + m * 16; const float swv = sw[bt * 4096 + 2048 + hd]; bf16_t* rowp = VT + (size_t)hd * M + col0;
#pragma unroll
                    for (int bj = 0; bj < 2; ++bj) { const f32x4 v0 = acc[ai][bj][m][0] * rs[bj][0] + swv, v1 = acc[ai][bj][m][1] * rs[bj][1] + swv;
                        u32x4 w; w.x = cvt_pk_bf16(v0[0], v0[1]); w.y = cvt_pk_bf16(v0[2], v0[3]); w.z = cvt_pk_bf16(v1[0], v1[1]); w.w = cvt_pk_bf16(v1[2], v1[3]);
                        *(u32x4*)(rowp + bj * HALF) = w; } }
            return;
        }
        const int bt = (u.pm * BM) / SEQ;
        float rs[2][4];
#pragma unroll
        for (int ai = 0; ai < 2; ++ai)
#pragma unroll
            for (int m = 0; m < 4; ++m) { float t = rstd_of(row0 + ai * HALF + m * 16, fq); t += __shfl_xor(t, 16); t += __shfl_xor(t, 32); rs[ai][m] = __builtin_amdgcn_rsqf(t * (1.0f / D) + EPS); }
        if (u.pn >= 8) {
            const int col0 = (u.pn - 8) * BM + wc * 32 + 8 * fq;
            f32x4 s4[2][2];
#pragma unroll
            for (int bj = 0; bj < 2; ++bj)
#pragma unroll
                for (int n = 0; n < 2; ++n) s4[bj][n] = *(const f32x4*)(sw + bt * 4096 + 3072 + col0 + bj * HALF + 4 * n);
#pragma unroll
            for (int ai = 0; ai < 2; ++ai)
#pragma unroll
                for (int m = 0; m < 4; ++m) { bf16_t* rowp = Q + 2 * (size_t)M * D + (size_t)(row0 + ai * HALF + m * 16) * D + col0;
#pragma unroll
                    for (int bj = 0; bj < 2; ++bj) { f32x4 v0 = acc[ai][bj][m][0] * rs[ai][m] + s4[bj][0], v1 = acc[ai][bj][m][1] * rs[ai][m] + s4[bj][1];
#pragma unroll
                        for (int j = 0; j < 4; ++j) { v0[j] = silu_f(v0[j]); v1[j] = silu_f(v1[j]); }
                        u32x4 w; w.x = cvt_pk_bf16(v0[0], v0[1]); w.y = cvt_pk_bf16(v0[2], v0[3]); w.z = cvt_pk_bf16(v1[0], v1[1]); w.w = cvt_pk_bf16(v1[2], v1[3]);
                        *(u32x4*)(rowp + bj * HALF) = w; } }
        } else {
            const bool isq = u.pn < 4; bf16_t* O = Q + (size_t)(u.pn >> 2) * ((size_t)M * D); const float* nw = qn; if (!isq) nw = kn; const float sc = isq ? (LOG2E * 0.125f) : 1.0f;
            const int col0 = (u.pn & 3) * BM + 64 * wc + 8 * fq;
            f32x4 w4[2][2], s4[2][2];
#pragma unroll
            for (int bj = 0; bj < 2; ++bj)
#pragma unroll
                for (int n = 0; n < 2; ++n) { w4[bj][n] = *(const f32x4*)(nw + 32 * bj + 8 * fq + 4 * n); s4[bj][n] = *(const f32x4*)(sw + bt * 4096 + (u.pn >> 2) * 1024 + col0 + 32 * bj + 4 * n); }
#pragma unroll
            for (int ai = 0; ai < 2; ++ai)
#pragma unroll
                for (int m = 0; m < 4; ++m) {
                    f32x4 v[2][2]; float ss = 0.f;
#pragma unroll
                    for (int bj = 0; bj < 2; ++bj)
#pragma unroll
                        for (int n = 0; n < 2; ++n) { v[bj][n] = acc[ai][bj][m][n] * rs[ai][m] + s4[bj][n]; const f32x4 t = v[bj][n]; ss += (t[0] * t[0] + t[1] * t[1]) + (t[2] * t[2] + t[3] * t[3]); }
                    ss += __shfl_xor(ss, 16); ss += __shfl_xor(ss, 32);
                    const float rq = __builtin_amdgcn_rsqf(ss * (1.0f / 64.0f) + EPS) * sc;
                    bf16_t* rowp = O + (size_t)(row0 + ai * HALF + m * 16) * D + col0;
#pragma unroll
                    for (int bj = 0; bj < 2; ++bj) { const f32x4 v0 = v[bj][0] * rq * w4[bj][0], v1 = v[bj][1] * rq * w4[bj][1];
                        u32x4 w; w.x = cvt_pk_bf16(v0[0], v0[1]); w.y = cvt_pk_bf16(v0[2], v0[3]); w.z = cvt_pk_bf16(v1[0], v1[1]); w.w = cvt_pk_bf16(v1[2], v1[3]);
                        *(u32x4*)(rowp + 32 * bj) = w; } }
        }
    }
};
template <bool STATS> struct EpiRes {
    static constexpr bool PERM = true;
    const void* base; void* out; const float* gate; const float* lng; const float* scale; bf16_t* xm; float* ssq;
    __device__ __forceinline__ void operator()(const f32x4 (&acc)[2][2][4][2], const Unit& u, int wr, int wc, int fr, int fq) const {
        const int row0 = u.pm * BM + wr * 64 + fr, col0 = u.pn * BM + wc * 32 + 8 * fq, bt = (u.pm * BM) / SEQ;
        f32x4 gv[2][2], mv[2][2];
#pragma unroll
        for (int bj = 0; bj < 2; ++bj)
#pragma unroll
            for (int n = 0; n < 2; ++n) { gv[bj][n] = *(const f32x4*)(gate + bt * 3072 + col0 + bj * HALF + 4 * n);
                if (STATS) mv[bj][n] = *(const f32x4*)(lng + col0 + bj * HALF + 4 * n) * (*(const f32x4*)(scale + bt * 3072 + col0 + bj * HALF + 4 * n) + 1.0f); }
#pragma unroll
        for (int ai = 0; ai < 2; ++ai)
#pragma unroll
            for (int m = 0; m < 4; ++m) { const int row = row0 + ai * HALF + m * 16; const size_t off = (size_t)row * D + col0; float ss = 0.f;
#pragma unroll
                for (int bj = 0; bj < 2; ++bj) { f32x4 b0, b1;
                    if (STATS) { b0 = *(const f32x4*)((const float*)base + off + bj * HALF); b1 = *(const f32x4*)((const float*)base + off + bj * HALF + 4); }
                    else { const u32x4 t = *(const u32x4*)((const bf16_t*)base + off + bj * HALF); b0 = (f32x4){bf_lo(t.x), bf_hi(t.x), bf_lo(t.y), bf_hi(t.y)}; b1 = (f32x4){bf_lo(t.z), bf_hi(t.z), bf_lo(t.w), bf_hi(t.w)}; }
                    const f32x4 o0 = b0 + gv[bj][0] * acc[ai][bj][m][0], o1 = b1 + gv[bj][1] * acc[ai][bj][m][1];
                    if (STATS) { u32x4 w; w.x = cvt_pk_bf16(o0[0], o0[1]); w.y = cvt_pk_bf16(o0[2], o0[3]); w.z = cvt_pk_bf16(o1[0], o1[1]); w.w = cvt_pk_bf16(o1[2], o1[3]);
                        *(u32x4*)((bf16_t*)out + off + bj * HALF) = w;
                        ss += (o0[0] * o0[0] + o0[1] * o0[1]) + (o0[2] * o0[2] + o0[3] * o0[3]) + (o1[0] * o1[0] + o1[1] * o1[1]) + (o1[2] * o1[2] + o1[3] * o1[3]);
                        const f32x4 x0 = o0 * mv[bj][0], x1 = o1 * mv[bj][1];
                        u32x4 w2; w2.x = cvt_pk_bf16(x0[0], x0[1]); w2.y = cvt_pk_bf16(x0[2], x0[3]); w2.z = cvt_pk_bf16(x1[0], x1[1]); w2.w = cvt_pk_bf16(x1[2], x1[3]);
                        *(u32x4*)(xm + off + bj * HALF) = w2; }
                    else { *(f32x4*)((float*)out + off + bj * HALF) = o0; *(f32x4*)((float*)out + off + bj * HALF + 4) = o1; } }
                if (STATS) { ss += __shfl_xor(ss, 16); ss += __shfl_xor(ss, 32); if (fq == 0) ssq[(size_t)row * 16 + u.pn * 4 + wc] = ss; } }
    }
};
}

#define XB_TMO      128
#define XB_XCNT(j)  (256  + 64 * (j))
#define XB_XSUB(j)  (1280 + 64 * (j))
#define XB_XGEN(j)  (2304 + 64 * (j))
#define XB_TOP      3328
#define XB_TOPGEN   3392
#define XCD_BAR_WORDS 3456
#define XB_SPIN_CAP (1u << 18)
__device__ __forceinline__ unsigned xb_ld(unsigned* p)              { return __hip_atomic_load(p, __ATOMIC_RELAXED, __HIP_MEMORY_SCOPE_AGENT); }
__device__ __forceinline__ unsigned xb_add(unsigned* p, unsigned v) { return __hip_atomic_fetch_add(p, v, __ATOMIC_RELAXED, __HIP_MEMORY_SCOPE_AGENT); }
__device__ __forceinline__ unsigned xb_xcc_id() { return (unsigned)__builtin_amdgcn_s_getreg((3 << 11) | 20) & 0xFu; }
#define XB_SPIN(cond, bar) do { unsigned _sp = 0; while (cond) { __builtin_amdgcn_s_sleep(1); \
    if ((++_sp & 255u) == 0u) { if (xb_ld(&(bar)[XB_TMO])) break; if (_sp > XB_SPIN_CAP) { atomicAdd(&(bar)[XB_TMO], 1u); break; } } } } while (0)
struct XcdBarrier { unsigned* bar; unsigned x; volatile LAS unsigned* st; };
__device__ __forceinline__ XcdBarrier xcd_barrier_post(unsigned* bar, volatile LAS unsigned* st) {
    XcdBarrier b; b.bar = bar; b.x = xb_xcc_id(); b.st = st;
    if (threadIdx.x == 0) (void)xb_add(&bar[XB_XCNT(b.x)], 1u);
    return b;
}
__device__ __forceinline__ void xcd_barrier_complete(unsigned* bar, unsigned x, unsigned& nloc, unsigned& nx) {
    const unsigned G = gridDim.x * gridDim.y * gridDim.z;
    unsigned sum, cnt, mine, sp = 0u;
    for (;;) {
        sum = 0u; cnt = 0u; mine = 0u;
#pragma unroll
        for (unsigned j = 0; j < 16; ++j) { const unsigned c = xb_ld(&bar[XB_XCNT(j)]); sum += c; cnt += (c > 0u) ? 1u : 0u; mine = (j == x) ? c : mine; }
        if (sum == G) break;
        __builtin_amdgcn_s_sleep(1);
        if ((++sp & 255u) == 0u) { if (xb_ld(&bar[XB_TMO])) break; if (sp > XB_SPIN_CAP) { atomicAdd(&bar[XB_TMO], 1u); break; } }
    }
    nloc = mine > 0u ? mine : 1u; nx = cnt > 0u ? cnt : 1u;
}
__device__ __forceinline__ void xcd_barrier(const XcdBarrier& b) {
    asm volatile("s_waitcnt vmcnt(0)" ::: "memory");
    __syncthreads();
    if (threadIdx.x == 0) {
        unsigned* bar = b.bar;
        __builtin_amdgcn_s_waitcnt(0);
        unsigned nloc = b.st[0], nx = b.st[1];
        if (nloc == 0u) { xcd_barrier_complete(bar, b.x, nloc, nx); b.st[0] = nloc; b.st[1] = nx; }
        const unsigned old = xb_add(&bar[XB_XSUB(b.x)], 1u);
        const unsigned gen = old / nloc;
        if (old + 1u == (gen + 1u) * nloc) {
            __builtin_amdgcn_fence(__ATOMIC_RELEASE, "agent");
            asm volatile("s_waitcnt vmcnt(0)" ::: "memory");
            const unsigned og = xb_add(&bar[XB_TOP], 1u);
            const unsigned tg = og / nx;
            if (og + 1u == (tg + 1u) * nx) xb_add(&bar[XB_TOPGEN], 1u);
            else XB_SPIN(xb_ld(&bar[XB_TOPGEN]) == tg, bar);
            __builtin_amdgcn_fence(__ATOMIC_ACQUIRE, "agent");
            xb_add(&bar[XB_XGEN(b.x)], 1u);
            asm volatile("s_waitcnt vmcnt(0)" ::: "memory");
        } else {
            XB_SPIN(xb_ld(&bar[XB_XGEN(b.x)]) == gen, bar);
            __builtin_amdgcn_fence(__ATOMIC_ACQUIRE, "agent");
            asm volatile("s_waitcnt vmcnt(0)" ::: "memory");
        }
    }
    __syncthreads();
}

struct Args {
    const float *x, *c, *ln_g, *ada_w, *ada_b, *w_in_ab, *conv_w, *sg_norm, *sg_w, *sg_b, *w_out_ab, *w_in_c, *q_norm, *k_norm, *w_out_c;
    float* out; unsigned char* ws; int ph_lo, ph_hi;
};

__device__ __forceinline__ int ab_row(int c) {
    const int seg = c >> 10, cc = c & 1023, t = cc >> 7, r = cc & 127;
    switch (seg) {
        case 1: return 256 * t + r;
        case 2: return 256 * t + 128 + r;
        case 0: return 256 * (8 + t) + r;
        case 3: return 256 * (8 + t) + 128 + r;
        case 4: return 256 * (16 + t) + r;
        case 6: return 256 * (16 + t) + 128 + r;
        default: return 256 * 24 + cc;
    }
}
__device__ __forceinline__ int c_row(int c) {
    const int seg = c >> 10, cc = c & 1023;
    if (seg == 2) return 3072 + cc;
    if (seg == 3) return 2048 + cc;
    const int tile = cc >> 8, ct = cc & 255, hh = ct >> 6, bj = (ct >> 5) & 1, i = ct & 31;
    return seg * 1024 + tile * 256 + 128 * bj + 32 * hh + i;
}
template <int MODE>
__device__ __forceinline__ void p0_transpose_item(const float* W, int K, int N, bf16_t* WT, LAS float* scr, int item, int lane) {
    const int nblk = N / 32, kb = item / nblk, nb = item % nblk, k0 = 64 * kb, n0 = 32 * nb;
    const int rb = MODE == 1 ? ab_row(n0) : (MODE == 2 ? c_row(n0) : n0);
#pragma unroll 8
    for (int i = 0; i < 32; ++i) { const int kk = 2 * i + (lane >> 5); scr[kk * 33 + (lane & 31)] = W[(size_t)(k0 + kk) * N + n0 + (lane & 31)]; }
    asm volatile("s_waitcnt lgkmcnt(0)" ::: "memory");
    const int c = lane & 7;
#pragma unroll
    for (int j = 0; j < 4; ++j) { const int n = (lane >> 3) + 8 * j; const LAS float* s = scr + (8 * c) * 33 + n;
        u32x4 o; o.x = cvt_pk_bf16(s[0 * 33], s[1 * 33]); o.y = cvt_pk_bf16(s[2 * 33], s[3 * 33]); o.z = cvt_pk_bf16(s[4 * 33], s[5 * 33]); o.w = cvt_pk_bf16(s[6 * 33], s[7 * 33]);
        *(u32x4*)(WT + (size_t)(rb + n) * K + k0 + 8 * c) = o; }
    asm volatile("s_waitcnt lgkmcnt(0)" ::: "memory");
}

__device__ __forceinline__ float wave_sum(float v) {
#pragma unroll
    for (int o = 1; o < 64; o <<= 1) v += __shfl_xor(v, o);
    return v;
}
__device__ __forceinline__ void rms_phase(const float* X, const float* g, const float* mod  , bf16_t* H, int gw, int NGW, int lane) {
    for (int b = 0; b < BATCH; ++b) {
        f32x4 mul[4], sh[4];
#pragma unroll
        for (int j = 0; j < 4; ++j) { const int col = 4 * lane + 256 * j; const f32x4 gg = *(const f32x4*)(g + col), sc = *(const f32x4*)(mod + b * 3072 + 1024 + col);
            sh[j] = *(const f32x4*)(mod + b * 3072 + col); mul[j] = gg * (sc + 1.0f); }
#pragma unroll 4
        for (int r = gw; r < SEQ; r += NGW) {
            const size_t m = (size_t)b * SEQ + r;
            const f32x4* xr = (const f32x4*)(X + m * D) + lane;
            f32x4 v[4]; float s = 0.f;
#pragma unroll
            for (int j = 0; j < 4; ++j) { v[j] = xr[64 * j]; s += (v[j].x * v[j].x + v[j].y * v[j].y) + (v[j].z * v[j].z + v[j].w * v[j].w); }
            const float rstd = __builtin_amdgcn_rsqf(wave_sum(s) * (1.f / D) + EPS);
            u32x2* o8 = (u32x2*)(H + m * D) + lane;
#pragma unroll
            for (int j = 0; j < 4; ++j) { const f32x4 o = v[j] * rstd * mul[j] + sh[j]; u32x2 w; w.x = cvt_pk_bf16(o.x, o.y); w.y = cvt_pk_bf16(o.z, o.w); o8[64 * j] = w; }
        }
    }
}

__device__ __forceinline__ void mixer_phase(LAS unsigned char* lds, const bf16_t* U, const bf16_t* Gt, const bf16_t* UZ, const bf16_t* V, const float* conv_w, const float* sg_norm,
                                            const bf16_t* WTR, const float* sg_b, bf16_t* Y, int vcu, int G) {
    const int tid = threadIdx.x, lane = tid & 63, w = __builtin_amdgcn_readfirstlane(tid >> 6), fr = lane & 15, fq = lane >> 4;
    constexpr int PT = 136;
    LAS bf16_t* VNT = (LAS bf16_t*)lds;
    LAS bf16_t* WL = (LAS bf16_t*)(lds + 128 * PT * 2);
    LAS float* SG = (LAS float*)(lds + 2 * 128 * PT * 2);
    int g_staged = -1;
    const int c8 = tid & 15, rg = tid >> 4;
    const int s = tid >> 2, qd = tid & 3;
    for (int unit = vcu; unit < BATCH * 64 * 8; unit += G) {
        const int g = unit & 7, cch = (unit >> 3) & 63, b = unit >> 9; const size_t r0 = (size_t)b * SEQ + cch * 128;
        const int ch = 128 * g + 8 * c8; const size_t row = r0 + 4 * rg;
        u32x4 ur[6], gv[4], vv[4], uz[4];
        const bool halo0 = (cch == 0 && rg == 0);
#pragma unroll
        for (int i = 0; i < 4; ++i) vv[i] = *(const u32x4*)(V + (r0 + s) * D + 128 * g + 32 * qd + 8 * i);
#pragma unroll
        for (int i = 0; i < 6; ++i) { if (i < 2 && halo0) ur[i] = (u32x4){0u, 0u, 0u, 0u}; else ur[i] = *(const u32x4*)(U + (row + i - 2) * D + ch); }
#pragma unroll
        for (int i = 0; i < 4; ++i) gv[i] = *(const u32x4*)(Gt + (row + i) * D + ch);
#pragma unroll
        for (int i = 0; i < 4; ++i) uz[i] = *(const u32x4*)(UZ + (r0 + s) * D + 128 * g + 32 * qd + 8 * i);
        if (g != g_staged) {
            __syncthreads();
            const bf16_t* wp = WTR + ((size_t)g * 128 + s) * 128 + 32 * qd;
#pragma unroll
            for (int i = 0; i < 4; ++i) *(LAS u32x4*)(WL + s * PT + 32 * qd + 8 * i) = *(const u32x4*)(wp + 8 * i);
            g_staged = g;
        }
        { float v[32]; float ss = 0.f;
#pragma unroll
          for (int i = 0; i < 4; ++i)
#pragma unroll
              for (int p = 0; p < 4; ++p) { v[8 * i + 2 * p] = bf_lo(vv[i][p]); v[8 * i + 2 * p + 1] = bf_hi(vv[i][p]); }
#pragma unroll
          for (int i = 0; i < 32; ++i) ss += v[i] * v[i];
          ss += __shfl_xor(ss, 1); ss += __shfl_xor(ss, 2);
          const float rs = __builtin_amdgcn_rsqf(ss * (1.0f / 128.0f) + EPS);
          const float* nw = sg_norm + g * 128 + 32 * qd;
#pragma unroll
          for (int i = 0; i < 32; i += 2) { const unsigned pk = cvt_pk_bf16(v[i] * rs * nw[i], v[i + 1] * rs * nw[i + 1]);
              VNT[(32 * qd + i) * PT + s] = (bf16_t)(pk & 0xffffu); VNT[(32 * qd + i + 1) * PT + s] = (bf16_t)(pk >> 16); }
        }
        { float cw[3][8];
#pragma unroll
          for (int k = 0; k < 3; ++k) { const f32x4 a = *(const f32x4*)(conv_w + k * D + ch), bq = *(const f32x4*)(conv_w + k * D + ch + 4);
              cw[k][0] = a.x; cw[k][1] = a.y; cw[k][2] = a.z; cw[k][3] = a.w; cw[k][4] = bq.x; cw[k][5] = bq.y; cw[k][6] = bq.z; cw[k][7] = bq.w; }
#pragma unroll
          for (int i = 0; i < 4; ++i) { float o[8];
#pragma unroll
              for (int p = 0; p < 4; ++p) { const unsigned u0 = ur[i][p], u1 = ur[i + 1][p], u2 = ur[i + 2][p];
                  o[2 * p] = bf_lo(gv[i][p]) * (cw[0][2 * p] * bf_lo(u0) + cw[1][2 * p] * bf_lo(u1) + cw[2][2 * p] * bf_lo(u2));
                  o[2 * p + 1] = bf_hi(gv[i][p]) * (cw[0][2 * p + 1] * bf_hi(u0) + cw[1][2 * p + 1] * bf_hi(u1) + cw[2][2 * p + 1] * bf_hi(u2)); }
              u32x4 wv; wv.x = cvt_pk_bf16(o[0], o[1]); wv.y = cvt_pk_bf16(o[2], o[3]); wv.z = cvt_pk_bf16(o[4], o[5]); wv.w = cvt_pk_bf16(o[6], o[7]);
              *(u32x4*)(Y + (row + i) * 2048 + ch) = wv; }
        }
        __syncthreads();
        f32x4 acc[8];
#pragma unroll
        for (int tt = 0; tt < 8; ++tt) acc[tt] = (f32x4){0.f, 0.f, 0.f, 0.f};
#pragma unroll
        for (int ks = 0; ks < 4; ++ks) { const bf16x8 a = *(const LAS bf16x8*)(VNT + (16 * w + fr) * PT + 32 * ks + 8 * fq);
#pragma unroll
            for (int tt = 2 * ks; tt < 8; ++tt) { const bf16x8 bw = *(const LAS bf16x8*)(WL + (16 * tt + fr) * PT + 32 * ks + 8 * fq);
                acc[tt] = __builtin_amdgcn_mfma_f32_16x16x32_bf16(a, bw, acc[tt], 0, 0, 0); } }
#pragma unroll
        for (int tt = 0; tt < 8; ++tt) { const int t = 16 * tt + fr; const float bb = sg_b[g * 128 + t];
            *(LAS f32x4*)(SG + t * 132 + 16 * w + 4 * fq) = acc[tt] + bb; }
        __syncthreads();
        { bf16_t* yp = Y + (r0 + s) * 2048 + 1024 + 128 * g + 32 * qd;
#pragma unroll
          for (int i = 0; i < 4; ++i) { const f32x4 s0 = *(const LAS f32x4*)(SG + s * 132 + 32 * qd + 8 * i), s1 = *(const LAS f32x4*)(SG + s * 132 + 32 * qd + 8 * i + 4);
              u32x4 wv; wv.x = cvt_pk_bf16(bf_lo(uz[i].x) * s0.x, bf_hi(uz[i].x) * s0.y); wv.y = cvt_pk_bf16(bf_lo(uz[i].y) * s0.z, bf_hi(uz[i].y) * s0.w);
              wv.z = cvt_pk_bf16(bf_lo(uz[i].z) * s1.x, bf_hi(uz[i].z) * s1.y); wv.w = cvt_pk_bf16(bf_lo(uz[i].w) * s1.z, bf_hi(uz[i].w) * s1.w);
              *(u32x4*)(yp + 8 * i) = wv; }
        }
    }
    __syncthreads();
}

__device__ __forceinline__ int crow(int i, int hi) { return (i & 3) + 8 * (i >> 2) + 4 * hi; }
__device__ __forceinline__ void attn_load_k(bf16x8 (&kf)[4], bool in_lds, LAS unsigned char* KL, int kl0, const bf16_t* kg, int ql, int hi) {
    if (in_lds) { const int r = kl0 + ql; LAS unsigned char* rp = KL + r * 128; const int sw = (r >> 1) & 7;
#pragma unroll
        for (int kk = 0; kk < 4; ++kk) kf[kk] = *(const LAS bf16x8*)(rp + (((2 * kk + hi) ^ sw) << 4));
    } else {
#pragma unroll
        for (int kk = 0; kk < 4; ++kk) kf[kk] = *(const bf16x8*)(kg + 16 * kk);
    }
}
__device__ __forceinline__ void attn_phase(LAS unsigned char* lds, const bf16_t* Q, const bf16_t* Kb, const bf16_t* VT, const bf16_t* Zs, bf16_t* OZ, int vcu, int G) {
    const int tid = threadIdx.x, lane = tid & 63, w = __builtin_amdgcn_readfirstlane(tid >> 6), ql = lane & 31, hi = lane >> 5;
    constexpr float STOP = 5.421010862427522e-20f;
    LAS unsigned char* KL = lds;
    LAS unsigned char* VL = lds + 65536;
    constexpr int NU = BATCH * 16 * (SEQ / 256);
    u32x4 sk[8], sv[8];
#define ATT_DECODE(u_, h_, rb_, q0b_, kw0_, nk_) const int h_ = ((u_) >> 5) & 15; const size_t rb_ = (size_t)((u_) >> 9) * SEQ; const int q0b_ = 256 * ((u_) & 31), kw0_ = q0b_ >= 256 ? q0b_ - 256 : 0, nk_ = q0b_ + 256 - kw0_;
#define ATT_LOAD_STAGE(u_) do { ATT_DECODE(u_, h__, rb__, q0b__, kw0__, nk__) \
        _Pragma("unroll") for (int i = 0; i < 8; ++i) { const int idx = tid + NTHR * i, r = idx >> 3, c = idx & 7; if (r < nk__) sk[i] = *(const u32x4*)(Kb + (rb__ + kw0__ + r) * D + h__ * 64 + 8 * c); } \
        _Pragma("unroll") for (int i = 0; i < 8; ++i) { const int idx = tid + NTHR * i, d = idx >> 6, ch = idx & 63; if (8 * ch < nk__) sv[i] = *(const u32x4*)(VT + (size_t)(h__ * 64 + d) * M + rb__ + kw0__ + 8 * ch); } } while (0)
    if (vcu < NU) ATT_LOAD_STAGE(vcu);
    for (int unit = vcu; unit < NU; unit += G) {
        ATT_DECODE(unit, h, rowbase, q0b, kw0, nk)
        const int qblk = unit & 31;
        const int qb = 8 * qblk + w, q0 = 32 * qb;
        bf16x8 qf[4];
        { const bf16_t* qp = Q + (rowbase + q0 + ql) * D + h * 64 + 8 * hi;
#pragma unroll
          for (int kk = 0; kk < 4; ++kk) qf[kk] = *(const bf16x8*)(qp + 16 * kk); }
        u32x2 zz[8];
        { const bf16_t* zp = Zs + (rowbase + q0 + ql) * D + h * 64 + 4 * hi;
#pragma unroll
          for (int g4 = 0; g4 < 4; ++g4) { zz[g4] = *(const u32x2*)(zp + 8 * g4); zz[4 + g4] = *(const u32x2*)(zp + 32 + 8 * g4); } }
#pragma unroll
        for (int i = 0; i < 8; ++i) { const int idx = tid + NTHR * i, r = idx >> 3, c = idx & 7;
            if (r < nk) *(LAS u32x4*)(KL + r * 128 + ((c ^ ((r >> 1) & 7)) << 4)) = sk[i]; }
#pragma unroll
        for (int i = 0; i < 8; ++i) { const int idx = tid + NTHR * i, d = idx >> 6, ch = idx & 63;
            if (8 * ch < nk) { u32x4 v = sv[i]; const int gp = (2 * ch) ^ (d & 31);
                if (d & 1) { const u32x4 t = v; v.x = t.z; v.y = t.w; v.z = t.x; v.w = t.y; }
                *(LAS u32x4*)(VL + d * 1024 + ((gp & ~1) << 3)) = v; } }
        __syncthreads();
        if (unit + G < NU) ATT_LOAD_STAGE(unit + G);
        f32x16 o0, o1;
#pragma unroll
        for (int i = 0; i < 16; ++i) { o0[i] = 0.f; o1[i] = 0.f; }
        float carry = 1.f;
        for (int kt = qb; kt >= 0; --kt) {
            const int key0 = 32 * kt; const bool in_lds = key0 >= kw0;
            u32x2 vf[2][2][2];
            if (in_lds) { const int g0 = ((key0 - kw0) >> 2) + hi;
#pragma unroll
                for (int dh = 0; dh < 2; ++dh) { LAS unsigned char* rp = VL + (32 * dh + ql) * 1024;
#pragma unroll
                    for (int s = 0; s < 2; ++s) { vf[dh][s][0] = *(const LAS u32x2*)(rp + (((g0 + 4 * s) ^ ql) << 3)); vf[dh][s][1] = *(const LAS u32x2*)(rp + (((g0 + 4 * s + 2) ^ ql) << 3)); } }
            } else { const bf16_t* vp = VT + (size_t)(h * 64 + ql) * M + rowbase + key0 + 4 * hi;
#pragma unroll
                for (int dh = 0; dh < 2; ++dh)
#pragma unroll
                    for (int s = 0; s < 2; ++s) { vf[dh][s][0] = *(const u32x2*)(vp + (size_t)dh * 32 * M + 16 * s); vf[dh][s][1] = *(const u32x2*)(vp + (size_t)dh * 32 * M + 16 * s + 8); } }
            bf16x8 kf[4];
            attn_load_k(kf, in_lds, KL, key0 - kw0, Kb + (rowbase + key0 + ql) * D + h * 64 + 8 * hi, ql, hi);
            f32x16 S;
#pragma unroll
            for (int i = 0; i < 16; ++i) S[i] = 0.f;
#pragma unroll
            for (int kk = 0; kk < 4; ++kk) S = __builtin_amdgcn_mfma_f32_32x32x16_bf16(kf[kk], qf[kk], S, 0, 0, 0);
            float be[16], om[16];
            const bool diag = (kt == qb);
#pragma unroll
            for (int i = 0; i < 16; ++i) { const float zc = __builtin_fmaxf(S[i], -126.0f); const float E = fast_exp2(-zc); float bv = fast_rcp(1.0f + E); float ov = E * bv;
                if (diag) { const bool valid = crow(i, hi) < ql; bv = valid ? bv : 0.f; ov = valid ? ov : 1.f; }
                be[i] = bv; om[i] = ov; }
            float gs[4], pg[4];
#pragma unroll
            for (int gi = 0; gi < 4; ++gi) { gs[gi] = (om[4 * gi] * om[4 * gi + 1]) * (om[4 * gi + 2] * om[4 * gi + 3]); pg[gi] = __shfl_xor(gs[gi], 32); }
            float run = carry; float wv[16];
#pragma unroll
            for (int gi = 3; gi >= 0; --gi) { const float base = hi == 0 ? run * pg[gi] : run;
                const float s3 = base, s2 = s3 * om[4 * gi + 3], s1 = s2 * om[4 * gi + 2], s0 = s1 * om[4 * gi + 1];
                wv[4 * gi + 3] = be[4 * gi + 3] * s3; wv[4 * gi + 2] = be[4 * gi + 2] * s2; wv[4 * gi + 1] = be[4 * gi + 1] * s1; wv[4 * gi] = be[4 * gi] * s0;
                run *= gs[gi] * pg[gi]; }
            carry = run;
#pragma unroll
            for (int s = 0; s < 2; ++s) { u32x4 pk; pk.x = cvt_pk_bf16(wv[8 * s], wv[8 * s + 1]); pk.y = cvt_pk_bf16(wv[8 * s + 2], wv[8 * s + 3]); pk.z = cvt_pk_bf16(wv[8 * s + 4], wv[8 * s + 5]); pk.w = cvt_pk_bf16(wv[8 * s + 6], wv[8 * s + 7]);
                const bf16x8 pf = __builtin_bit_cast(bf16x8, pk);
                { u32x4 a; a.x = vf[0][s][0].x; a.y = vf[0][s][0].y; a.z = vf[0][s][1].x; a.w = vf[0][s][1].y; o0 = __builtin_amdgcn_mfma_f32_32x32x16_bf16(__builtin_bit_cast(bf16x8, a), pf, o0, 0, 0, 0); }
                { u32x4 a; a.x = vf[1][s][0].x; a.y = vf[1][s][0].y; a.z = vf[1][s][1].x; a.w = vf[1][s][1].y; o1 = __builtin_amdgcn_mfma_f32_32x32x16_bf16(__builtin_bit_cast(bf16x8, a), pf, o1, 0, 0, 0); } }
            if (__all(carry < STOP)) break;
        }
        bf16_t* op = OZ + (rowbase + q0 + ql) * D + h * 64 + 4 * hi;
#pragma unroll
        for (int g4 = 0; g4 < 4; ++g4) {
            { const u32x2 z2 = zz[g4]; u32x2 wo; wo.x = cvt_pk_bf16(o0[4 * g4] * bf_lo(z2.x), o0[4 * g4 + 1] * bf_hi(z2.x)); wo.y = cvt_pk_bf16(o0[4 * g4 + 2] * bf_lo(z2.y), o0[4 * g4 + 3] * bf_hi(z2.y)); *(u32x2*)(op + 8 * g4) = wo; }
            { const u32x2 z2 = zz[4 + g4]; u32x2 wo; wo.x = cvt_pk_bf16(o1[4 * g4] * bf_lo(z2.x), o1[4 * g4 + 1] * bf_hi(z2.x)); wo.y = cvt_pk_bf16(o1[4 * g4 + 2] * bf_lo(z2.y), o1[4 * g4 + 3] * bf_hi(z2.y)); *(u32x2*)(op + 32 + 8 * g4) = wo; }
        }
        __syncthreads();
    }
#undef ATT_DECODE
#undef ATT_LOAD_STAGE
}

constexpr int N_PHASES = 9;
__global__ void __launch_bounds__(NTHR, 2) hybrid_fwd(Args a) {
    extern __shared__ __attribute__((aligned(16))) unsigned char lds_raw[];
    LAS unsigned char* lds = (LAS unsigned char*)lds_raw;
    const int tid = threadIdx.x, lane = tid & 63, wave = __builtin_amdgcn_readfirstlane(tid >> 6);
    const int G = gridDim.x, bx = blockIdx.x;
    const int vcu = (G % 8 == 0) ? (bx % 8) * (G / 8) + bx / 8 : bx;
    const int gw = vcu * NWAVES + wave, NGW = G * NWAVES;
    unsigned char* ws = a.ws;
    float* MOD = (float*)(ws + WS_MOD); float* SWp = (float*)(ws + WS_SW); float* SSQ = (float*)(ws + WS_SSQ);
    bf16_t* WAB = (bf16_t*)(ws + WS_WAB); bf16_t* WOAB = (bf16_t*)(ws + WS_WOAB); bf16_t* WC = (bf16_t*)(ws + WS_WC); bf16_t* WOC = (bf16_t*)(ws + WS_WOC);
    bf16_t* H0 = (bf16_t*)(ws + WS_H0); bf16_t* Y = (bf16_t*)(ws + WS_Y);
    bf16_t* Ub = (bf16_t*)(ws + WS_U); bf16_t* Gb = (bf16_t*)(ws + WS_G); bf16_t* UZb = (bf16_t*)(ws + WS_UZ); bf16_t* Vb = (bf16_t*)(ws + WS_V);
    bf16_t* X1 = (bf16_t*)(ws + WS_X1); bf16_t* H1 = (bf16_t*)(ws + WS_H1);
    bf16_t* Qb = (bf16_t*)(ws + WS_Q); bf16_t* Kb = (bf16_t*)(ws + WS_K); bf16_t* Zb = (bf16_t*)(ws + WS_Z); bf16_t* VTb = (bf16_t*)(ws + WS_VT); bf16_t* OZb = (bf16_t*)(ws + WS_OZ);
    const int lo = a.ph_lo, hi = a.ph_hi;
#define IN(k) (lo <= (k) && (k) < hi)
    volatile LAS unsigned* bst = (volatile LAS unsigned*)(lds + LDS_BYTES - 64);
    if (tid < 4) bst[tid] = 0u;
    __syncthreads();
    XcdBarrier xbar; xbar.bar = (unsigned*)(ws + WS_CTL); xbar.x = 0; xbar.st = bst;
    if (hi - lo > 1) xbar = xcd_barrier_post((unsigned*)(ws + WS_CTL), bst);
#define SEAM(k) do { if (IN(k) && IN((k) + 1)) xcd_barrier(xbar); } while (0)

    if (IN(0)) {
        for (int task = bx; task < 192; task += G) {
            LAS float* sc_l = (LAS float*)lds; LAS float* red = sc_l + 2048;
            for (int i = tid; i < BATCH * D; i += NTHR) { const float v = a.c[i]; sc_l[i] = v / (1.0f + __expf(-v)); }
            __syncthreads();
            const int l = task / 96, n0 = (task % 96) * 32, kc = wave * 2 + (lane >> 5), n = n0 + (lane & 31);
            const float* W = a.ada_w + (size_t)l * D * 3072 + (size_t)(kc * 64) * 3072 + n;
            float a0 = 0.f, a1 = 0.f;
#pragma unroll
            for (int k = 0; k < 64; ++k) { const float wv = W[(size_t)k * 3072]; a0 += sc_l[kc * 64 + k] * wv; a1 += sc_l[D + kc * 64 + k] * wv; }
            red[(kc * 2 + 0) * 32 + (lane & 31)] = a0; red[(kc * 2 + 1) * 32 + (lane & 31)] = a1;
            __syncthreads();
            if (tid < 64) { const int b = tid >> 5, nn = tid & 31; float s = 0.f;
#pragma unroll
                for (int k = 0; k < 16; ++k) s += red[(k * 2 + b) * 32 + nn];
                MOD[(l * 2 + b) * 3072 + n0 + nn] = s + a.ada_b[l * 3072 + n0 + nn]; }
            __syncthreads();
        }
        for (int i = gw * 64 + lane; i < 8 * 128 * 128 / 8; i += NGW * 64) {
            const int e0 = 8 * i, t = (e0 >> 7) & 127, s0 = e0 & 127; const f32x4 p = *(const f32x4*)(a.sg_w + e0), q = *(const f32x4*)(a.sg_w + e0 + 4);
            float e[8] = {p.x, p.y, p.z, p.w, q.x, q.y, q.z, q.w};
#pragma unroll
            for (int k = 0; k < 8; ++k) if (s0 + k > t) e[k] = 0.f;
            u32x4 wv; wv.x = cvt_pk_bf16(e[0], e[1]); wv.y = cvt_pk_bf16(e[2], e[3]); wv.z = cvt_pk_bf16(e[4], e[5]); wv.w = cvt_pk_bf16(e[6], e[7]);
            *(u32x4*)((bf16_t*)(ws + WS_WTR) + e0) = wv; }
        LAS float* scr = (LAS float*)(lds + wave * 16384);
        constexpr int I_AB = (D / 64) * (IN_AB / 32), I_OAB = (2048 / 64) * (D / 32), I_C = (D / 64) * (IN_C / 32), I_OC = (D / 64) * (D / 32);
        for (int it = gw; it < I_AB + I_OAB + I_C + I_OC; it += NGW) {
            int r = it;
            if (r < I_AB) { p0_transpose_item<1>(a.w_in_ab, D, IN_AB, WAB, scr, r, lane); continue; } r -= I_AB;
            if (r < I_OAB) { p0_transpose_item<0>(a.w_out_ab, 2048, D, WOAB, scr, r, lane); continue; } r -= I_OAB;
            if (r < I_C) { p0_transpose_item<2>(a.w_in_c, D, IN_C, WC, scr, r, lane); continue; } r -= I_C;
            p0_transpose_item<0>(a.w_out_c, D, D, WOC, scr, r, lane);
        }
    }
    SEAM(0);
    if (IN(1)) {
        rms_phase(a.x, a.ln_g, MOD, H0, gw, NGW, lane);
        for (int task = bx; task < IN_C / 16; task += G) {
            LAS float* red = (LAS float*)lds; const int kc = tid >> 4, col = tid & 15, n = 16 * task + col;
            const float* W = a.w_in_c + (size_t)(32 * kc) * IN_C + n; const float* s0 = MOD + 2 * 3072 + 32 * kc; const float* s1 = s0 + 3072;
            float a0 = 0.f, a1 = 0.f;
#pragma unroll
            for (int k = 0; k < 32; ++k) { const float wv = W[(size_t)k * IN_C]; a0 += s0[k] * wv; a1 += s1[k] * wv; }
            red[(kc * 2 + 0) * 16 + col] = a0; red[(kc * 2 + 1) * 16 + col] = a1;
            __syncthreads();
            if (tid < 32) { const int b = tid >> 4, cc = tid & 15; float sum = 0.f;
#pragma unroll
                for (int k = 0; k < 32; ++k) sum += red[(k * 2 + b) * 16 + cc];
                SWp[b * 4096 + 16 * task + cc] = sum; }
            __syncthreads();
        }
    }
    SEAM(1);
    if (IN(2)) { pg8::Sched2 S; S.init(H0, WAB, M, IN_AB, nullptr, nullptr, 0, 0, D, G, bx);
        pg8::EpiP1 E{Ub}; pg8::gemm_phase<pg8::EpiP1, true, true>(lds, S, E); }
    SEAM(2);
    if (IN(3)) mixer_phase(lds, Ub, Gb, UZb, Vb, a.conv_w, a.sg_norm, (const bf16_t*)(ws + WS_WTR), a.sg_b, Y, vcu, G);
    SEAM(3);
    if (IN(4)) { pg8::Sched2 S; S.init(Y, WOAB, M, D, nullptr, nullptr, 0, 0, 2048, G, bx);
        pg8::EpiRes<true> E{a.x, X1, MOD + 2048, a.ln_g + D, MOD + 2 * 3072 + 1024, H1, SSQ}; pg8::gemm_phase<pg8::EpiRes<true>, true, true>(lds, S, E); }
    if (IN(4) && IN(6)) xcd_barrier(xbar);
    if (IN(6)) { pg8::Sched2 S; S.init(H1, WC, M, 3072, WC + (size_t)3072 * D, H1, D, M, D, G, bx);
        pg8::EpiP5 E{Qb, VTb, a.q_norm, a.k_norm, SSQ, SWp}; pg8::gemm_phase<pg8::EpiP5, true, true>(lds, S, E); }
    SEAM(6);
    if (IN(7)) attn_phase(lds, Qb, Kb, VTb, Zb, OZb, vcu, G);
    SEAM(7);
    if (IN(8)) { pg8::Sched2 S; S.init(OZb, WOC, M, D, nullptr, nullptr, 0, 0, D, G, bx);
        pg8::EpiRes<false> E{X1, a.out, MOD + 2 * 3072 + 2048, nullptr, nullptr, nullptr, nullptr}; pg8::gemm_phase<pg8::EpiRes<false>, true, true>(lds, S, E); }
#undef IN
#undef SEAM
}

extern "C" void kernel_launch(void* const* d_in, const int* in_sizes, int n_in, void* d_out, int out_size, void* d_ws, size_t ws_size, hipStream_t stream) {
    static int grid = 0;
    if (grid == 0) {
        if (n_in != 15 || in_sizes[0] != M * D || out_size != M * D || ws_size < WS_END) { fprintf(stderr, "kernel_launch: unexpected problem geometry (n_in %d, ws %zu)\n", n_in, ws_size); grid = -1; return; }
        int dev = 0, cus = 0, per_cu = 0;
        (void)hipGetDevice(&dev); (void)hipDeviceGetAttribute(&cus, hipDeviceAttributeMultiprocessorCount, dev);
        if (hipFuncSetAttribute((const void*)hybrid_fwd, hipFuncAttributeMaxDynamicSharedMemorySize, LDS_BYTES) != hipSuccess) { fprintf(stderr, "kernel_launch: hipFuncSetAttribute failed\n"); grid = -1; return; }
        if (hipOccupancyMaxActiveBlocksPerMultiprocessor(&per_cu, (const void*)hybrid_fwd, NTHR, LDS_BYTES) != hipSuccess || per_cu < 1) { fprintf(stderr, "kernel_launch: occupancy query says %d\n", per_cu); per_cu = 1; }
        (void)hipGetLastError();
        grid = cus * per_cu;
    }
    if (grid < 0) return;
    Args a{};
    a.x = (const float*)d_in[0]; a.c = (const float*)d_in[1]; a.ln_g = (const float*)d_in[2]; a.ada_w = (const float*)d_in[3]; a.ada_b = (const float*)d_in[4];
    a.w_in_ab = (const float*)d_in[5]; a.conv_w = (const float*)d_in[6]; a.sg_norm = (const float*)d_in[7]; a.sg_w = (const float*)d_in[8]; a.sg_b = (const float*)d_in[9];
    a.w_out_ab = (const float*)d_in[10]; a.w_in_c = (const float*)d_in[11]; a.q_norm = (const float*)d_in[12]; a.k_norm = (const float*)d_in[13]; a.w_out_c = (const float*)d_in[14];
    a.out = (float*)d_out; a.ws = (unsigned char*)d_ws;
#if MK_MULTI
    for (int p = 0; p < N_PHASES; ++p) { a.ph_lo = p; a.ph_hi = p + 1; hipLaunchKernelGGL(hybrid_fwd, dim3(grid), dim3(NTHR), LDS_BYTES, stream, a); }
#else
    a.ph_lo = 0; a.ph_hi = N_PHASES;
    (void)hipMemsetAsync((char*)d_ws + WS_CTL, 0, CTL_ZERO_BYTES, stream);
    void* args[] = {&a};
    hipError_t e = hipLaunchCooperativeKernel((const void*)hybrid_fwd, dim3(grid), dim3(NTHR), args, LDS_BYTES, stream);
    if (e != hipSuccess) fprintf(stderr, "kernel_launch: cooperative launch failed: %s (grid %d)\n", hipGetErrorString(e), grid);
#endif
}
```

```cpp
#include <hip/hip_runtime.h>
#include <hip/hip_cooperative_groups.h>
#include <cstdio>
#include <cstdint>
namespace cg = cooperative_groups;

#ifndef MK_MULTI
#define MK_MULTI 0
#endif

#define LAS __attribute__((address_space(3)))
typedef unsigned short bf16_t;
typedef short bf16x8 __attribute__((ext_vector_type(8)));
typedef float f32x4 __attribute__((ext_vector_type(4)));
typedef float f32x16 __attribute__((ext_vector_type(16)));
typedef unsigned u32x4 __attribute__((ext_vector_type(4)));
typedef unsigned u32x2 __attribute__((ext_vector_type(2)));

constexpr int BATCH = 2, SEQ = 8192, D = 1024, M = BATCH * SEQ;
constexpr int IN_AB = 7168, IN_C = 4096;
constexpr float EPS = 1e-6f;
constexpr int NWAVES = 8, NTHR = 512;
constexpr float LOG2E = 1.4426950408889634f;

constexpr size_t MiB = 1u << 20;
constexpr size_t WS_CTL = 0, CTL_ZERO_BYTES = 64 * 1024;
constexpr size_t WS_MOD = 1 * MiB;
constexpr size_t WS_WAB = 2 * MiB;
constexpr size_t WS_WOAB = 16 * MiB;
constexpr size_t WS_WC = 20 * MiB;
constexpr size_t WS_WOC = 28 * MiB;
constexpr size_t WS_SSQ = 31 * MiB;
constexpr size_t WS_SW = 1 * MiB + 65536;
constexpr size_t WS_WTR = 30 * MiB;
constexpr size_t WS_U = 32 * MiB, WS_G = 64 * MiB, WS_UZ = 96 * MiB, WS_V = 128 * MiB;
constexpr size_t WS_H0 = 160 * MiB;
constexpr size_t WS_Y = 160 * MiB;
constexpr size_t WS_X1 = 32 * MiB;
constexpr size_t WS_H1 = 96 * MiB;
constexpr size_t WS_Q = 128 * MiB, WS_K = 160 * MiB, WS_Z = 192 * MiB, WS_VT = 224 * MiB;
constexpr size_t WS_OZ = 96 * MiB;
constexpr size_t WS_END = 256 * MiB;
static_assert(WS_G - WS_U == (size_t)M * D * 2 && WS_UZ - WS_G == (size_t)M * D * 2 && WS_V - WS_UZ == (size_t)M * D * 2 && WS_K - WS_Q == (size_t)M * D * 2 && WS_Z - WS_K == (size_t)M * D * 2, "contiguous activations");

constexpr int LDS_BYTES = 147456;

typedef float f32x2_t __attribute__((ext_vector_type(2))); typedef __bf16 bf16x2_t __attribute__((ext_vector_type(2)));
__device__ __forceinline__ unsigned cvt_pk_bf16(float lo, float hi) { f32x2_t v = {lo, hi}; bf16x2_t b = __builtin_convertvector(v, bf16x2_t); return __builtin_bit_cast(unsigned, b); }
__device__ __forceinline__ float bf_lo(unsigned u) { return __uint_as_float(u << 16); }
__device__ __forceinline__ float bf_hi(unsigned u) { return __uint_as_float(u & 0xffff0000u); }
__device__ __forceinline__ float fast_exp2(float x) { return __builtin_amdgcn_exp2f(x); }
__device__ __forceinline__ float fast_log2(float x) { return __builtin_amdgcn_logf(x); }
__device__ __forceinline__ float fast_rcp(float x) { return __builtin_amdgcn_rcpf(x); }
__device__ __forceinline__ float silu_f(float v) { return v * fast_rcp(1.0f + fast_exp2(-LOG2E * v)); }

namespace pg8 {
constexpr int BM = 256, BK = 64, HALF = 128, HTB = HALF * BK * 2, STAGE_BYTES = 8 * HTB, NXCD = 8, WGM = 8;
__host__ __device__ __forceinline__ int lds_byte(int r, int c) { const int st = (r >> 4) * 2 + (c >> 5), rr = r & 15, cc = c & 31, ob = rr * 64 + cc * 2; return st * 1024 + (ob ^ (((ob >> 9) & 1) << 5)); }
__host__ __device__ __forceinline__ void stage_rc(int b, int& R, int& C) { const int st = b / 1024, sb = b % 1024, swz = sb ^ (((sb >> 9) & 1) << 5); R = (st >> 1) * 16 + swz / 64; C = (st & 1) * 32 + (swz % 64) / 2; }
__host__ __device__ __forceinline__ int perm32(int rho) { const int n = rho >> 4, i = rho & 15; return 8 * (i >> 2) + 4 * n + (i & 3); }

struct Unit { int pm, pn, sel; };
struct Sched2 {
    const bf16_t *A0, *B0, *A1, *B1; int nM0, nN0, nwg0, nM1, nN1, nwg1, G, c, K;
    __device__ void init(const bf16_t* a0, const bf16_t* b0, int m0, int n0, const bf16_t* a1, const bf16_t* b1, int m1, int n1, int K_, int G_, int c_) {
        A0 = a0; B0 = b0; nM0 = m0 / BM; nN0 = n0 / BM; nwg0 = nM0 * nN0; A1 = a1; B1 = b1; nM1 = m1 / BM; nN1 = n1 / BM; nwg1 = nM1 * nN1; K = K_; G = G_; c = c_; }
    __device__ static void map(int wgid, int nM, int nN, int& pm, int& pn) {
        const int nwg = nM * nN; { const int q = nwg / NXCD, r = nwg % NXCD, xcd = wgid % NXCD, off = wgid / NXCD; wgid = (xcd < r ? xcd * (q + 1) : r * (q + 1) + (xcd - r) * q) + off; }
        const int nig = WGM * nN, gid = wgid / nig, fm = gid * WGM, gsz = (nM - fm) < WGM ? (nM - fm) : WGM;
        pm = fm + ((wgid % nig) % gsz); pn = (wgid % nig) / gsz; }
    __device__ bool next(int i, Unit& u) const {
        const int L = i * G + c;
        if (L < nwg0) { map(L, nM0, nN0, u.pm, u.pn); u.sel = 0; return true; }
        if (L < nwg0 + nwg1) { map(L - nwg0, nM1, nN1, u.pm, u.pn); u.sel = 1; return true; }
        return false; }
    __device__ __forceinline__ const char* baseA(const Unit& u) const { return (const char*)(u.sel ? A1 : A0) + (size_t)u.pm * BM * K * 2; }
    __device__ __forceinline__ const char* baseB(const Unit& u) const { return (const char*)(u.sel ? B1 : B0) + (size_t)u.pn * BM * K * 2; }
};

template <class Epi, bool ALIGN_EPI, bool SP2>
__device__ __forceinline__ void gemm_phase(LAS unsigned char* lds, const Sched2& S, const Epi& E) {
    const int tid = threadIdx.x, wid = __builtin_amdgcn_readfirstlane(tid >> 6), lane = tid & 63, wr = wid >> 2, wc = wid & 3, fr = lane & 15, fq = lane >> 4;
    const int K = S.K, nt = K / BK;
    unsigned voffA[2], voffB[2];
#pragma unroll
    for (int i = 0; i < 2; ++i) { int R, C; stage_rc(tid * 16 + i * 8192, R, C); const int Rb = Epi::PERM ? ((R & ~31) + perm32(R & 31)) : R;
        voffA[i] = (unsigned)(R * K + C) * 2u; voffB[i] = (unsigned)(Rb * K + C) * 2u; }
    const size_t kstep = (size_t)(BK * 2);
    const size_t hstep = (size_t)HALF * K * 2;
    const unsigned ldsw = (unsigned)wid * 1024u;
    const int aoff = lds_byte(wr * 64 + fr, fq * 8), boff = lds_byte(wc * 32 + fr, fq * 8);
#define PG8_SA(b, h) (((b) * 2 + (h)) * HTB)
#define PG8_SB(b, h) ((4 + (b) * 2 + (h)) * HTB)
#define PG8_STAGE(bufoff, gbase, voff) do { _Pragma("unroll") for (int _i = 0; _i < 2; ++_i) \
        __builtin_amdgcn_global_load_lds((const unsigned*)((const char*)(gbase) + (voff)[_i]), (LAS unsigned*)(lds + (bufoff) + ldsw + _i * 8192), 16, 0, 0); } while (0)
#define PG8_LDA(dst, b, h) do { _Pragma("unroll") for (int m = 0; m < 4; ++m) _Pragma("unroll") for (int k = 0; k < 2; ++k) dst[m][k] = *(const LAS bf16x8*)(lds + PG8_SA(b, h) + aoff + m * 2048 + k * 1024); } while (0)
#define PG8_LDB(dst, b, h) do { _Pragma("unroll") for (int n = 0; n < 2; ++n) _Pragma("unroll") for (int k = 0; k < 2; ++k) dst[n][k] = *(const LAS bf16x8*)(lds + PG8_SB(b, h) + boff + n * 2048 + k * 1024); } while (0)
#define PG8_MMA(ai, bj, At, Bt) do { __builtin_amdgcn_s_setprio(1); _Pragma("unroll") for (int m = 0; m < 4; ++m) _Pragma("unroll") for (int n = 0; n < 2; ++n) _Pragma("unroll") for (int k = 0; k < 2; ++k) \
        acc[ai][bj][m][n] = __builtin_amdgcn_mfma_f32_16x16x32_bf16(Bt[n][k], At[m][k], acc[ai][bj][m][n], 0, 0, 0); __builtin_amdgcn_s_setprio(0); } while (0)
#define PG8_WAIT_V(n) asm volatile("s_waitcnt vmcnt(" #n ")" ::: "memory")
#define PG8_WAIT_L(n) asm volatile("s_waitcnt lgkmcnt(" #n ")" ::: "memory")
#define PG8_BAR __builtin_amdgcn_s_barrier()
#define PG8_SCHED __builtin_amdgcn_sched_barrier(0)
    Unit cur, nxt; int ui = 0;
    if (!S.next(0, cur)) return;
    f32x4 acc[2][2][4][2];
#pragma unroll
    for (int a = 0; a < 2; ++a)
#pragma unroll
        for (int b = 0; b < 2; ++b)
#pragma unroll
            for (int m = 0; m < 4; ++m)
#pragma unroll
                for (int n = 0; n < 2; ++n) acc[a][b][m][n] = (f32x4){0.f, 0.f, 0.f, 0.f};
    bf16x8 At[4][2], B0[2][2], B1[2][2];
    const char* cA = S.baseA(cur); const char* cB = S.baseB(cur);
    if constexpr (SP2) {
        PG8_STAGE(PG8_SB(0, 0), cB, voffB); PG8_STAGE(PG8_SB(0, 1), cB + hstep, voffB); PG8_STAGE(PG8_SA(0, 0), cA, voffA); PG8_STAGE(PG8_SA(0, 1), cA + hstep, voffA);
        if (wr == 1) PG8_BAR;
        PG8_WAIT_V(2); PG8_BAR;
        PG8_STAGE(PG8_SB(1, 0), cB + kstep, voffB); PG8_STAGE(PG8_SA(1, 0), cA + kstep, voffA); PG8_STAGE(PG8_SB(1, 1), cB + hstep + kstep, voffB);
        PG8_WAIT_V(6); PG8_BAR;
    } else {
        PG8_STAGE(PG8_SB(0, 0), cB, voffB); PG8_STAGE(PG8_SA(0, 0), cA, voffA); PG8_STAGE(PG8_SB(0, 1), cB + hstep, voffB); PG8_STAGE(PG8_SA(0, 1), cA + hstep, voffA);
        if (wr == 1) PG8_BAR;
        PG8_WAIT_V(4); PG8_BAR;
        PG8_STAGE(PG8_SB(1, 0), cB + kstep, voffB); PG8_STAGE(PG8_SA(1, 0), cA + kstep, voffA); PG8_STAGE(PG8_SB(1, 1), cB + hstep + kstep, voffB);
        PG8_WAIT_V(6); PG8_BAR;
    }
    for (;;) {
        const bool has_next = S.next(ui + 1, nxt);
        const char* nA = has_next ? S.baseA(nxt) : cA; const char* nB = has_next ? S.baseB(nxt) : cB;
        for (int t = 0; t < nt; t += 2) {
            const bool last = (t == nt - 2);
            const char* a1 = cA + (size_t)(t + 1) * kstep;
            const char* a2 = last ? nA : cA + (size_t)(t + 2) * kstep; const char* b2 = last ? nB : cB + (size_t)(t + 2) * kstep;
            const char* a3 = a2 + kstep; const char* b3 = b2 + kstep;
            if constexpr (SP2) {
            PG8_LDB(B0, 0, 0); PG8_LDB(B1, 0, 1); PG8_SCHED; PG8_LDA(At, 0, 0); PG8_STAGE(PG8_SA(1, 1), a1 + hstep, voffA);
            PG8_WAIT_V(8); PG8_WAIT_L(0); PG8_BAR; PG8_MMA(0, 0, At, B0); PG8_MMA(0, 1, At, B1); PG8_BAR; PG8_SCHED;
            PG8_LDA(At, 0, 1); PG8_STAGE(PG8_SB(0, 0), b2, voffB); PG8_STAGE(PG8_SB(0, 1), b2 + hstep, voffB); PG8_STAGE(PG8_SA(0, 0), a2, voffA);
            PG8_WAIT_V(8); PG8_WAIT_L(0); PG8_BAR; PG8_MMA(1, 0, At, B0); PG8_MMA(1, 1, At, B1); PG8_BAR; PG8_SCHED;
            PG8_LDB(B0, 1, 0); PG8_LDB(B1, 1, 1); PG8_SCHED; PG8_LDA(At, 1, 0); PG8_STAGE(PG8_SA(0, 1), a2 + hstep, voffA);
            PG8_WAIT_V(8); PG8_WAIT_L(0); PG8_BAR; PG8_MMA(0, 0, At, B0); PG8_MMA(0, 1, At, B1); PG8_BAR; PG8_SCHED;
            PG8_LDA(At, 1, 1); PG8_STAGE(PG8_SB(1, 0), b3, voffB); PG8_STAGE(PG8_SB(1, 1), b3 + hstep, voffB); PG8_STAGE(PG8_SA(1, 0), a3, voffA);
            PG8_WAIT_V(8); PG8_WAIT_L(0); PG8_BAR; PG8_MMA(1, 0, At, B0); PG8_MMA(1, 1, At, B1); PG8_BAR; PG8_SCHED;
            } else {
            PG8_LDB(B0, 0, 0); PG8_SCHED; PG8_LDA(At, 0, 0); PG8_STAGE(PG8_SA(1, 1), a1 + hstep, voffA);
            PG8_WAIT_L(8); PG8_BAR; PG8_WAIT_L(0); PG8_MMA(0, 0, At, B0); PG8_BAR; PG8_SCHED;
            PG8_LDB(B1, 0, 1); PG8_STAGE(PG8_SB(0, 0), b2, voffB);
            PG8_BAR; PG8_WAIT_L(0); PG8_MMA(0, 1, At, B1); PG8_BAR;
            PG8_LDA(At, 0, 1); PG8_STAGE(PG8_SA(0, 0), a2, voffA);
            PG8_BAR; PG8_WAIT_L(0); PG8_MMA(1, 0, At, B0); PG8_BAR; PG8_SCHED;
            PG8_STAGE(PG8_SB(0, 1), b2 + hstep, voffB);
            PG8_WAIT_V(6); PG8_BAR; PG8_MMA(1, 1, At, B1); PG8_BAR;
            PG8_LDB(B0, 1, 0); PG8_SCHED; PG8_LDA(At, 1, 0); PG8_STAGE(PG8_SA(0, 1), a2 + hstep, voffA);
            PG8_WAIT_L(8); PG8_BAR; PG8_WAIT_L(0); PG8_MMA(0, 0, At, B0); PG8_BAR; PG8_SCHED;
            PG8_LDB(B1, 1, 1); PG8_STAGE(PG8_SB(1, 0), b3, voffB);
            PG8_BAR; PG8_WAIT_L(0); PG8_MMA(0, 1, At, B1); PG8_BAR;
            PG8_LDA(At, 1, 1); PG8_STAGE(PG8_SA(1, 0), a3, voffA);
            PG8_BAR; PG8_WAIT_L(0); PG8_MMA(1, 0, At, B0); PG8_BAR; PG8_SCHED;
            PG8_STAGE(PG8_SB(1, 1), b3 + hstep, voffB);
            PG8_WAIT_V(6); PG8_BAR; PG8_MMA(1, 1, At, B1); PG8_BAR;
            }
        }
        if constexpr (ALIGN_EPI) { if (wr == 0) PG8_BAR; }
        E(acc, cur, wr, wc, fr, fq);
        if (!has_next) break;
#pragma unroll
        for (int a = 0; a < 2; ++a)
#pragma unroll
            for (int b = 0; b < 2; ++b)
#pragma unroll
                for (int m = 0; m < 4; ++m)
#pragma unroll
                    for (int n = 0; n < 2; ++n) acc[a][b][m][n] = (f32x4){0.f, 0.f, 0.f, 0.f};
        cur = nxt; cA = nA; cB = nB; ++ui;
        if constexpr (ALIGN_EPI) { if (wr == 1) PG8_BAR; }
    }
    PG8_WAIT_V(0);
    if constexpr (!ALIGN_EPI) { if (wr == 0) PG8_BAR; }
    PG8_BAR;
#undef PG8_SA
#undef PG8_SB
#undef PG8_STAGE
#undef PG8_LDA
#undef PG8_LDB
#undef PG8_MMA
#undef PG8_WAIT_V
#undef PG8_WAIT_L
#undef PG8_BAR
#undef PG8_SCHED
}

struct EpiP1 {
    static constexpr bool PERM = true;
    bf16_t* U;
    __device__ __forceinline__ void operator()(const f32x4 (&acc)[2][2][4][2], const Unit& u, int wr, int wc, int fr, int fq) const {
        const int row0 = u.pm * BM + wr * 64 + fr;
        bf16_t* O = U + (size_t)(u.pn >> 3) * ((size_t)M * D);
        if (u.pn < 24) {
            const bool act = u.pn >= 8;
            const int col0 = (u.pn & 7) * 128 + wc * 32 + 8 * fq;
#pragma unroll
            for (int ai = 0; ai < 2; ++ai)
#pragma unroll
                for (int m = 0; m < 4; ++m) { bf16_t* rowp = O + (size_t)(row0 + ai * HALF + m * 16) * D + col0;
                    f32x4 a0 = acc[ai][0][m][0], a1 = acc[ai][0][m][1], b0 = acc[ai][1][m][0], b1 = acc[ai][1][m][1];
                    if (act) {
#pragma unroll
                        for (int j = 0; j < 4; ++j) { b0[j] = silu_f(b0[j]); b1[j] = silu_f(b1[j]); } }
                    a0 = a0 * b0; a1 = a1 * b1;
                    u32x4 w; w.x = cvt_pk_bf16(a0[0], a0[1]); w.y = cvt_pk_bf16(a0[2], a0[3]); w.z = cvt_pk_bf16(a1[0], a1[1]); w.w = cvt_pk_bf16(a1[2], a1[3]);
                    *(u32x4*)rowp = w; }
        } else {
            const int col0 = (u.pn - 24) * 256 + wc * 32 + 8 * fq;
#pragma unroll
            for (int ai = 0; ai < 2; ++ai)
#pragma unroll
                for (int m = 0; m < 4; ++m) { bf16_t* rowp = O + (size_t)(row0 + ai * HALF + m * 16) * D + col0;
#pragma unroll
                    for (int bj = 0; bj < 2; ++bj) { const f32x4 v0 = acc[ai][bj][m][0], v1 = acc[ai][bj][m][1];
                        u32x4 w; w.x = cvt_pk_bf16(v0[0], v0[1]); w.y = cvt_pk_bf16(v0[2], v0[3]); w.z = cvt_pk_bf16(v1[0], v1[1]); w.w = cvt_pk_bf16(v1[2], v1[3]);
                        *(u32x4*)(rowp + bj * HALF) = w; } }
        }
    }
};
struct EpiP5 {
    static constexpr bool PERM = true;
    bf16_t *Q, *VT; const float *qn, *kn;
    const float* ssq; const float* sw;
    __device__ __forceinline__ float rstd_of(int token, int part  ) const { const f32x4 p = *(const f32x4*)(ssq + (size_t)token * 16 + 4 * part); return (p[0] + p[1]) + (p[2] + p[3]); }
    __device__ __forceinline__ void operator()(const f32x4 (&acc)[2][2][4][2], const Unit& u, int wr, int wc, int fr, int fq) const {
        const int row0 = u.pm * BM + wr * 64 + fr;
        if (u.sel == 1) {
            const int col0 = u.pn * BM + wc * 32 + 8 * fq, bt = (u.pn * BM) / SEQ;
            float mine; { const int k = fr, tok = col0 + (k >> 3) * HALF + ((k >> 2) & 1) * 4 + (k & 3);
                const float t = (rstd_of(tok, 0) + rstd_of(tok, 1)) + (rstd_of(tok, 2) + rstd_of(tok, 3)); mine = __builtin_amdgcn_rsqf(t * (1.0f / D) + EPS); }
            f32x4 rs[2][2];
#pragma unroll
            for (int k = 0; k < 16; ++k) rs[k >> 3][(k >> 2) & 1][k & 3] = __shfl(mine, (fq << 4) | k);
#pragma unroll
            for (int ai = 0; ai < 2; ++ai)
#pragma unroll
                for (int m = 0; m < 4; ++m) { const int hd = row0 + ai * HALF + m * 16; const float swv = sw[bt * 4096 + 2048 + hd]; bf16_t* rowp = VT + (size_t)hd * M + col0;
#pragma unroll
                    for (int bj = 0; bj < 2; ++bj) { const f32x4 v0 = acc[ai][bj][m][0] * rs[bj][0] + swv, v1 = acc[ai][bj][m][1] * rs[bj][1] + swv;
                        u32x4 w; w.x = cvt_pk_bf16(v0[0], v0[1]); w.y = cvt_pk_bf16(v0[2], v0[3]); w.z = cvt_pk_bf16(v1[0], v1[1]); w.w = cvt_pk_bf16(v1[2], v1[3]);
                        *(u32x4*)(rowp + bj * HALF) = w; } }
            return;
        }
        const int bt = (u.pm * BM) / SEQ;
        float rs[2][4];
#pragma unroll
        for (int ai = 0; ai < 2; ++ai)
#pragma unroll
            for (int m = 0; m < 4; ++m) { float t = rstd_of(row0 + ai * HALF + m * 16, fq); t += __shfl_xor(t, 16); t += __shfl_xor(t, 32); rs[ai][m] = __builtin_amdgcn_rsqf(t * (1.0f / D) + EPS); }
        if (u.pn >= 8) {
            const int col0 = (u.pn - 8) * BM + wc * 32 + 8 * fq;
            f32x4 s4[2][2];
#pragma unroll
            for (int bj = 0; bj < 2; ++bj)
#pragma unroll
                for (int n = 0; n < 2; ++n) s4[bj][n] = *(const f32x4*)(sw + bt * 4096 + 3072 + col0 + bj * HALF + 4 * n);
#pragma unroll
            for (int ai = 0; ai < 2; ++ai)
#pragma unroll
                for (int m = 0; m < 4; ++m) { bf16_t* rowp = Q + 2 * (size_t)M * D + (size_t)(row0 + ai * HALF + m * 16) * D + col0;
#pragma unroll
                    for (int bj = 0; bj < 2; ++bj) { f32x4 v0 = acc[ai][bj][m][0] * rs[ai][m] + s4[bj][0], v1 = acc[ai][bj][m][1] * rs[ai][m] + s4[bj][1];
#pragma unroll
                        for (int j = 0; j < 4; ++j) { v0[j] = silu_f(v0[j]); v1[j] = silu_f(v1[j]); }
                        u32x4 w; w.x = cvt_pk_bf16(v0[0], v0[1]); w.y = cvt_pk_bf16(v0[2], v0[3]); w.z = cvt_pk_bf16(v1[0], v1[1]); w.w = cvt_pk_bf16(v1[2], v1[3]);
                        *(u32x4*)(rowp + bj * HALF) = w; } }
        } else {
            const bool isq = u.pn < 4; bf16_t* O = Q + (size_t)(u.pn >> 2) * ((size_t)M * D); const float* nw = qn; if (!isq) nw = kn; const float sc = isq ? (LOG2E * 0.125f) : 1.0f;
            const int col0 = (u.pn & 3) * BM + 64 * wc + 8 * fq;
            f32x4 w4[2][2], s4[2][2];
#pragma unroll
            for (int bj = 0; bj < 2; ++bj)
#pragma unroll
                for (int n = 0; n < 2; ++n) { w4[bj][n] = *(const f32x4*)(nw + 32 * bj + 8 * fq + 4 * n); s4[bj][n] = *(const f32x4*)(sw + bt * 4096 + (u.pn >> 2) * 1024 + col0 + 32 * bj + 4 * n); }
#pragma unroll
            for (int ai = 0; ai < 2; ++ai)
#pragma unroll
                for (int m = 0; m < 4; ++m) {
                    f32x4 v[2][2]; float ss = 0.f;
#pragma unroll
                    for (int bj = 0; bj < 2; ++bj)
#pragma unroll
                        for (int n = 0; n < 2; ++n) { v[bj][n] = acc[ai][bj][m][n] * rs[ai][m] + s4[bj][n]; const f32x4 t = v[bj][n]; ss += (t[0] * t[0] + t[1] * t[1]) + (t[2] * t[2] + t[3] * t[3]); }
                    ss += __shfl_xor(ss, 16); ss += __shfl_xor(ss, 32);
                    const float rq = __builtin_amdgcn_rsqf(ss * (1.0f / 64.0f) + EPS) * sc;
                    bf16_t* rowp = O + (size_t)(row0 + ai * HALF + m * 16) * D + col0;
#pragma unroll
                    for (int bj = 0; bj < 2; ++bj) { const f32x4 v0 = v[bj][0] * rq * w4[bj][0], v1 = v[bj][1] * rq * w4[bj][1];
                        u32x4 w; w.x = cvt_pk_bf16(v0[0], v0[1]); w.y = cvt_pk_bf16(v0[2], v0[3]); w.z = cvt_pk_bf16(v1[0], v1[1]); w.w = cvt_pk_bf16(v1[2], v1[3]);
                        *(u32x4*)(rowp + 32 * bj) = w; } }
        }
    }
};
template <bool STATS> struct EpiRes {
    static constexpr bool PERM = true;
    const void* base; void* out; const float* gate; const float* lng; const float* scale; bf16_t* xm; float* ssq;
    __device__ __forceinline__ void operator()(const f32x4 (&acc)[2][2][4][2], const Unit& u, int wr, int wc, int fr, int fq) const {
        const int row0 = u.pm * BM + wr * 64 + fr, col0 = u.pn * BM + wc * 32 + 8 * fq, bt = (u.pm * BM) / SEQ;
        f32x4 gv[2][2], mv[2][2];
#pragma unroll
        for (int bj = 0; bj < 2; ++bj)
#pragma unroll
            for (int n = 0; n < 2; ++n) { gv[bj][n] = *(const f32x4*)(gate + bt * 3072 + col0 + bj * HALF + 4 * n);
                if (STATS) mv[bj][n] = *(const f32x4*)(lng + col0 + bj * HALF + 4 * n) * (*(const f32x4*)(scale + bt * 3072 + col0 + bj * HALF + 4 * n) + 1.0f); }
        constexpr int MB = STATS ? 2 : 4;
#pragma unroll
        for (int ai = 0; ai < 2; ++ai)
#pragma unroll
        for (int mb = 0; mb < 4; mb += MB) {
            f32x4 bf[MB][2][2]; u32x4 bh[MB][2];
#pragma unroll
            for (int mm = 0; mm < MB; ++mm) { const size_t off = (size_t)(row0 + ai * HALF + (mb + mm) * 16) * D + col0;
#pragma unroll
                for (int bj = 0; bj < 2; ++bj) {
                    if (STATS) { bf[mm][bj][0] = *(const f32x4*)((const float*)base + off + bj * HALF); bf[mm][bj][1] = *(const f32x4*)((const float*)base + off + bj * HALF + 4); }
                    else bh[mm][bj] = *(const u32x4*)((const bf16_t*)base + off + bj * HALF); } }
#pragma unroll
            for (int mm = 0; mm < MB; ++mm) { const int m = mb + mm; const int row = row0 + ai * HALF + m * 16; const size_t off = (size_t)row * D + col0; float ss = 0.f;
#pragma unroll
                for (int bj = 0; bj < 2; ++bj) { f32x4 b0, b1;
                    if (STATS) { b0 = bf[mm][bj][0]; b1 = bf[mm][bj][1]; }
                    else { const u32x4 t = bh[mm][bj]; b0 = (f32x4){bf_lo(t.x), bf_hi(t.x), bf_lo(t.y), bf_hi(t.y)}; b1 = (f32x4){bf_lo(t.z), bf_hi(t.z), bf_lo(t.w), bf_hi(t.w)}; }
                    const f32x4 o0 = b0 + gv[bj][0] * acc[ai][bj][m][0], o1 = b1 + gv[bj][1] * acc[ai][bj][m][1];
                    if (STATS) { u32x4 w; w.x = cvt_pk_bf16(o0[0], o0[1]); w.y = cvt_pk_bf16(o0[2], o0[3]); w.z = cvt_pk_bf16(o1[0], o1[1]); w.w = cvt_pk_bf16(o1[2], o1[3]);
                        *(u32x4*)((bf16_t*)out + off + bj * HALF) = w;
                        ss += (o0[0] * o0[0] + o0[1] * o0[1]) + (o0[2] * o0[2] + o0[3] * o0[3]) + (o1[0] * o1[0] + o1[1] * o1[1]) + (o1[2] * o1[2] + o1[3] * o1[3]);
                        const f32x4 x0 = o0 * mv[bj][0], x1 = o1 * mv[bj][1];
                        u32x4 w2; w2.x = cvt_pk_bf16(x0[0], x0[1]); w2.y = cvt_pk_bf16(x0[2], x0[3]); w2.z = cvt_pk_bf16(x1[0], x1[1]); w2.w = cvt_pk_bf16(x1[2], x1[3]);
                        *(u32x4*)(xm + off + bj * HALF) = w2; }
                    else { *(f32x4*)((float*)out + off + bj * HALF) = o0; *(f32x4*)((float*)out + off + bj * HALF + 4) = o1; } }
                if (STATS) { ss += __shfl_xor(ss, 16); ss += __shfl_xor(ss, 32); if (fq == 0) ssq[(size_t)row * 16 + u.pn * 4 + wc] = ss; } }
        }
    }
};
}

#define XB_TMO      128
#define XB_XCNT(j)  (256  + 64 * (j))
#define XB_XSUB(j)  (1280 + 64 * (j))
#define XB_XGEN(j)  (2304 + 64 * (j))
#define XB_TOP      3328
#define XB_TOPGEN   3392
#define XCD_BAR_WORDS 3456
#define XB_SPIN_CAP (1u << 18)
__device__ __forceinline__ unsigned xb_ld(unsigned* p)              { return __hip_atomic_load(p, __ATOMIC_RELAXED, __HIP_MEMORY_SCOPE_AGENT); }
__device__ __forceinline__ unsigned xb_add(unsigned* p, unsigned v) { return __hip_atomic_fetch_add(p, v, __ATOMIC_RELAXED, __HIP_MEMORY_SCOPE_AGENT); }
__device__ __forceinline__ unsigned xb_xcc_id() { return (unsigned)__builtin_amdgcn_s_getreg((3 << 11) | 20) & 0xFu; }
#define XB_SPIN(cond, bar) do { unsigned _sp = 0; while (cond) { __builtin_amdgcn_s_sleep(1); \
    if ((++_sp & 255u) == 0u) { if (xb_ld(&(bar)[XB_TMO])) break; if (_sp > XB_SPIN_CAP) { atomicAdd(&(bar)[XB_TMO], 1u); break; } } } } while (0)
struct XcdBarrier { unsigned* bar; unsigned x; volatile LAS unsigned* st; };
__device__ __forceinline__ XcdBarrier xcd_barrier_post(unsigned* bar, volatile LAS unsigned* st) {
    XcdBarrier b; b.bar = bar; b.x = xb_xcc_id(); b.st = st;
    if (threadIdx.x == 0) (void)xb_add(&bar[XB_XCNT(b.x)], 1u);
    return b;
}
__device__ __forceinline__ void xcd_barrier_complete(unsigned* bar, unsigned x, unsigned& nloc, unsigned& nx) {
    const unsigned G = gridDim.x * gridDim.y * gridDim.z;
    unsigned sum, cnt, mine, sp = 0u;
    for (;;) {
        sum = 0u; cnt = 0u; mine = 0u;
#pragma unroll
        for (unsigned j = 0; j < 16; ++j) { const unsigned c = xb_ld(&bar[XB_XCNT(j)]); sum += c; cnt += (c > 0u) ? 1u : 0u; mine = (j == x) ? c : mine; }
        if (sum == G) break;
        __builtin_amdgcn_s_sleep(1);
        if ((++sp & 255u) == 0u) { if (xb_ld(&bar[XB_TMO])) break; if (sp > XB_SPIN_CAP) { atomicAdd(&bar[XB_TMO], 1u); break; } }
    }
    nloc = mine > 0u ? mine : 1u; nx = cnt > 0u ? cnt : 1u;
}
__device__ __forceinline__ void xcd_barrier(const XcdBarrier& b) {
    asm volatile("s_waitcnt vmcnt(0)" ::: "memory");
    __syncthreads();
    if (threadIdx.x == 0) {
        unsigned* bar = b.bar;
        __builtin_amdgcn_s_waitcnt(0);
        unsigned nloc = b.st[0], nx = b.st[1];
        if (nloc == 0u) { xcd_barrier_complete(bar, b.x, nloc, nx); b.st[0] = nloc; b.st[1] = nx; }
        const unsigned old = xb_add(&bar[XB_XSUB(b.x)], 1u);
        const unsigned gen = old / nloc;
        if (old + 1u == (gen + 1u) * nloc) {
            __builtin_amdgcn_fence(__ATOMIC_RELEASE, "agent");
            asm volatile("s_waitcnt vmcnt(0)" ::: "memory");
            const unsigned og = xb_add(&bar[XB_TOP], 1u);
            const unsigned tg = og / nx;
            if (og + 1u == (tg + 1u) * nx) xb_add(&bar[XB_TOPGEN], 1u);
            else XB_SPIN(xb_ld(&bar[XB_TOPGEN]) == tg, bar);
            __builtin_amdgcn_fence(__ATOMIC_ACQUIRE, "agent");
            xb_add(&bar[XB_XGEN(b.x)], 1u);
            asm volatile("s_waitcnt vmcnt(0)" ::: "memory");
        } else {
            XB_SPIN(xb_ld(&bar[XB_XGEN(b.x)]) == gen, bar);
            __builtin_amdgcn_fence(__ATOMIC_ACQUIRE, "agent");
            asm volatile("s_waitcnt vmcnt(0)" ::: "memory");
        }
    }
    __syncthreads();
}

struct Args {
    const float *x, *c, *ln_g, *ada_w, *ada_b, *w_in_ab, *conv_w, *sg_norm, *sg_w, *sg_b, *w_out_ab, *w_in_c, *q_norm, *k_norm, *w_out_c;
    float* out; unsigned char* ws; int ph_lo, ph_hi;
};

__device__ __forceinline__ int ab_row(int c) {
    const int seg = c >> 10, cc = c & 1023, t = cc >> 7, r = cc & 127;
    switch (seg) {
        case 1: return 256 * t + r;
        case 2: return 256 * t + 128 + r;
        case 0: return 256 * (8 + t) + r;
        case 3: return 256 * (8 + t) + 128 + r;
        case 4: return 256 * (16 + t) + r;
        case 6: return 256 * (16 + t) + 128 + r;
        default: return 256 * 24 + cc;
    }
}
__device__ __forceinline__ int c_row(int c) {
    const int seg = c >> 10, cc = c & 1023;
    if (seg == 2) return 3072 + cc;
    if (seg == 3) return 2048 + cc;
    const int tile = cc >> 8, ct = cc & 255, hh = ct >> 6, bj = (ct >> 5) & 1, i = ct & 31;
    return seg * 1024 + tile * 256 + 128 * bj + 32 * hh + i;
}
template <int MODE>
__device__ __forceinline__ void p0_transpose_item(const float* W, int K, int N, bf16_t* WT, LAS float* scr, int item, int lane) {
    const int nblk = N / 32, kb = item / nblk, nb = item % nblk, k0 = 64 * kb, n0 = 32 * nb;
    const int rb = MODE == 1 ? ab_row(n0) : (MODE == 2 ? c_row(n0) : n0);
#pragma unroll 8
    for (int i = 0; i < 32; ++i) { const int kk = 2 * i + (lane >> 5); scr[kk * 33 + (lane & 31)] = W[(size_t)(k0 + kk) * N + n0 + (lane & 31)]; }
    asm volatile("s_waitcnt lgkmcnt(0)" ::: "memory");
    const int c = lane & 7;
#pragma unroll
    for (int j = 0; j < 4; ++j) { const int n = (lane >> 3) + 8 * j; const LAS float* s = scr + (8 * c) * 33 + n;
        u32x4 o; o.x = cvt_pk_bf16(s[0 * 33], s[1 * 33]); o.y = cvt_pk_bf16(s[2 * 33], s[3 * 33]); o.z = cvt_pk_bf16(s[4 * 33], s[5 * 33]); o.w = cvt_pk_bf16(s[6 * 33], s[7 * 33]);
        *(u32x4*)(WT + (size_t)(rb + n) * K + k0 + 8 * c) = o; }
    asm volatile("s_waitcnt lgkmcnt(0)" ::: "memory");
}

__device__ __forceinline__ float wave_sum(float v) {
#pragma unroll
    for (int o = 1; o < 64; o <<= 1) v += __shfl_xor(v, o);
    return v;
}
__device__ __forceinline__ void rms_phase(const float* X, const float* g, const float* mod  , bf16_t* H, int gw, int NGW, int lane) {
    for (int b = 0; b < BATCH; ++b) {
        f32x4 mul[4], sh[4];
#pragma unroll
        for (int j = 0; j < 4; ++j) { const int col = 4 * lane + 256 * j; const f32x4 gg = *(const f32x4*)(g + col), sc = *(const f32x4*)(mod + b * 3072 + 1024 + col);
            sh[j] = *(const f32x4*)(mod + b * 3072 + col); mul[j] = gg * (sc + 1.0f); }
#pragma unroll 4
        for (int r = gw; r < SEQ; r += NGW) {
            const size_t m = (size_t)b * SEQ + r;
            const f32x4* xr = (const f32x4*)(X + m * D) + lane;
            f32x4 v[4]; float s = 0.f;
#pragma unroll
            for (int j = 0; j < 4; ++j) { v[j] = xr[64 * j]; s += (v[j].x * v[j].x + v[j].y * v[j].y) + (v[j].z * v[j].z + v[j].w * v[j].w); }
            const float rstd = __builtin_amdgcn_rsqf(wave_sum(s) * (1.f / D) + EPS);
            u32x2* o8 = (u32x2*)(H + m * D) + lane;
#pragma unroll
            for (int j = 0; j < 4; ++j) { const f32x4 o = v[j] * rstd * mul[j] + sh[j]; u32x2 w; w.x = cvt_pk_bf16(o.x, o.y); w.y = cvt_pk_bf16(o.z, o.w); o8[64 * j] = w; }
        }
    }
}

__device__ __forceinline__ void mixer_phase(LAS unsigned char* lds, const bf16_t* U, const bf16_t* Gt, const bf16_t* UZ, const bf16_t* V, const float* conv_w, const float* sg_norm,
                                            const bf16_t* WTR, const float* sg_b, bf16_t* Y, int vcu, int G) {
    const int tid = threadIdx.x, lane = tid & 63, w = __builtin_amdgcn_readfirstlane(tid >> 6), fr = lane & 15, fq = lane >> 4;
    constexpr int PT = 136;
    LAS bf16_t* VNT = (LAS bf16_t*)lds;
    LAS bf16_t* WL = (LAS bf16_t*)(lds + 128 * PT * 2);
    LAS float* SG = (LAS float*)(lds + 2 * 128 * PT * 2);
    int g_staged = -1;
    const int c8 = tid & 15, rg = tid >> 4;
    const int s = tid >> 2, qd = tid & 3;
    for (int unit = vcu; unit < BATCH * 64 * 8; unit += G) {
        const int g = unit & 7, cch = (unit >> 3) & 63, b = unit >> 9; const size_t r0 = (size_t)b * SEQ + cch * 128;
        const int ch = 128 * g + 8 * c8; const size_t row = r0 + 4 * rg;
        u32x4 ur[6], gv[4], vv[4], uz[4];
        const bool halo0 = (cch == 0 && rg == 0);
#pragma unroll
        for (int i = 0; i < 4; ++i) vv[i] = *(const u32x4*)(V + (r0 + s) * D + 128 * g + 32 * qd + 8 * i);
#pragma unroll
        for (int i = 0; i < 6; ++i) { if (i < 2 && halo0) ur[i] = (u32x4){0u, 0u, 0u, 0u}; else ur[i] = *(const u32x4*)(U + (row + i - 2) * D + ch); }
#pragma unroll
        for (int i = 0; i < 4; ++i) gv[i] = *(const u32x4*)(Gt + (row + i) * D + ch);
#pragma unroll
        for (int i = 0; i < 4; ++i) uz[i] = *(const u32x4*)(UZ + (r0 + s) * D + 128 * g + 32 * qd + 8 * i);
        if (g != g_staged) {
            __syncthreads();
            const bf16_t* wp = WTR + ((size_t)g * 128 + s) * 128 + 32 * qd;
#pragma unroll
            for (int i = 0; i < 4; ++i) *(LAS u32x4*)(WL + s * PT + 32 * qd + 8 * i) = *(const u32x4*)(wp + 8 * i);
            g_staged = g;
        }
        { float v[32]; float ss = 0.f;
#pragma unroll
          for (int i = 0; i < 4; ++i)
#pragma unroll
              for (int p = 0; p < 4; ++p) { v[8 * i + 2 * p] = bf_lo(vv[i][p]); v[8 * i + 2 * p + 1] = bf_hi(vv[i][p]); }
#pragma unroll
          for (int i = 0; i < 32; ++i) ss += v[i] * v[i];
          ss += __shfl_xor(ss, 1); ss += __shfl_xor(ss, 2);
          const float rs = __builtin_amdgcn_rsqf(ss * (1.0f / 128.0f) + EPS);
          const float* nw = sg_norm + g * 128 + 32 * qd;
#pragma unroll
          for (int i = 0; i < 32; i += 2) { const unsigned pk = cvt_pk_bf16(v[i] * rs * nw[i], v[i + 1] * rs * nw[i + 1]);
              VNT[(32 * qd + i) * PT + s] = (bf16_t)(pk & 0xffffu); VNT[(32 * qd + i + 1) * PT + s] = (bf16_t)(pk >> 16); }
        }
        { float cw[3][8];
#pragma unroll
          for (int k = 0; k < 3; ++k) { const f32x4 a = *(const f32x4*)(conv_w + k * D + ch), bq = *(const f32x4*)(conv_w + k * D + ch + 4);
              cw[k][0] = a.x; cw[k][1] = a.y; cw[k][2] = a.z; cw[k][3] = a.w; cw[k][4] = bq.x; cw[k][5] = bq.y; cw[k][6] = bq.z; cw[k][7] = bq.w; }
#pragma unroll
          for (int i = 0; i < 4; ++i) { float o[8];
#pragma unroll
              for (int p = 0; p < 4; ++p) { const unsigned u0 = ur[i][p], u1 = ur[i + 1][p], u2 = ur[i + 2][p];
                  o[2 * p] = bf_lo(gv[i][p]) * (cw[0][2 * p] * bf_lo(u0) + cw[1][2 * p] * bf_lo(u1) + cw[2][2 * p] * bf_lo(u2));
                  o[2 * p + 1] = bf_hi(gv[i][p]) * (cw[0][2 * p + 1] * bf_hi(u0) + cw[1][2 * p + 1] * bf_hi(u1) + cw[2][2 * p + 1] * bf_hi(u2)); }
              u32x4 wv; wv.x = cvt_pk_bf16(o[0], o[1]); wv.y = cvt_pk_bf16(o[2], o[3]); wv.z = cvt_pk_bf16(o[4], o[5]); wv.w = cvt_pk_bf16(o[6], o[7]);
              *(u32x4*)(Y + (row + i) * 2048 + ch) = wv; }
        }
        __syncthreads();
        f32x4 acc[8];
#pragma unroll
        for (int tt = 0; tt < 8; ++tt) acc[tt] = (f32x4){0.f, 0.f, 0.f, 0.f};
#pragma unroll
        for (int ks = 0; ks < 4; ++ks) { const bf16x8 a = *(const LAS bf16x8*)(VNT + (16 * w + fr) * PT + 32 * ks + 8 * fq);
#pragma unroll
            for (int tt = 2 * ks; tt < 8; ++tt) { const bf16x8 bw = *(const LAS bf16x8*)(WL + (16 * tt + fr) * PT + 32 * ks + 8 * fq);
                acc[tt] = __builtin_amdgcn_mfma_f32_16x16x32_bf16(a, bw, acc[tt], 0, 0, 0); } }
#pragma unroll
        for (int tt = 0; tt < 8; ++tt) { const int t = 16 * tt + fr; const float bb = sg_b[g * 128 + t];
            *(LAS f32x4*)(SG + t * 132 + 16 * w + 4 * fq) = acc[tt] + bb; }
        __syncthreads();
        { bf16_t* yp = Y + (r0 + s) * 2048 + 1024 + 128 * g + 32 * qd;
#pragma unroll
          for (int i = 0; i < 4; ++i) { const f32x4 s0 = *(const LAS f32x4*)(SG + s * 132 + 32 * qd + 8 * i), s1 = *(const LAS f32x4*)(SG + s * 132 + 32 * qd + 8 * i + 4);
              u32x4 wv; wv.x = cvt_pk_bf16(bf_lo(uz[i].x) * s0.x, bf_hi(uz[i].x) * s0.y); wv.y = cvt_pk_bf16(bf_lo(uz[i].y) * s0.z, bf_hi(uz[i].y) * s0.w);
              wv.z = cvt_pk_bf16(bf_lo(uz[i].z) * s1.x, bf_hi(uz[i].z) * s1.y); wv.w = cvt_pk_bf16(bf_lo(uz[i].w) * s1.z, bf_hi(uz[i].w) * s1.w);
              *(u32x4*)(yp + 8 * i) = wv; }
        }
    }
    __syncthreads();
}

__device__ __forceinline__ int crow(int i, int hi) { return (i & 3) + 8 * (i >> 2) + 4 * hi; }
__device__ __forceinline__ void attn_load_k(bf16x8 (&kf)[4], bool in_lds, LAS unsigned char* KL, int kl0, const bf16_t* kg, int ql, int hi) {
    if (in_lds) { const int r = kl0 + ql; LAS unsigned char* rp = KL + r * 128; const int sw = (r >> 1) & 7;
#pragma unroll
        for (int kk = 0; kk < 4; ++kk) kf[kk] = *(const LAS bf16x8*)(rp + (((2 * kk + hi) ^ sw) << 4));
    } else {
#pragma unroll
        for (int kk = 0; kk < 4; ++kk) kf[kk] = *(const bf16x8*)(kg + 16 * kk);
    }
}
__device__ __forceinline__ void attn_phase(LAS unsigned char* lds, const bf16_t* Q, const bf16_t* Kb, const bf16_t* VT, const bf16_t* Zs, bf16_t* OZ, int vcu, int G) {
    const int tid = threadIdx.x, lane = tid & 63, w = __builtin_amdgcn_readfirstlane(tid >> 6), ql = lane & 31, hi = lane >> 5;
    constexpr float STOP = 5.421010862427522e-20f;
    LAS unsigned char* KL = lds;
    LAS unsigned char* VL = lds + 65536;
    constexpr int NU = BATCH * 16 * (SEQ / 256);
    u32x4 sk[8], sv[8];
#define ATT_DECODE(u_, h_, rb_, q0b_, kw0_, nk_) const int h_ = ((u_) >> 5) & 15; const size_t rb_ = (size_t)((u_) >> 9) * SEQ; const int q0b_ = 256 * ((u_) & 31), kw0_ = q0b_ >= 256 ? q0b_ - 256 : 0, nk_ = q0b_ + 256 - kw0_;
#define ATT_LOAD_STAGE(u_) do { ATT_DECODE(u_, h__, rb__, q0b__, kw0__, nk__) \
        _Pragma("unroll") for (int i = 0; i < 8; ++i) { const int idx = tid + NTHR * i, r = idx >> 3, c = idx & 7; if (r < nk__) sk[i] = *(const u32x4*)(Kb + (rb__ + kw0__ + r) * D + h__ * 64 + 8 * c); } \
        _Pragma("unroll") for (int i = 0; i < 8; ++i) { const int idx = tid + NTHR * i, d = idx >> 6, ch = idx & 63; if (8 * ch < nk__) sv[i] = *(const u32x4*)(VT + (size_t)(h__ * 64 + d) * M + rb__ + kw0__ + 8 * ch); } } while (0)
    if (vcu < NU) ATT_LOAD_STAGE(vcu);
    for (int unit = vcu; unit < NU; unit += G) {
        ATT_DECODE(unit, h, rowbase, q0b, kw0, nk)
        const int qblk = unit & 31;
        const int qb = 8 * qblk + w, q0 = 32 * qb;
        bf16x8 qf[4];
        { const bf16_t* qp = Q + (rowbase + q0 + ql) * D + h * 64 + 8 * hi;
#pragma unroll
          for (int kk = 0; kk < 4; ++kk) qf[kk] = *(const bf16x8*)(qp + 16 * kk); }
        u32x2 zz[8];
        { const bf16_t* zp = Zs + (rowbase + q0 + ql) * D + h * 64 + 4 * hi;
#pragma unroll
          for (int g4 = 0; g4 < 4; ++g4) { zz[g4] = *(const u32x2*)(zp + 8 * g4); zz[4 + g4] = *(const u32x2*)(zp + 32 + 8 * g4); } }
#pragma unroll
        for (int i = 0; i < 8; ++i) { const int idx = tid + NTHR * i, r = idx >> 3, c = idx & 7;
            if (r < nk) *(LAS u32x4*)(KL + r * 128 + ((c ^ ((r >> 1) & 7)) << 4)) = sk[i]; }
#pragma unroll
        for (int i = 0; i < 8; ++i) { const int idx = tid + NTHR * i, d = idx >> 6, ch = idx & 63;
            if (8 * ch < nk) { u32x4 v = sv[i]; const int gp = (2 * ch) ^ (d & 31);
                if (d & 1) { const u32x4 t = v; v.x = t.z; v.y = t.w; v.z = t.x; v.w = t.y; }
                *(LAS u32x4*)(VL + d * 1024 + ((gp & ~1) << 3)) = v; } }
        __syncthreads();
        if (unit + G < NU) ATT_LOAD_STAGE(unit + G);
        f32x16 o0, o1;
#pragma unroll
        for (int i = 0; i < 16; ++i) { o0[i] = 0.f; o1[i] = 0.f; }
        float carry = 1.f;
        for (int kt = qb; kt >= 0; --kt) {
            const int key0 = 32 * kt; const bool in_lds = key0 >= kw0;
            u32x2 vf[2][2][2];
            if (in_lds) { const int g0 = ((key0 - kw0) >> 2) + hi;
#pragma unroll
                for (int dh = 0; dh < 2; ++dh) { LAS unsigned char* rp = VL + (32 * dh + ql) * 1024;
#pragma unroll
                    for (int s = 0; s < 2; ++s) { vf[dh][s][0] = *(const LAS u32x2*)(rp + (((g0 + 4 * s) ^ ql) << 3)); vf[dh][s][1] = *(const LAS u32x2*)(rp + (((g0 + 4 * s + 2) ^ ql) << 3)); } }
            } else { const bf16_t* vp = VT + (size_t)(h * 64 + ql) * M + rowbase + key0 + 4 * hi;
#pragma unroll
                for (int dh = 0; dh < 2; ++dh)
#pragma unroll
                    for (int s = 0; s < 2; ++s) { vf[dh][s][0] = *(const u32x2*)(vp + (size_t)dh * 32 * M + 16 * s); vf[dh][s][1] = *(const u32x2*)(vp + (size_t)dh * 32 * M + 16 * s + 8); } }
            bf16x8 kf[4];
            attn_load_k(kf, in_lds, KL, key0 - kw0, Kb + (rowbase + key0 + ql) * D + h * 64 + 8 * hi, ql, hi);
            f32x16 S;
#pragma unroll
            for (int i = 0; i < 16; ++i) S[i] = 0.f;
#pragma unroll
            for (int kk = 0; kk < 4; ++kk) S = __builtin_amdgcn_mfma_f32_32x32x16_bf16(kf[kk], qf[kk], S, 0, 0, 0);
            float be[16], om[16];
            const bool diag = (kt == qb);
#pragma unroll
            for (int i = 0; i < 16; ++i) { const float zc = __builtin_fmaxf(S[i], -126.0f); const float E = fast_exp2(-zc); float bv = fast_rcp(1.0f + E); float ov = E * bv;
                if (diag) { const bool valid = crow(i, hi) < ql; bv = valid ? bv : 0.f; ov = valid ? ov : 1.f; }
                be[i] = bv; om[i] = ov; }
            float gs[4], pg[4];
#pragma unroll
            for (int gi = 0; gi < 4; ++gi) { gs[gi] = (om[4 * gi] * om[4 * gi + 1]) * (om[4 * gi + 2] * om[4 * gi + 3]); pg[gi] = __shfl_xor(gs[gi], 32); }
            float run = carry; float wv[16];
#pragma unroll
            for (int gi = 3; gi >= 0; --gi) { const float base = hi == 0 ? run * pg[gi] : run;
                const float s3 = base, s2 = s3 * om[4 * gi + 3], s1 = s2 * om[4 * gi + 2], s0 = s1 * om[4 * gi + 1];
                wv[4 * gi + 3] = be[4 * gi + 3] * s3; wv[4 * gi + 2] = be[4 * gi + 2] * s2; wv[4 * gi + 1] = be[4 * gi + 1] * s1; wv[4 * gi] = be[4 * gi] * s0;
                run *= gs[gi] * pg[gi]; }
            carry = run;
#pragma unroll
            for (int s = 0; s < 2; ++s) { u32x4 pk; pk.x = cvt_pk_bf16(wv[8 * s], wv[8 * s + 1]); pk.y = cvt_pk_bf16(wv[8 * s + 2], wv[8 * s + 3]); pk.z = cvt_pk_bf16(wv[8 * s + 4], wv[8 * s + 5]); pk.w = cvt_pk_bf16(wv[8 * s + 6], wv[8 * s + 7]);
                const bf16x8 pf = __builtin_bit_cast(bf16x8, pk);
                { u32x4 a; a.x = vf[0][s][0].x; a.y = vf[0][s][0].y; a.z = vf[0][s][1].x; a.w = vf[0][s][1].y; o0 = __builtin_amdgcn_mfma_f32_32x32x16_bf16(__builtin_bit_cast(bf16x8, a), pf, o0, 0, 0, 0); }
                { u32x4 a; a.x = vf[1][s][0].x; a.y = vf[1][s][0].y; a.z = vf[1][s][1].x; a.w = vf[1][s][1].y; o1 = __builtin_amdgcn_mfma_f32_32x32x16_bf16(__builtin_bit_cast(bf16x8, a), pf, o1, 0, 0, 0); } }
            if (__all(carry < STOP)) break;
        }
        bf16_t* op = OZ + (rowbase + q0 + ql) * D + h * 64 + 4 * hi;
#pragma unroll
        for (int g4 = 0; g4 < 4; ++g4) {
            { const u32x2 z2 = zz[g4]; u32x2 wo; wo.x = cvt_pk_bf16(o0[4 * g4] * bf_lo(z2.x), o0[4 * g4 + 1] * bf_hi(z2.x)); wo.y = cvt_pk_bf16(o0[4 * g4 + 2] * bf_lo(z2.y), o0[4 * g4 + 3] * bf_hi(z2.y)); *(u32x2*)(op + 8 * g4) = wo; }
            { const u32x2 z2 = zz[4 + g4]; u32x2 wo; wo.x = cvt_pk_bf16(o1[4 * g4] * bf_lo(z2.x), o1[4 * g4 + 1] * bf_hi(z2.x)); wo.y = cvt_pk_bf16(o1[4 * g4 + 2] * bf_lo(z2.y), o1[4 * g4 + 3] * bf_hi(z2.y)); *(u32x2*)(op + 32 + 8 * g4) = wo; }
        }
        __syncthreads();
    }
#undef ATT_DECODE
#undef ATT_LOAD_STAGE
}

constexpr int N_PHASES = 9;
__global__ void __launch_bounds__(NTHR, 2) hybrid_fwd(Args a) {
    extern __shared__ __attribute__((aligned(16))) unsigned char lds_raw[];
    LAS unsigned char* lds = (LAS unsigned char*)lds_raw;
    const int tid = threadIdx.x, lane = tid & 63, wave = __builtin_amdgcn_readfirstlane(tid >> 6);
    const int G = gridDim.x, bx = blockIdx.x;
    const int vcu = (G % 8 == 0) ? (bx % 8) * (G / 8) + bx / 8 : bx;
    const int gw = vcu * NWAVES + wave, NGW = G * NWAVES;
    unsigned char* ws = a.ws;
    float* MOD = (float*)(ws + WS_MOD); float* SWp = (float*)(ws + WS_SW); float* SSQ = (float*)(ws + WS_SSQ);
    bf16_t* WAB = (bf16_t*)(ws + WS_WAB); bf16_t* WOAB = (bf16_t*)(ws + WS_WOAB); bf16_t* WC = (bf16_t*)(ws + WS_WC); bf16_t* WOC = (bf16_t*)(ws + WS_WOC);
    bf16_t* H0 = (bf16_t*)(ws + WS_H0); bf16_t* Y = (bf16_t*)(ws + WS_Y);
    bf16_t* Ub = (bf16_t*)(ws + WS_U); bf16_t* Gb = (bf16_t*)(ws + WS_G); bf16_t* UZb = (bf16_t*)(ws + WS_UZ); bf16_t* Vb = (bf16_t*)(ws + WS_V);
    bf16_t* X1 = (bf16_t*)(ws + WS_X1); bf16_t* H1 = (bf16_t*)(ws + WS_H1);
    bf16_t* Qb = (bf16_t*)(ws + WS_Q); bf16_t* Kb = (bf16_t*)(ws + WS_K); bf16_t* Zb = (bf16_t*)(ws + WS_Z); bf16_t* VTb = (bf16_t*)(ws + WS_VT); bf16_t* OZb = (bf16_t*)(ws + WS_OZ);
    const int lo = a.ph_lo, hi = a.ph_hi;
#define IN(k) (lo <= (k) && (k) < hi)
    volatile LAS unsigned* bst = (volatile LAS unsigned*)(lds + LDS_BYTES - 64);
    if (tid < 4) bst[tid] = 0u;
    __syncthreads();
    XcdBarrier xbar; xbar.bar = (unsigned*)(ws + WS_CTL); xbar.x = 0; xbar.st = bst;
    if (hi - lo > 1) xbar = xcd_barrier_post((unsigned*)(ws + WS_CTL), bst);
#define SEAM(k) do { if (IN(k) && IN((k) + 1)) xcd_barrier(xbar); } while (0)

    if (IN(0)) {
        for (int task = bx; task < 192; task += G) {
            LAS float* sc_l = (LAS float*)lds; LAS float* red = sc_l + 2048;
            for (int i = tid; i < BATCH * D; i += NTHR) { const float v = a.c[i]; sc_l[i] = v / (1.0f + __expf(-v)); }
            __syncthreads();
            const int l = task / 96, n0 = (task % 96) * 32, kc = wave * 2 + (lane >> 5), n = n0 + (lane & 31);
            const float* W = a.ada_w + (size_t)l * D * 3072 + (size_t)(kc * 64) * 3072 + n;
            float a0 = 0.f, a1 = 0.f;
#pragma unroll
            for (int k = 0; k < 64; ++k) { const float wv = W[(size_t)k * 3072]; a0 += sc_l[kc * 64 + k] * wv; a1 += sc_l[D + kc * 64 + k] * wv; }
            red[(kc * 2 + 0) * 32 + (lane & 31)] = a0; red[(kc * 2 + 1) * 32 + (lane & 31)] = a1;
            __syncthreads();
            if (tid < 64) { const int b = tid >> 5, nn = tid & 31; float s = 0.f;
#pragma unroll
                for (int k = 0; k < 16; ++k) s += red[(k * 2 + b) * 32 + nn];
                MOD[(l * 2 + b) * 3072 + n0 + nn] = s + a.ada_b[l * 3072 + n0 + nn]; }
            __syncthreads();
        }
        for (int i = gw * 64 + lane; i < 8 * 128 * 128 / 8; i += NGW * 64) {
            const int e0 = 8 * i, t = (e0 >> 7) & 127, s0 = e0 & 127; const f32x4 p = *(const f32x4*)(a.sg_w + e0), q = *(const f32x4*)(a.sg_w + e0 + 4);
            float e[8] = {p.x, p.y, p.z, p.w, q.x, q.y, q.z, q.w};
#pragma unroll
            for (int k = 0; k < 8; ++k) if (s0 + k > t) e[k] = 0.f;
            u32x4 wv; wv.x = cvt_pk_bf16(e[0], e[1]); wv.y = cvt_pk_bf16(e[2], e[3]); wv.z = cvt_pk_bf16(e[4], e[5]); wv.w = cvt_pk_bf16(e[6], e[7]);
            *(u32x4*)((bf16_t*)(ws + WS_WTR) + e0) = wv; }
        LAS float* scr = (LAS float*)(lds + wave * 16384);
        constexpr int I_AB = (D / 64) * (IN_AB / 32), I_OAB = (2048 / 64) * (D / 32), I_C = (D / 64) * (IN_C / 32), I_OC = (D / 64) * (D / 32);
        for (int it = gw; it < I_AB + I_OAB + I_C + I_OC; it += NGW) {
            int r = it;
            if (r < I_AB) { p0_transpose_item<1>(a.w_in_ab, D, IN_AB, WAB, scr, r, lane); continue; } r -= I_AB;
            if (r < I_OAB) { p0_transpose_item<0>(a.w_out_ab, 2048, D, WOAB, scr, r, lane); continue; } r -= I_OAB;
            if (r < I_C) { p0_transpose_item<2>(a.w_in_c, D, IN_C, WC, scr, r, lane); continue; } r -= I_C;
            p0_transpose_item<0>(a.w_out_c, D, D, WOC, scr, r, lane);
        }
    }
    SEAM(0);
    if (IN(1)) {
        rms_phase(a.x, a.ln_g, MOD, H0, gw, NGW, lane);
        for (int task = bx; task < IN_C / 16; task += G) {
            LAS float* red = (LAS float*)lds; const int kc = tid >> 4, col = tid & 15, n = 16 * task + col;
            const float* W = a.w_in_c + (size_t)(32 * kc) * IN_C + n; const float* s0 = MOD + 2 * 3072 + 32 * kc; const float* s1 = s0 + 3072;
            float a0 = 0.f, a1 = 0.f;
#pragma unroll
            for (int k = 0; k < 32; ++k) { const float wv = W[(size_t)k * IN_C]; a0 += s0[k] * wv; a1 += s1[k] * wv; }
            red[(kc * 2 + 0) * 16 + col] = a0; red[(kc * 2 + 1) * 16 + col] = a1;
            __syncthreads();
            if (tid < 32) { const int b = tid >> 4, cc = tid & 15; float sum = 0.f;
#pragma unroll
                for (int k = 0; k < 32; ++k) sum += red[(k * 2 + b) * 16 + cc];
                SWp[b * 4096 + 16 * task + cc] = sum; }
            __syncthreads();
        }
    }
    SEAM(1);
    if (IN(2)) { pg8::Sched2 S; S.init(H0, WAB, M, IN_AB, nullptr, nullptr, 0, 0, D, G, bx);
        pg8::EpiP1 E{Ub}; pg8::gemm_phase<pg8::EpiP1, true, true>(lds, S, E); }
    SEAM(2);
    if (IN(3)) mixer_phase(lds, Ub, Gb, UZb, Vb, a.conv_w, a.sg_norm, (const bf16_t*)(ws + WS_WTR), a.sg_b, Y, vcu, G);
    SEAM(3);
    if (IN(4)) { pg8::Sched2 S; S.init(Y, WOAB, M, D, nullptr, nullptr, 0, 0, 2048, G, bx);
        pg8::EpiRes<true> E{a.x, X1, MOD + 2048, a.ln_g + D, MOD + 2 * 3072 + 1024, H1, SSQ}; pg8::gemm_phase<pg8::EpiRes<true>, true, true>(lds, S, E); }
    if (IN(4) && IN(6)) xcd_barrier(xbar);
    if (IN(6)) { pg8::Sched2 S; S.init(H1, WC, M, 3072, WC + (size_t)3072 * D, H1, D, M, D, G, bx);
        pg8::EpiP5 E{Qb, VTb, a.q_norm, a.k_norm, SSQ, SWp}; pg8::gemm_phase<pg8::EpiP5, true, true>(lds, S, E); }
    SEAM(6);
    if (IN(7)) attn_phase(lds, Qb, Kb, VTb, Zb, OZb, vcu, G);
    SEAM(7);
    if (IN(8)) { pg8::Sched2 S; S.init(OZb, WOC, M, D, nullptr, nullptr, 0, 0, D, G, bx);
        pg8::EpiRes<false> E{X1, a.out, MOD + 2 * 3072 + 2048, nullptr, nullptr, nullptr, nullptr}; pg8::gemm_phase<pg8::EpiRes<false>, true, true>(lds, S, E); }
#undef IN
#undef SEAM
}

extern "C" void kernel_launch(void* const* d_in, const int* in_sizes, int n_in, void* d_out, int out_size, void* d_ws, size_t ws_size, hipStream_t stream) {
    static int grid = 0;
    if (grid == 0) {
        if (n_in != 15 || in_sizes[0] != M * D || out_size != M * D || ws_size < WS_END) { fprintf(stderr, "kernel_launch: unexpected problem geometry (n_in %d, ws %zu)\n", n_in, ws_size); grid = -1; return; }
        int dev = 0, cus = 0, per_cu = 0;
        (void)hipGetDevice(&dev); (void)hipDeviceGetAttribute(&cus, hipDeviceAttributeMultiprocessorCount, dev);
        if (hipFuncSetAttribute((const void*)hybrid_fwd, hipFuncAttributeMaxDynamicSharedMemorySize, LDS_BYTES) != hipSuccess) { fprintf(stderr, "kernel_launch: hipFuncSetAttribute failed\n"); grid = -1; return; }
        if (hipOccupancyMaxActiveBlocksPerMultiprocessor(&per_cu, (const void*)hybrid_fwd, NTHR, LDS_BYTES) != hipSuccess || per_cu < 1) { fprintf(stderr, "kernel_launch: occupancy query says %d\n", per_cu); per_cu = 1; }
        (void)hipGetLastError();
        grid = cus * per_cu;
    }
    if (grid < 0) return;
    Args a{};
    a.x = (const float*)d_in[0]; a.c = (const float*)d_in[1]; a.ln_g = (const float*)d_in[2]; a.ada_w = (const float*)d_in[3]; a.ada_b = (const float*)d_in[4];
    a.w_in_ab = (const float*)d_in[5]; a.conv_w = (const float*)d_in[6]; a.sg_norm = (const float*)d_in[7]; a.sg_w = (const float*)d_in[8]; a.sg_b = (const float*)d_in[9];
    a.w_out_ab = (const float*)d_in[10]; a.w_in_c = (const float*)d_in[11]; a.q_norm = (const float*)d_in[12]; a.k_norm = (const float*)d_in[13]; a.w_out_c = (const float*)d_in[14];
    a.out = (float*)d_out; a.ws = (unsigned char*)d_ws;
#if MK_MULTI
    for (int p = 0; p < N_PHASES; ++p) { a.ph_lo = p; a.ph_hi = p + 1; hipLaunchKernelGGL(hybrid_fwd, dim3(grid), dim3(NTHR), LDS_BYTES, stream, a); }
#else
    a.ph_lo = 0; a.ph_hi = N_PHASES;
    (void)hipMemsetAsync((char*)d_ws + WS_CTL, 0, CTL_ZERO_BYTES, stream);
    void* args[] = {&a};
    hipError_t e = hipLaunchCooperativeKernel((const void*)hybrid_fwd, dim3(grid), dim3(NTHR), args, LDS_BYTES, stream);
    if (e != hipSuccess) fprintf(stderr, "kernel_launch: cooperative launch failed: %s (grid %d)\n", hipGetErrorString(e), grid);
#endif
}
```

```cpp
#include <hip/hip_runtime.h>
#include <hip/hip_cooperative_groups.h>
#include <cstdio>
#include <cstdint>
namespace cg = cooperative_groups;

#ifndef MK_MULTI
#define MK_MULTI 0
#endif

#define LAS __attribute__((address_space(3)))
typedef unsigned short bf16_t;
typedef short bf16x8 __attribute__((ext_vector_type(8)));
typedef float f32x4 __attribute__((ext_vector_type(4)));
typedef float f32x16 __attribute__((ext_vector_type(16)));
typedef unsigned u32x4 __attribute__((ext_vector_type(4)));
typedef unsigned u32x2 __attribute__((ext_vector_type(2)));

constexpr int BATCH = 2, SEQ = 8192, D = 1024, M = BATCH * SEQ;
constexpr int IN_AB = 7168, IN_C = 4096;
constexpr float EPS = 1e-6f;
constexpr int NWAVES = 8, NTHR = 512;
constexpr float LOG2E = 1.4426950408889634f;

constexpr size_t MiB = 1u << 20;
constexpr size_t WS_CTL = 0, CTL_ZERO_BYTES = 64 * 1024;
constexpr size_t WS_MOD = 1 * MiB;
constexpr size_t WS_WAB = 2 * MiB;
constexpr size_t WS_WOAB = 16 * MiB;
constexpr size_t WS_WC = 20 * MiB;
constexpr size_t WS_WOC = 28 * MiB;
constexpr size_t WS_SSQ = 31 * MiB;
constexpr size_t WS_SW = 1 * MiB + 65536;
constexpr size_t WS_WTR = 30 * MiB;
constexpr size_t WS_U = 32 * MiB, WS_G = 64 * MiB, WS_UZ = 96 * MiB, WS_V = 128 * MiB;
constexpr size_t WS_H0 = 160 * MiB;
constexpr size_t WS_Y = 160 * MiB;
constexpr size_t WS_X1 = 32 * MiB;
constexpr size_t WS_H1 = 96 * MiB;
constexpr size_t WS_Q = 128 * MiB, WS_K = 160 * MiB, WS_Z = 192 * MiB, WS_VT = 224 * MiB;
constexpr size_t WS_OZ = 96 * MiB;
constexpr size_t WS_END = 256 * MiB;
static_assert(WS_G - WS_U == (size_t)M * D * 2 && WS_UZ - WS_G == (size_t)M * D * 2 && WS_V - WS_UZ == (size_t)M * D * 2 && WS_K - WS_Q == (size_t)M * D * 2 && WS_Z - WS_K == (size_t)M * D * 2, "contiguous activations");

constexpr int LDS_BYTES = 147456;

typedef float f32x2_t __attribute__((ext_vector_type(2))); typedef __bf16 bf16x2_t __attribute__((ext_vector_type(2)));
__device__ __forceinline__ unsigned cvt_pk_bf16(float lo, float hi) { f32x2_t v = {lo, hi}; bf16x2_t b = __builtin_convertvector(v, bf16x2_t); return __builtin_bit_cast(unsigned, b); }
__device__ __forceinline__ float bf_lo(unsigned u) { return __uint_as_float(u << 16); }
__device__ __forceinline__ float bf_hi(unsigned u) { return __uint_as_float(u & 0xffff0000u); }
__device__ __forceinline__ float fast_exp2(float x) { return __builtin_amdgcn_exp2f(x); }
__device__ __forceinline__ float fast_log2(float x) { return __builtin_amdgcn_logf(x); }
__device__ __forceinline__ float fast_rcp(float x) { return __builtin_amdgcn_rcpf(x); }
__device__ __forceinline__ float silu_f(float v) { return v * fast_rcp(1.0f + fast_exp2(-LOG2E * v)); }

namespace pg8 {
constexpr int BM = 256, BK = 64, HALF = 128, HTB = HALF * BK * 2, STAGE_BYTES = 8 * HTB, NXCD = 8, WGM = 8;
__host__ __device__ __forceinline__ int lds_byte(int r, int c) { const int st = (r >> 4) * 2 + (c >> 5), rr = r & 15, cc = c & 31, ob = rr * 64 + cc * 2; return st * 1024 + (ob ^ (((ob >> 9) & 1) << 5)); }
__host__ __device__ __forceinline__ void stage_rc(int b, int& R, int& C) { const int st = b / 1024, sb = b % 1024, swz = sb ^ (((sb >> 9) & 1) << 5); R = (st >> 1) * 16 + swz / 64; C = (st & 1) * 32 + (swz % 64) / 2; }
__host__ __device__ __forceinline__ int perm32(int rho) { const int n = rho >> 4, i = rho & 15; return 8 * (i >> 2) + 4 * n + (i & 3); }

struct Unit { int pm, pn, sel; };
struct Sched2 {
    const bf16_t *A0, *B0, *A1, *B1; int nM0, nN0, nwg0, nM1, nN1, nwg1, G, c, K;
    __device__ void init(const bf16_t* a0, const bf16_t* b0, int m0, int n0, const bf16_t* a1, const bf16_t* b1, int m1, int n1, int K_, int G_, int c_) {
        A0 = a0; B0 = b0; nM0 = m0 / BM; nN0 = n0 / BM; nwg0 = nM0 * nN0; A1 = a1; B1 = b1; nM1 = m1 / BM; nN1 = n1 / BM; nwg1 = nM1 * nN1; K = K_; G = G_; c = c_; }
    __device__ static void map(int wgid, int nM, int nN, int& pm, int& pn) {
        const int nwg = nM * nN; { const int q = nwg / NXCD, r = nwg % NXCD, xcd = wgid % NXCD, off = wgid / NXCD; wgid = (xcd < r ? xcd * (q + 1) : r * (q + 1) + (xcd - r) * q) + off; }
        const int nig = WGM * nN, gid = wgid / nig, fm = gid * WGM, gsz = (nM - fm) < WGM ? (nM - fm) : WGM;
        pm = fm + ((wgid % nig) % gsz); pn = (wgid % nig) / gsz; }
    __device__ bool next(int i, Unit& u) const {
        const int L = i * G + c;
        if (L < nwg0) { map(L, nM0, nN0, u.pm, u.pn); u.sel = 0; return true; }
        if (L < nwg0 + nwg1) { map(L - nwg0, nM1, nN1, u.pm, u.pn); u.sel = 1; return true; }
        return false; }
    __device__ __forceinline__ const char* baseA(const Unit& u) const { return (const char*)(u.sel ? A1 : A0) + (size_t)u.pm * BM * K * 2; }
    __device__ __forceinline__ const char* baseB(const Unit& u) const { return (const char*)(u.sel ? B1 : B0) + (size_t)u.pn * BM * K * 2; }
};

template <class Epi, bool ALIGN_EPI, bool SP2>
__device__ __forceinline__ void gemm_phase(LAS unsigned char* lds, const Sched2& S, const Epi& E) {
    const int tid = threadIdx.x, wid = __builtin_amdgcn_readfirstlane(tid >> 6), lane = tid & 63, wr = wid >> 2, wc = wid & 3, fr = lane & 15, fq = lane >> 4;
    const int K = S.K, nt = K / BK;
    unsigned voffA[2], voffB[2];
#pragma unroll
    for (int i = 0; i < 2; ++i) { int R, C; stage_rc(tid * 16 + i * 8192, R, C); const int Rb = Epi::PERM ? ((R & ~31) + perm32(R & 31)) : R;
        voffA[i] = (unsigned)(R * K + C) * 2u; voffB[i] = (unsigned)(Rb * K + C) * 2u; }
    const size_t kstep = (size_t)(BK * 2);
    const size_t hstep = (size_t)HALF * K * 2;
    const unsigned ldsw = (unsigned)wid * 1024u;
    const int aoff = lds_byte(wr * 64 + fr, fq * 8), boff = lds_byte(wc * 32 + fr, fq * 8);
#define PG8_SA(b, h) (((b) * 2 + (h)) * HTB)
#define PG8_SB(b, h) ((4 + (b) * 2 + (h)) * HTB)
#define PG8_STAGE(bufoff, gbase, voff) do { _Pragma("unroll") for (int _i = 0; _i < 2; ++_i) \
        __builtin_amdgcn_global_load_lds((const unsigned*)((const char*)(gbase) + (voff)[_i]), (LAS unsigned*)(lds + (bufoff) + ldsw + _i * 8192), 16, 0, 0); } while (0)
#define PG8_LDA(dst, b, h) do { _Pragma("unroll") for (int m = 0; m < 4; ++m) _Pragma("unroll") for (int k = 0; k < 2; ++k) dst[m][k] = *(const LAS bf16x8*)(lds + PG8_SA(b, h) + aoff + m * 2048 + k * 1024); } while (0)
#define PG8_LDB(dst, b, h) do { _Pragma("unroll") for (int n = 0; n < 2; ++n) _Pragma("unroll") for (int k = 0; k < 2; ++k) dst[n][k] = *(const LAS bf16x8*)(lds + PG8_SB(b, h) + boff + n * 2048 + k * 1024); } while (0)
#define PG8_MMA(ai, bj, At, Bt) do { __builtin_amdgcn_s_setprio(1); _Pragma("unroll") for (int m = 0; m < 4; ++m) _Pragma("unroll") for (int n = 0; n < 2; ++n) _Pragma("unroll") for (int k = 0; k < 2; ++k) \
        acc[ai][bj][m][n] = __builtin_amdgcn_mfma_f32_16x16x32_bf16(Bt[n][k], At[m][k], acc[ai][bj][m][n], 0, 0, 0); __builtin_amdgcn_s_setprio(0); } while (0)
#define PG8_WAIT_V(n) asm volatile("s_waitcnt vmcnt(" #n ")" ::: "memory")
#define PG8_WAIT_L(n) asm volatile("s_waitcnt lgkmcnt(" #n ")" ::: "memory")
#define PG8_BAR __builtin_amdgcn_s_barrier()
#define PG8_SCHED __builtin_amdgcn_sched_barrier(0)
    Unit cur, nxt; int ui = 0;
    if (!S.next(0, cur)) return;
    f32x4 acc[2][2][4][2];
#pragma unroll
    for (int a = 0; a < 2; ++a)
#pragma unroll
        for (int b = 0; b < 2; ++b)
#pragma unroll
            for (int m = 0; m < 4; ++m)
#pragma unroll
                for (int n = 0; n < 2; ++n) acc[a][b][m][n] = (f32x4){0.f, 0.f, 0.f, 0.f};
    bf16x8 At[4][2], B0[2][2], B1[2][2];
    const char* cA = S.baseA(cur); const char* cB = S.baseB(cur);
    if constexpr (SP2) {
        PG8_STAGE(PG8_SB(0, 0), cB, voffB); PG8_STAGE(PG8_SB(0, 1), cB + hstep, voffB); PG8_STAGE(PG8_SA(0, 0), cA, voffA); PG8_STAGE(PG8_SA(0, 1), cA + hstep, voffA);
        if (wr == 1) PG8_BAR;
        PG8_WAIT_V(2); PG8_BAR;
        PG8_STAGE(PG8_SB(1, 0), cB + kstep, voffB); PG8_STAGE(PG8_SA(1, 0), cA + kstep, voffA); PG8_STAGE(PG8_SB(1, 1), cB + hstep + kstep, voffB);
        PG8_WAIT_V(6); PG8_BAR;
    } else {
        PG8_STAGE(PG8_SB(0, 0), cB, voffB); PG8_STAGE(PG8_SA(0, 0), cA, voffA); PG8_STAGE(PG8_SB(0, 1), cB + hstep, voffB); PG8_STAGE(PG8_SA(0, 1), cA + hstep, voffA);
        if (wr == 1) PG8_BAR;
        PG8_WAIT_V(4); PG8_BAR;
        PG8_STAGE(PG8_SB(1, 0), cB + kstep, voffB); PG8_STAGE(PG8_SA(1, 0), cA + kstep, voffA); PG8_STAGE(PG8_SB(1, 1), cB + hstep + kstep, voffB);
        PG8_WAIT_V(6); PG8_BAR;
    }
    for (;;) {
        const bool has_next = S.next(ui + 1, nxt);
        const char* nA = has_next ? S.baseA(nxt) : cA; const char* nB = has_next ? S.baseB(nxt) : cB;
        for (int t = 0; t < nt; t += 2) {
            const bool last = (t == nt - 2);
            const char* a1 = cA + (size_t)(t + 1) * kstep;
            const char* a2 = last ? nA : cA + (size_t)(t + 2) * kstep; const char* b2 = last ? nB : cB + (size_t)(t + 2) * kstep;
            const char* a3 = a2 + kstep; const char* b3 = b2 + kstep;
            if constexpr (SP2) {
            PG8_LDB(B0, 0, 0); PG8_LDB(B1, 0, 1); PG8_SCHED; PG8_LDA(At, 0, 0); PG8_STAGE(PG8_SA(1, 1), a1 + hstep, voffA);
            PG8_WAIT_V(8); PG8_WAIT_L(0); PG8_BAR; PG8_MMA(0, 0, At, B0); PG8_MMA(0, 1, At, B1); PG8_BAR; PG8_SCHED;
            PG8_LDA(At, 0, 1); PG8_STAGE(PG8_SB(0, 0), b2, voffB); PG8_STAGE(PG8_SB(0, 1), b2 + hstep, voffB); PG8_STAGE(PG8_SA(0, 0), a2, voffA);
            PG8_WAIT_V(8); PG8_WAIT_L(0); PG8_BAR; PG8_MMA(1, 0, At, B0); PG8_MMA(1, 1, At, B1); PG8_BAR; PG8_SCHED;
            PG8_LDB(B0, 1, 0); PG8_LDB(B1, 1, 1); PG8_SCHED; PG8_LDA(At, 1, 0); PG8_STAGE(PG8_SA(0, 1), a2 + hstep, voffA);
            PG8_WAIT_V(8); PG8_WAIT_L(0); PG8_BAR; PG8_MMA(0, 0, At, B0); PG8_MMA(0, 1, At, B1); PG8_BAR; PG8_SCHED;
            PG8_LDA(At, 1, 1); PG8_STAGE(PG8_SB(1, 0), b3, voffB); PG8_STAGE(PG8_SB(1, 1), b3 + hstep, voffB); PG8_STAGE(PG8_SA(1, 0), a3, voffA);
            PG8_WAIT_V(8); PG8_WAIT_L(0); PG8_BAR; PG8_MMA(1, 0, At, B0); PG8_MMA(1, 1, At, B1); PG8_BAR; PG8_SCHED;
            } else {
            PG8_LDB(B0, 0, 0); PG8_SCHED; PG8_LDA(At, 0, 0); PG8_STAGE(PG8_SA(1, 1), a1 + hstep, voffA);
            PG8_WAIT_L(8); PG8_BAR; PG8_WAIT_L(0); PG8_MMA(0, 0, At, B0); PG8_BAR; PG8_SCHED;
            PG8_LDB(B1, 0, 1); PG8_STAGE(PG8_SB(0, 0), b2, voffB);
            PG8_BAR; PG8_WAIT_L(0); PG8_MMA(0, 1, At, B1); PG8_BAR;
            PG8_LDA(At, 0, 1); PG8_STAGE(PG8_SA(0, 0), a2, voffA);
            PG8_BAR; PG8_WAIT_L(0); PG8_MMA(1, 0, At, B0); PG8_BAR; PG8_SCHED;
            PG8_STAGE(PG8_SB(0, 1), b2 + hstep, voffB);
            PG8_WAIT_V(6); PG8_BAR; PG8_MMA(1, 1, At, B1); PG8_BAR;
            PG8_LDB(B0, 1, 0); PG8_SCHED; PG8_LDA(At, 1, 0); PG8_STAGE(PG8_SA(0, 1), a2 + hstep, voffA);
            PG8_WAIT_L(8); PG8_BAR; PG8_WAIT_L(0); PG8_MMA(0, 0, At, B0); PG8_BAR; PG8_SCHED;
            PG8_LDB(B1, 1, 1); PG8_STAGE(PG8_SB(1, 0), b3, voffB);
            PG8_BAR; PG8_WAIT_L(0); PG8_MMA(0, 1, At, B1); PG8_BAR;
            PG8_LDA(At, 1, 1); PG8_STAGE(PG8_SA(1, 0), a3, voffA);
            PG8_BAR; PG8_WAIT_L(0); PG8_MMA(1, 0, At, B0); PG8_BAR; PG8_SCHED;
            PG8_STAGE(PG8_SB(1, 1), b3 + hstep, voffB);
            PG8_WAIT_V(6); PG8_BAR; PG8_MMA(1, 1, At, B1); PG8_BAR;
            }
        }
        if constexpr (ALIGN_EPI) { if (wr == 0) PG8_BAR; }
        E(acc, cur, wr, wc, fr, fq);
        if (!has_next) break;
#pragma unroll
        for (int a = 0; a < 2; ++a)
#pragma unroll
            for (int b = 0; b < 2; ++b)
#pragma unroll
                for (int m = 0; m < 4; ++m)
#pragma unroll
                    for (int n = 0; n < 2; ++n) acc[a][b][m][n] = (f32x4){0.f, 0.f, 0.f, 0.f};
        cur = nxt; cA = nA; cB = nB; ++ui;
        if constexpr (ALIGN_EPI) { if (wr == 1) PG8_BAR; }
    }
    PG8_WAIT_V(0);
    if constexpr (!ALIGN_EPI) { if (wr == 0) PG8_BAR; }
    PG8_BAR;
#undef PG8_SA
#undef PG8_SB
#undef PG8_STAGE
#undef PG8_LDA
#undef PG8_LDB
#undef PG8_MMA
#undef PG8_WAIT_V
#undef PG8_WAIT_L
#undef PG8_BAR
#undef PG8_SCHED
}

struct EpiP1 {
    static constexpr bool PERM = true;
    bf16_t* U;
    __device__ __forceinline__ void operator()(const f32x4 (&acc)[2][2][4][2], const Unit& u, int wr, int wc, int fr, int fq) const {
        const int row0 = u.pm * BM + wr * 64 + fr;
        bf16_t* O = U + (size_t)(u.pn >> 3) * ((size_t)M * D);
        if (u.pn < 24) {
            const bool act = u.pn >= 8;
            const int col0 = (u.pn & 7) * 128 + wc * 32 + 8 * fq;
#pragma unroll
            for (int ai = 0; ai < 2; ++ai)
#pragma unroll
                for (int m = 0; m < 4; ++m) { bf16_t* rowp = O + (size_t)(row0 + ai * HALF + m * 16) * D + col0;
                    f32x4 a0 = acc[ai][0][m][0], a1 = acc[ai][0][m][1], b0 = acc[ai][1][m][0], b1 = acc[ai][1][m][1];
                    if (act) {
#pragma unroll
                        for (int j = 0; j < 4; ++j) { b0[j] = silu_f(b0[j]); b1[j] = silu_f(b1[j]); } }
                    a0 = a0 * b0; a1 = a1 * b1;
                    u32x4 w; w.x = cvt_pk_bf16(a0[0], a0[1]); w.y = cvt_pk_bf16(a0[2], a0[3]); w.z = cvt_pk_bf16(a1[0], a1[1]); w.w = cvt_pk_bf16(a1[2], a1[3]);
                    *(u32x4*)rowp = w; }
        } else {
            const int col0 = (u.pn - 24) * 256 + wc * 32 + 8 * fq;
#pragma unroll
            for (int ai = 0; ai < 2; ++ai)
#pragma unroll
                for (int m = 0; m < 4; ++m) { bf16_t* rowp = O + (size_t)(row0 + ai * HALF + m * 16) * D + col0;
#pragma unroll
                    for (int bj = 0; bj < 2; ++bj) { const f32x4 v0 = acc[ai][bj][m][0], v1 = acc[ai][bj][m][1];
                        u32x4 w; w.x = cvt_pk_bf16(v0[0], v0[1]); w.y = cvt_pk_bf16(v0[2], v0[3]); w.z = cvt_pk_bf16(v1[0], v1[1]); w.w = cvt_pk_bf16(v1[2], v1[3]);
                        *(u32x4*)(rowp + bj * HALF) = w; } }
        }
    }
};
struct EpiP5 {
    static constexpr bool PERM = true;
    bf16_t *Q, *VT; const float *qn, *kn;
    const float* ssq; const float* sw;
    __device__ __forceinline__ float rstd_of(int token, int part  ) const { const f32x4 p = *(const f32x4*)(ssq + (size_t)token * 16 + 4 * part); return (p[0] + p[1]) + (p[2] + p[3]); }
    __device__ __forceinline__ void operator()(const f32x4 (&acc)[2][2][4][2], const Unit& u, int wr, int wc, int fr, int fq) const {
        const int row0 = u.pm * BM + wr * 64 + fr;
        if (u.sel == 1) {
            const int col0 = u.pn * BM + wc * 32 + 8 * fq, bt = (u.pn * BM) / SEQ;
            float mine; { const int k = fr, tok = col0 + (k >> 3) * HALF + ((k >> 2) & 1) * 4 + (k & 3);
                const float t = (rstd_of(tok, 0) + rstd_of(tok, 1)) + (rstd_of(tok, 2) + rstd_of(tok, 3)); mine = __builtin_amdgcn_rsqf(t * (1.0f / D) + EPS); }
            f32x4 rs[2][2];
#pragma unroll
            for (int k = 0; k < 16; ++k) rs[k >> 3][(k >> 2) & 1][k & 3] = __shfl(mine, (fq << 4) | k);
#pragma unroll
            for (int ai = 0; ai < 2; ++ai)
#pragma unroll
                for (int m = 0; m < 4; ++m) { const int hd = row0 + ai * HALF + m * 16; const float swv = sw[bt * 4096 + 2048 + hd]; bf16_t* rowp = VT + (size_t)hd * M + col0;
#pragma unroll
                    for (int bj = 0; bj < 2; ++bj) { const f32x4 v0 = acc[ai][bj][m][0] * rs[bj][0] + swv, v1 = acc[ai][bj][m][1] * rs[bj][1] + swv;
                        u32x4 w; w.x = cvt_pk_bf16(v0[0], v0[1]); w.y = cvt_pk_bf16(v0[2], v0[3]); w.z = cvt_pk_bf16(v1[0], v1[1]); w.w = cvt_pk_bf16(v1[2], v1[3]);
                        *(u32x4*)(rowp + bj * HALF) = w; } }
            return;
        }
        const int bt = (u.pm * BM) / SEQ;
        float rs[2][4];
#pragma unroll
        for (int ai = 0; ai < 2; ++ai)
#pragma unroll
            for (int m = 0; m < 4; ++m) { float t = rstd_of(row0 + ai * HALF + m * 16, fq); t += __shfl_xor(t, 16); t += __shfl_xor(t, 32); rs[ai][m] = __builtin_amdgcn_rsqf(t * (1.0f / D) + EPS); }
        if (u.pn >= 8) {
            const int col0 = (u.pn - 8) * BM + wc * 32 + 8 * fq;
            f32x4 s4[2][2];
#pragma unroll
            for (int bj = 0; bj < 2; ++bj)
#pragma unroll
                for (int n = 0; n < 2; ++n) s4[bj][n] = *(const f32x4*)(sw + bt * 4096 + 3072 + col0 + bj * HALF + 4 * n);
#pragma unroll
            for (int ai = 0; ai < 2; ++ai)
#pragma unroll
                for (int m = 0; m < 4; ++m) { bf16_t* rowp = Q + 2 * (size_t)M * D + (size_t)(row0 + ai * HALF + m * 16) * D + col0;
#pragma unroll
                    for (int bj = 0; bj < 2; ++bj) { f32x4 v0 = acc[ai][bj][m][0] * rs[ai][m] + s4[bj][0], v1 = acc[ai][bj][m][1] * rs[ai][m] + s4[bj][1];
#pragma unroll
                        for (int j = 0; j < 4; ++j) { v0[j] = silu_f(v0[j]); v1[j] = silu_f(v1[j]); }
                        u32x4 w; w.x = cvt_pk_bf16(v0[0], v0[1]); w.y = cvt_pk_bf16(v0[2], v0[3]); w.z = cvt_pk_bf16(v1[0], v1[1]); w.w = cvt_pk_bf16(v1[2], v1[3]);
                        *(u32x4*)(rowp + bj * HALF) = w; } }
        } else {
            const bool isq = u.pn < 4; bf16_t* O = Q + (size_t)(u.pn >> 2) * ((size_t)M * D); const float* nw = qn; if (!isq) nw = kn; const float sc = isq ? (LOG2E * 0.125f) : 1.0f;
            const int col0 = (u.pn & 3) * BM + 64 * wc + 8 * fq;
            f32x4 w4[2][2], s4[2][2];
#pragma unroll
            for (int bj = 0; bj < 2; ++bj)
#pragma unroll
                for (int n = 0; n < 2; ++n) { w4[bj][n] = *(const f32x4*)(nw + 32 * bj + 8 * fq + 4 * n); s4[bj][n] = *(const f32x4*)(sw + bt * 4096 + (u.pn >> 2) * 1024 + col0 + 32 * bj + 4 * n); }
#pragma unroll
            for (int ai = 0; ai < 2; ++ai)
#pragma unroll
                for (int m = 0; m < 4; ++m) {
                    f32x4 v[2][2]; float ss = 0.f;
#pragma unroll
                    for (int bj = 0; bj < 2; ++bj)
#pragma unroll
                        for (int n = 0; n < 2; ++n) { v[bj][n] = acc[ai][bj][m][n] * rs[ai][m] + s4[bj][n]; const f32x4 t = v[bj][n]; ss += (t[0] * t[0] + t[1] * t[1]) + (t[2] * t[2] + t[3] * t[3]); }
                    ss += __shfl_xor(ss, 16); ss += __shfl_xor(ss, 32);
                    const float rq = __builtin_amdgcn_rsqf(ss * (1.0f / 64.0f) + EPS) * sc;
                    bf16_t* rowp = O + (size_t)(row0 + ai * HALF + m * 16) * D + col0;
#pragma unroll
                    for (int bj = 0; bj < 2; ++bj) { const f32x4 v0 = v[bj][0] * rq * w4[bj][0], v1 = v[bj][1] * rq * w4[bj][1];
                        u32x4 w; w.x = cvt_pk_bf16(v0[0], v0[1]); w.y = cvt_pk_bf16(v0[2], v0[3]); w.z = cvt_pk_bf16(v1[0], v1[1]); w.w = cvt_pk_bf16(v1[2], v1[3]);
                        *(u32x4*)(rowp + 32 * bj) = w; } }
        }
    }
};
template <bool STATS> struct EpiRes {
    static constexpr bool PERM = true;
    const void* base; void* out; const float* gate; const float* lng; const float* scale; bf16_t* xm; float* ssq;
    __device__ __forceinline__ void operator()(const f32x4 (&acc)[2][2][4][2], const Unit& u, int wr, int wc, int fr, int fq) const {
        const int row0 = u.pm * BM + wr * 64 + fr, col0 = u.pn * BM + wc * 32 + 8 * fq, bt = (u.pm * BM) / SEQ;
        f32x4 gv[2][2], mv[2][2];
#pragma unroll
        for (int bj = 0; bj < 2; ++bj)
#pragma unroll
            for (int n = 0; n < 2; ++n) { gv[bj][n] = *(const f32x4*)(gate + bt * 3072 + col0 + bj * HALF + 4 * n);
                if (STATS) mv[bj][n] = *(const f32x4*)(lng + col0 + bj * HALF + 4 * n) * (*(const f32x4*)(scale + bt * 3072 + col0 + bj * HALF + 4 * n) + 1.0f); }
        constexpr int MB = STATS ? 2 : 4;
#pragma unroll
        for (int ai = 0; ai < 2; ++ai)
#pragma unroll
        for (int mb = 0; mb < 4; mb += MB) {
            f32x4 bf[MB][2][2]; u32x4 bh[MB][2];
#pragma unroll
            for (int mm = 0; mm < MB; ++mm) { const size_t off = (size_t)(row0 + ai * HALF + (mb + mm) * 16) * D + col0;
#pragma unroll
                for (int bj = 0; bj < 2; ++bj) {
                    if (STATS) { bf[mm][bj][0] = *(const f32x4*)((const float*)base + off + bj * HALF); bf[mm][bj][1] = *(const f32x4*)((const float*)base + off + bj * HALF + 4); }
                    else bh[mm][bj] = *(const u32x4*)((const bf16_t*)base + off + bj * HALF); } }
#pragma unroll
            for (int mm = 0; mm < MB; ++mm) { const int m = mb + mm; const int row = row0 + ai * HALF + m * 16; const size_t off = (size_t)row * D + col0; float ss = 0.f;
#pragma unroll
                for (int bj = 0; bj < 2; ++bj) { f32x4 b0, b1;
                    if (STATS) { b0 = bf[mm][bj][0]; b1 = bf[mm][bj][1]; }
                    else { const u32x4 t = bh[mm][bj]; b0 = (f32x4){bf_lo(t.x), bf_hi(t.x), bf_lo(t.y), bf_hi(t.y)}; b1 = (f32x4){bf_lo(t.z), bf_hi(t.z), bf_lo(t.w), bf_hi(t.w)}; }
                    const f32x4 o0 = b0 + gv[bj][0] * acc[ai][bj][m][0], o1 = b1 + gv[bj][1] * acc[ai][bj][m][1];
                    if (STATS) { u32x4 w; w.x = cvt_pk_bf16(o0[0], o0[1]); w.y = cvt_pk_bf16(o0[2], o0[3]); w.z = cvt_pk_bf16(o1[0], o1[1]); w.w = cvt_pk_bf16(o1[2], o1[3]);
                        *(u32x4*)((bf16_t*)out + off + bj * HALF) = w;
                        ss += (o0[0] * o0[0] + o0[1] * o0[1]) + (o0[2] * o0[2] + o0[3] * o0[3]) + (o1[0] * o1[0] + o1[1] * o1[1]) + (o1[2] * o1[2] + o1[3] * o1[3]);
                        const f32x4 x0 = o0 * mv[bj][0], x1 = o1 * mv[bj][1];
                        u32x4 w2; w2.x = cvt_pk_bf16(x0[0], x0[1]); w2.y = cvt_pk_bf16(x0[2], x0[3]); w2.z = cvt_pk_bf16(x1[0], x1[1]); w2.w = cvt_pk_bf16(x1[2], x1[3]);
                        *(u32x4*)(xm + off + bj * HALF) = w2; }
                    else { *(f32x4*)((float*)out + off + bj * HALF) = o0; *(f32x4*)((float*)out + off + bj * HALF + 4) = o1; } }
                if (STATS) { ss += __shfl_xor(ss, 16); ss += __shfl_xor(ss, 32); if (fq == 0) ssq[(size_t)row * 16 + u.pn * 4 + wc] = ss; } }
        }
    }
};
}

#define XB_TMO      128
#define XB_XCNT(j)  (256  + 64 * (j))
#define XB_XSUB(j)  (1280 + 64 * (j))
#define XB_XGEN(j)  (2304 + 64 * (j))
#define XB_TOP      3328
#define XB_TOPGEN   3392
#define XCD_BAR_WORDS 3456
#define XB_SPIN_CAP (1u << 18)
__device__ __forceinline__ unsigned xb_ld(unsigned* p)              { return __hip_atomic_load(p, __ATOMIC_RELAXED, __HIP_MEMORY_SCOPE_AGENT); }
__device__ __forceinline__ unsigned xb_add(unsigned* p, unsigned v) { return __hip_atomic_fetch_add(p, v, __ATOMIC_RELAXED, __HIP_MEMORY_SCOPE_AGENT); }
__device__ __forceinline__ unsigned xb_xcc_id() { return (unsigned)__builtin_amdgcn_s_getreg((3 << 11) | 20) & 0xFu; }
#define XB_SPIN(cond, bar) do { unsigned _sp = 0; while (cond) { __builtin_amdgcn_s_sleep(1); \
    if ((++_sp & 255u) == 0u) { if (xb_ld(&(bar)[XB_TMO])) break; if (_sp > XB_SPIN_CAP) { atomicAdd(&(bar)[XB_TMO], 1u); break; } } } } while (0)
struct XcdBarrier { unsigned* bar; unsigned x; volatile LAS unsigned* st; };
__device__ __forceinline__ XcdBarrier xcd_barrier_post(unsigned* bar, volatile LAS unsigned* st) {
    XcdBarrier b; b.bar = bar; b.x = xb_xcc_id(); b.st = st;
    if (threadIdx.x == 0) (void)xb_add(&bar[XB_XCNT(b.x)], 1u);
    return b;
}
__device__ __forceinline__ void xcd_barrier_complete(unsigned* bar, unsigned x, unsigned& nloc, unsigned& nx) {
    const unsigned G = gridDim.x * gridDim.y * gridDim.z;
    unsigned sum, cnt, mine, sp = 0u;
    for (;;) {
        sum = 0u; cnt = 0u; mine = 0u;
#pragma unroll
        for (unsigned j = 0; j < 16; ++j) { const unsigned c = xb_ld(&bar[XB_XCNT(j)]); sum += c; cnt += (c > 0u) ? 1u : 0u; mine = (j == x) ? c : mine; }
        if (sum == G) break;
        __builtin_amdgcn_s_sleep(1);
        if ((++sp & 255u) == 0u) { if (xb_ld(&bar[XB_TMO])) break; if (sp > XB_SPIN_CAP) { atomicAdd(&bar[XB_TMO], 1u); break; } }
    }
    nloc = mine > 0u ? mine : 1u; nx = cnt > 0u ? cnt : 1u;
}
__device__ __forceinline__ void xcd_barrier(const XcdBarrier& b) {
    asm volatile("s_waitcnt vmcnt(0)" ::: "memory");
    __syncthreads();
    if (threadIdx.x == 0) {
        unsigned* bar = b.bar;
        __builtin_amdgcn_s_waitcnt(0);
        unsigned nloc = b.st[0], nx = b.st[1];
        if (nloc == 0u) { xcd_barrier_complete(bar, b.x, nloc, nx); b.st[0] = nloc; b.st[1] = nx; }
        const unsigned old = xb_add(&bar[XB_XSUB(b.x)], 1u);
        const unsigned gen = old / nloc;
        if (old + 1u == (gen + 1u) * nloc) {
            __builtin_amdgcn_fence(__ATOMIC_RELEASE, "agent");
            asm volatile("s_waitcnt vmcnt(0)" ::: "memory");
            const unsigned og = xb_add(&bar[XB_TOP], 1u);
            const unsigned tg = og / nx;
            if (og + 1u == (tg + 1u) * nx) xb_add(&bar[XB_TOPGEN], 1u);
            else XB_SPIN(xb_ld(&bar[XB_TOPGEN]) == tg, bar);
            __builtin_amdgcn_fence(__ATOMIC_ACQUIRE, "agent");
            xb_add(&bar[XB_XGEN(b.x)], 1u);
            asm volatile("s_waitcnt vmcnt(0)" ::: "memory");
        } else {
            XB_SPIN(xb_ld(&bar[XB_XGEN(b.x)]) == gen, bar);
            __builtin_amdgcn_fence(__ATOMIC_ACQUIRE, "agent");
            asm volatile("s_waitcnt vmcnt(0)" ::: "memory");
        }
    }
    __syncthreads();
}

struct Args {
    const float *x, *c, *ln_g, *ada_w, *ada_b, *w_in_ab, *conv_w, *sg_norm, *sg_w, *sg_b, *w_out_ab, *w_in_c, *q_norm, *k_norm, *w_out_c;
    float* out; unsigned char* ws; int ph_lo, ph_hi;
};

__device__ __forceinline__ int ab_row(int c) {
    const int seg = c >> 10, cc = c & 1023, t = cc >> 7, r = cc & 127;
    switch (seg) {
        case 1: return 256 * t + r;
        case 2: return 256 * t + 128 + r;
        case 0: return 256 * (8 + t) + r;
        case 3: return 256 * (8 + t) + 128 + r;
        case 4: return 256 * (16 + t) + r;
        case 6: return 256 * (16 + t) + 128 + r;
        default: return 256 * 24 + cc;
    }
}
__device__ __forceinline__ int c_row(int c) {
    const int seg = c >> 10, cc = c & 1023;
    if (seg == 2) return 3072 + cc;
    if (seg == 3) return 2048 + cc;
    const int tile = cc >> 8, ct = cc & 255, hh = ct >> 6, bj = (ct >> 5) & 1, i = ct & 31;
    return seg * 1024 + tile * 256 + 128 * bj + 32 * hh + i;
}
template <int MODE>
__device__ __forceinline__ void p0_transpose_item(const float* W, int K, int N, bf16_t* WT, LAS float* scr, int item, int lane) {
    const int nblk = N / 32, kb = item / nblk, nb = item % nblk, k0 = 64 * kb, n0 = 32 * nb;
    const int rb = MODE == 1 ? ab_row(n0) : (MODE == 2 ? c_row(n0) : n0);
#pragma unroll 8
    for (int i = 0; i < 32; ++i) { const int kk = 2 * i + (lane >> 5); scr[kk * 33 + (lane & 31)] = W[(size_t)(k0 + kk) * N + n0 + (lane & 31)]; }
    asm volatile("s_waitcnt lgkmcnt(0)" ::: "memory");
    const int c = lane & 7;
#pragma unroll
    for (int j = 0; j < 4; ++j) { const int n = (lane >> 3) + 8 * j; const LAS float* s = scr + (8 * c) * 33 + n;
        u32x4 o; o.x = cvt_pk_bf16(s[0 * 33], s[1 * 33]); o.y = cvt_pk_bf16(s[2 * 33], s[3 * 33]); o.z = cvt_pk_bf16(s[4 * 33], s[5 * 33]); o.w = cvt_pk_bf16(s[6 * 33], s[7 * 33]);
        *(u32x4*)(WT + (size_t)(rb + n) * K + k0 + 8 * c) = o; }
    asm volatile("s_waitcnt lgkmcnt(0)" ::: "memory");
}

__device__ __forceinline__ float wave_sum(float v) {
#pragma unroll
    for (int o = 1; o < 64; o <<= 1) v += __shfl_xor(v, o);
    return v;
}
__device__ __forceinline__ void rms_phase(const float* X, const float* g, const float* mod  , bf16_t* H, int gw, int NGW, int lane) {
    for (int b = 0; b < BATCH; ++b) {
        f32x4 mul[4], sh[4];
#pragma unroll
        for (int j = 0; j < 4; ++j) { const int col = 4 * lane + 256 * j; const f32x4 gg = *(const f32x4*)(g + col), sc = *(const f32x4*)(mod + b * 3072 + 1024 + col);
            sh[j] = *(const f32x4*)(mod + b * 3072 + col); mul[j] = gg * (sc + 1.0f); }
#pragma unroll 4
        for (int r = gw; r < SEQ; r += NGW) {
            const size_t m = (size_t)b * SEQ + r;
            const f32x4* xr = (const f32x4*)(X + m * D) + lane;
            f32x4 v[4]; float s = 0.f;
#pragma unroll
            for (int j = 0; j < 4; ++j) { v[j] = xr[64 * j]; s += (v[j].x * v[j].x + v[j].y * v[j].y) + (v[j].z * v[j].z + v[j].w * v[j].w); }
            const float rstd = __builtin_amdgcn_rsqf(wave_sum(s) * (1.f / D) + EPS);
            u32x2* o8 = (u32x2*)(H + m * D) + lane;
#pragma unroll
            for (int j = 0; j < 4; ++j) { const f32x4 o = v[j] * rstd * mul[j] + sh[j]; u32x2 w; w.x = cvt_pk_bf16(o.x, o.y); w.y = cvt_pk_bf16(o.z, o.w); o8[64 * j] = w; }
        }
    }
}

__device__ __forceinline__ void mixer_phase(LAS unsigned char* lds, const bf16_t* U, const bf16_t* Gt, const bf16_t* UZ, const bf16_t* V, const float* conv_w, const float* sg_norm,
                                            const bf16_t* WTR, const float* sg_b, bf16_t* Y, int vcu, int G) {
    const int tid = threadIdx.x, lane = tid & 63, w = __builtin_amdgcn_readfirstlane(tid >> 6), fr = lane & 15, fq = lane >> 4;
    constexpr int PT = 136;
    LAS bf16_t* VNT = (LAS bf16_t*)lds;
    LAS bf16_t* WL = (LAS bf16_t*)(lds + 128 * PT * 2);
    LAS float* SG = (LAS float*)(lds + 2 * 128 * PT * 2);
    int g_staged = -1;
    const int c8 = tid & 15, rg = tid >> 4;
    const int s = tid >> 2, qd = tid & 3;
    for (int unit = vcu; unit < BATCH * 64 * 8; unit += G) {
        const int g = unit & 7, cch = (unit >> 3) & 63, b = unit >> 9; const size_t r0 = (size_t)b * SEQ + cch * 128;
        const int ch = 128 * g + 8 * c8; const size_t row = r0 + 4 * rg;
        u32x4 ur[6], gv[4], vv[4], uz[4];
        const bool halo0 = (cch == 0 && rg == 0);
#pragma unroll
        for (int i = 0; i < 4; ++i) vv[i] = *(const u32x4*)(V + (r0 + s) * D + 128 * g + 32 * qd + 8 * i);
#pragma unroll
        for (int i = 0; i < 6; ++i) { if (i < 2 && halo0) ur[i] = (u32x4){0u, 0u, 0u, 0u}; else ur[i] = *(const u32x4*)(U + (row + i - 2) * D + ch); }
#pragma unroll
        for (int i = 0; i < 4; ++i) gv[i] = *(const u32x4*)(Gt + (row + i) * D + ch);
#pragma unroll
        for (int i = 0; i < 4; ++i) uz[i] = *(const u32x4*)(UZ + (r0 + s) * D + 128 * g + 32 * qd + 8 * i);
        if (g != g_staged) {
            __syncthreads();
            const bf16_t* wp = WTR + ((size_t)g * 128 + s) * 128 + 32 * qd;
#pragma unroll
            for (int i = 0; i < 4; ++i) *(LAS u32x4*)(WL + s * PT + 32 * qd + 8 * i) = *(const u32x4*)(wp + 8 * i);
            g_staged = g;
        }
        { float v[32]; float ss = 0.f;
#pragma unroll
          for (int i = 0; i < 4; ++i)
#pragma unroll
              for (int p = 0; p < 4; ++p) { v[8 * i + 2 * p] = bf_lo(vv[i][p]); v[8 * i + 2 * p + 1] = bf_hi(vv[i][p]); }
#pragma unroll
          for (int i = 0; i < 32; ++i) ss += v[i] * v[i];
          ss += __shfl_xor(ss, 1); ss += __shfl_xor(ss, 2);
          const float rs = __builtin_amdgcn_rsqf(ss * (1.0f / 128.0f) + EPS);
          const float* nw = sg_norm + g * 128 + 32 * qd;
#pragma unroll
          for (int i = 0; i < 32; i += 2) { const unsigned pk = cvt_pk_bf16(v[i] * rs * nw[i], v[i + 1] * rs * nw[i + 1]);
              VNT[(32 * qd + i) * PT + s] = (bf16_t)(pk & 0xffffu); VNT[(32 * qd + i + 1) * PT + s] = (bf16_t)(pk >> 16); }
        }
        { float cw[3][8];
#pragma unroll
          for (int k = 0; k < 3; ++k) { const f32x4 a = *(const f32x4*)(conv_w + k * D + ch), bq = *(const f32x4*)(conv_w + k * D + ch + 4);
              cw[k][0] = a.x; cw[k][1] = a.y; cw[k][2] = a.z; cw[k][3] = a.w; cw[k][4] = bq.x; cw[k][5] = bq.y; cw[k][6] = bq.z; cw[k][7] = bq.w; }
#pragma unroll
          for (int i = 0; i < 4; ++i) { float o[8];
#pragma unroll
              for (int p = 0; p < 4; ++p) { const unsigned u0 = ur[i][p], u1 = ur[i + 1][p], u2 = ur[i + 2][p];
                  o[2 * p] = bf_lo(gv[i][p]) * (cw[0][2 * p] * bf_lo(u0) + cw[1][2 * p] * bf_lo(u1) + cw[2][2 * p] * bf_lo(u2));
                  o[2 * p + 1] = bf_hi(gv[i][p]) * (cw[0][2 * p + 1] * bf_hi(u0) + cw[1][2 * p + 1] * bf_hi(u1) + cw[2][2 * p + 1] * bf_hi(u2)); }
              u32x4 wv; wv.x = cvt_pk_bf16(o[0], o[1]); wv.y = cvt_pk_bf16(o[2], o[3]); wv.z = cvt_pk_bf16(o[4], o[5]); wv.w = cvt_pk_bf16(o[6], o[7]);
              *(u32x4*)(Y + (row + i) * 2048 + ch) = wv; }
        }
        __syncthreads();
        f32x4 acc[8];
#pragma unroll
        for (int tt = 0; tt < 8; ++tt) acc[tt] = (f32x4){0.f, 0.f, 0.f, 0.f};
#pragma unroll
        for (int ks = 0; ks < 4; ++ks) { const bf16x8 a = *(const LAS bf16x8*)(VNT + (16 * w + fr) * PT + 32 * ks + 8 * fq);
#pragma unroll
            for (int tt = 2 * ks; tt < 8; ++tt) { const bf16x8 bw = *(const LAS bf16x8*)(WL + (16 * tt + fr) * PT + 32 * ks + 8 * fq);
                acc[tt] = __builtin_amdgcn_mfma_f32_16x16x32_bf16(a, bw, acc[tt], 0, 0, 0); } }
#pragma unroll
        for (int tt = 0; tt < 8; ++tt) { const int t = 16 * tt + fr; const float bb = sg_b[g * 128 + t];
            *(LAS f32x4*)(SG + t * 132 + 16 * w + 4 * fq) = acc[tt] + bb; }
        __syncthreads();
        { bf16_t* yp = Y + (r0 + s) * 2048 + 1024 + 128 * g + 32 * qd;
#pragma unroll
          for (int i = 0; i < 4; ++i) { const f32x4 s0 = *(const LAS f32x4*)(SG + s * 132 + 32 * qd + 8 * i), s1 = *(const LAS f32x4*)(SG + s * 132 + 32 * qd + 8 * i + 4);
              u32x4 wv; wv.x = cvt_pk_bf16(bf_lo(uz[i].x) * s0.x, bf_hi(uz[i].x) * s0.y); wv.y = cvt_pk_bf16(bf_lo(uz[i].y) * s0.z, bf_hi(uz[i].y) * s0.w);
              wv.z = cvt_pk_bf16(bf_lo(uz[i].z) * s1.x, bf_hi(uz[i].z) * s1.y); wv.w = cvt_pk_bf16(bf_lo(uz[i].w) * s1.z, bf_hi(uz[i].w) * s1.w);
              *(u32x4*)(yp + 8 * i) = wv; }
        }
    }
    __syncthreads();
}

__device__ __forceinline__ int crow(int i, int hi) { return (i & 3) + 8 * (i >> 2) + 4 * hi; }
__device__ __forceinline__ void attn_load_k(bf16x8 (&kf)[4], bool in_lds, LAS unsigned char* KL, int kl0, const bf16_t* kg, int ql, int hi) {
    if (in_lds) { const int r = kl0 + ql; LAS unsigned char* rp = KL + r * 128; const int sw = (r >> 1) & 7;
#pragma unroll
        for (int kk = 0; kk < 4; ++kk) kf[kk] = *(const LAS bf16x8*)(rp + (((2 * kk + hi) ^ sw) << 4));
    } else {
#pragma unroll
        for (int kk = 0; kk < 4; ++kk) kf[kk] = *(const bf16x8*)(kg + 16 * kk);
    }
}
__device__ __forceinline__ void attn_phase(LAS unsigned char* lds, const bf16_t* Q, const bf16_t* Kb, const bf16_t* VT, const bf16_t* Zs, bf16_t* OZ, int vcu, int G) {
    const int tid = threadIdx.x, lane = tid & 63, w = __builtin_amdgcn_readfirstlane(tid >> 6), ql = lane & 31, hi = lane >> 5;
    constexpr float STOP = 5.421010862427522e-20f;
    LAS unsigned char* KL = lds;
    LAS unsigned char* VL = lds + 49152;
    constexpr int NU = BATCH * 16 * (SEQ / 256);
    u32x4 sk[6], sv[6];
#define ATT_DECODE(u_, h_, rb_, q0b_, kw0_) const int h_ = ((u_) >> 5) & 15; const size_t rb_ = (size_t)((u_) >> 9) * SEQ; const int q0b_ = 256 * ((u_) & 31), kw0_ = q0b_ >= 128 ? q0b_ - 128 : 0;
#define ATT_LOAD_STAGE(u_) do { ATT_DECODE(u_, h__, rb__, q0b__, kw0__) \
        _Pragma("unroll") for (int i = 0; i < 6; ++i) { const int idx = tid + NTHR * i, r = idx >> 3, c = idx & 7; sk[i] = *(const u32x4*)(Kb + (rb__ + kw0__ + r) * D + h__ * 64 + 8 * c); } \
        _Pragma("unroll") for (int i = 0; i < 6; ++i) { const int idx = tid + NTHR * i, d = idx / 48, ch = idx % 48; sv[i] = *(const u32x4*)(VT + (size_t)(h__ * 64 + d) * M + rb__ + kw0__ + 8 * ch); } } while (0)
    if (vcu < NU) ATT_LOAD_STAGE(vcu);
    for (int unit = vcu; unit < NU; unit += G) {
        ATT_DECODE(unit, h, rowbase, q0b, kw0)
        const int qblk = unit & 31;
        const int qb = 8 * qblk + w, q0 = 32 * qb;
        bf16x8 qf[4];
        { const bf16_t* qp = Q + (rowbase + q0 + ql) * D + h * 64 + 8 * hi;
#pragma unroll
          for (int kk = 0; kk < 4; ++kk) qf[kk] = *(const bf16x8*)(qp + 16 * kk); }
        u32x2 zz[8];
        { const bf16_t* zp = Zs + (rowbase + q0 + ql) * D + h * 64 + 4 * hi;
#pragma unroll
          for (int g4 = 0; g4 < 4; ++g4) { zz[g4] = *(const u32x2*)(zp + 8 * g4); zz[4 + g4] = *(const u32x2*)(zp + 32 + 8 * g4); } }
        asm volatile("" ::: "memory");
#pragma unroll
        for (int i = 0; i < 6; ++i) { const int idx = tid + NTHR * i, r = idx >> 3, c = idx & 7;
            *(LAS u32x4*)(KL + r * 128 + ((c ^ ((r >> 1) & 7)) << 4)) = sk[i]; }
#pragma unroll
        for (int i = 0; i < 6; ++i) { const int idx = tid + NTHR * i, d = idx / 48, ch = idx % 48;
            { u32x4 v = sv[i]; const int gp = (2 * ch) ^ (d & 31);
                if (d & 1) { const u32x4 t = v; v.x = t.z; v.y = t.w; v.z = t.x; v.w = t.y; }
                *(LAS u32x4*)(VL + d * 768 + ((gp & ~1) << 3)) = v; } }
        __syncthreads();
        { const int nu_ = unit + G < NU ? unit + G : unit; ATT_LOAD_STAGE(nu_); }
        f32x16 o0, o1;
#pragma unroll
        for (int i = 0; i < 16; ++i) { o0[i] = 0.f; o1[i] = 0.f; }
        float carry = 1.f;
#define ATT_TILE(IN_LDS_) { const int key0 = 32 * kt; \
            u32x2 vf[2][2][2]; \
            if (IN_LDS_) { const int g0 = ((key0 - kw0) >> 2) + hi; \
_Pragma("unroll") \
                for (int dh = 0; dh < 2; ++dh) { LAS unsigned char* rp = VL + (32 * dh + ql) * 768; \
_Pragma("unroll") \
                    for (int s = 0; s < 2; ++s) { vf[dh][s][0] = *(const LAS u32x2*)(rp + (((g0 + 4 * s) ^ ql) << 3)); vf[dh][s][1] = *(const LAS u32x2*)(rp + (((g0 + 4 * s + 2) ^ ql) << 3)); } } \
            } else { const bf16_t* vp = VT + (size_t)(h * 64 + ql) * M + rowbase + key0 + 4 * hi; \
_Pragma("unroll") \
                for (int dh = 0; dh < 2; ++dh) \
_Pragma("unroll") \
                    for (int s = 0; s < 2; ++s) { vf[dh][s][0] = *(const u32x2*)(vp + (size_t)dh * 32 * M + 16 * s); vf[dh][s][1] = *(const u32x2*)(vp + (size_t)dh * 32 * M + 16 * s + 8); } } \
            bf16x8 kf[4]; \
            attn_load_k(kf, IN_LDS_, KL, key0 - kw0, Kb + (rowbase + key0 + ql) * D + h * 64 + 8 * hi, ql, hi); \
            f32x16 S; \
_Pragma("unroll") \
            for (int i = 0; i < 16; ++i) S[i] = 0.f; \
_Pragma("unroll") \
            for (int kk = 0; kk < 4; ++kk) S = __builtin_amdgcn_mfma_f32_32x32x16_bf16(kf[kk], qf[kk], S, 0, 0, 0); \
            float be[16], om[16]; \
            const bool diag = (kt == qb); \
_Pragma("unroll") \
            for (int i = 0; i < 16; ++i) { const float zc = __builtin_fmaxf(S[i], -126.0f); const float E = fast_exp2(-zc); float bv = fast_rcp(1.0f + E); float ov = E * bv; \
                if (diag) { const bool valid = crow(i, hi) < ql; bv = valid ? bv : 0.f; ov = valid ? ov : 1.f; } \
                be[i] = bv; om[i] = ov; } \
            float gs[4], pg[4]; \
_Pragma("unroll") \
            for (int gi = 0; gi < 4; ++gi) { gs[gi] = (om[4 * gi] * om[4 * gi + 1]) * (om[4 * gi + 2] * om[4 * gi + 3]); pg[gi] = __shfl_xor(gs[gi], 32); } \
            float run = carry; float wv[16]; \
_Pragma("unroll") \
            for (int gi = 3; gi >= 0; --gi) { const float base = hi == 0 ? run * pg[gi] : run; \
                const float s3 = base, s2 = s3 * om[4 * gi + 3], s1 = s2 * om[4 * gi + 2], s0 = s1 * om[4 * gi + 1]; \
                wv[4 * gi + 3] = be[4 * gi + 3] * s3; wv[4 * gi + 2] = be[4 * gi + 2] * s2; wv[4 * gi + 1] = be[4 * gi + 1] * s1; wv[4 * gi] = be[4 * gi] * s0; \
                run *= gs[gi] * pg[gi]; } \
            carry = run; \
_Pragma("unroll") \
            for (int s = 0; s < 2; ++s) { u32x4 pk; pk.x = cvt_pk_bf16(wv[8 * s], wv[8 * s + 1]); pk.y = cvt_pk_bf16(wv[8 * s + 2], wv[8 * s + 3]); pk.z = cvt_pk_bf16(wv[8 * s + 4], wv[8 * s + 5]); pk.w = cvt_pk_bf16(wv[8 * s + 6], wv[8 * s + 7]); \
                const bf16x8 pf = __builtin_bit_cast(bf16x8, pk); \
                { u32x4 a; a.x = vf[0][s][0].x; a.y = vf[0][s][0].y; a.z = vf[0][s][1].x; a.w = vf[0][s][1].y; o0 = __builtin_amdgcn_mfma_f32_32x32x16_bf16(__builtin_bit_cast(bf16x8, a), pf, o0, 0, 0, 0); } \
                { u32x4 a; a.x = vf[1][s][0].x; a.y = vf[1][s][0].y; a.z = vf[1][s][1].x; a.w = vf[1][s][1].y; o1 = __builtin_amdgcn_mfma_f32_32x32x16_bf16(__builtin_bit_cast(bf16x8, a), pf, o1, 0, 0, 0); } } }
        int kt = qb; bool done = false;
        for (; kt >= 0 && 32 * kt >= kw0; --kt) {
            ATT_TILE(true)
            if (__all(carry < STOP)) { done = true; break; }
        }
        if (!done) for (; kt >= 0; --kt) {
            ATT_TILE(false)
            if (__all(carry < STOP)) break;
        }
#undef ATT_TILE
        bf16_t* op = OZ + (rowbase + q0 + ql) * D + h * 64 + 4 * hi;
#pragma unroll
        for (int g4 = 0; g4 < 4; ++g4) {
            { const u32x2 z2 = zz[g4]; u32x2 wo; wo.x = cvt_pk_bf16(o0[4 * g4] * bf_lo(z2.x), o0[4 * g4 + 1] * bf_hi(z2.x)); wo.y = cvt_pk_bf16(o0[4 * g4 + 2] * bf_lo(z2.y), o0[4 * g4 + 3] * bf_hi(z2.y)); *(u32x2*)(op + 8 * g4) = wo; }
            { const u32x2 z2 = zz[4 + g4]; u32x2 wo; wo.x = cvt_pk_bf16(o1[4 * g4] * bf_lo(z2.x), o1[4 * g4 + 1] * bf_hi(z2.x)); wo.y = cvt_pk_bf16(o1[4 * g4 + 2] * bf_lo(z2.y), o1[4 * g4 + 3] * bf_hi(z2.y)); *(u32x2*)(op + 32 + 8 * g4) = wo; }
        }
        __syncthreads();
    }
#undef ATT_DECODE
#undef ATT_LOAD_STAGE
}

constexpr int N_PHASES = 9;
__global__ void __launch_bounds__(NTHR, 2) hybrid_fwd(Args a) {
    extern __shared__ __attribute__((aligned(16))) unsigned char lds_raw[];
    LAS unsigned char* lds = (LAS unsigned char*)lds_raw;
    const int tid = threadIdx.x, lane = tid & 63, wave = __builtin_amdgcn_readfirstlane(tid >> 6);
    const int G = gridDim.x, bx = blockIdx.x;
    const int vcu = (G % 8 == 0) ? (bx % 8) * (G / 8) + bx / 8 : bx;
    const int gw = vcu * NWAVES + wave, NGW = G * NWAVES;
    unsigned char* ws = a.ws;
    float* MOD = (float*)(ws + WS_MOD); float* SWp = (float*)(ws + WS_SW); float* SSQ = (float*)(ws + WS_SSQ);
    bf16_t* WAB = (bf16_t*)(ws + WS_WAB); bf16_t* WOAB = (bf16_t*)(ws + WS_WOAB); bf16_t* WC = (bf16_t*)(ws + WS_WC); bf16_t* WOC = (bf16_t*)(ws + WS_WOC);
    bf16_t* H0 = (bf16_t*)(ws + WS_H0); bf16_t* Y = (bf16_t*)(ws + WS_Y);
    bf16_t* Ub = (bf16_t*)(ws + WS_U); bf16_t* Gb = (bf16_t*)(ws + WS_G); bf16_t* UZb = (bf16_t*)(ws + WS_UZ); bf16_t* Vb = (bf16_t*)(ws + WS_V);
    bf16_t* X1 = (bf16_t*)(ws + WS_X1); bf16_t* H1 = (bf16_t*)(ws + WS_H1);
    bf16_t* Qb = (bf16_t*)(ws + WS_Q); bf16_t* Kb = (bf16_t*)(ws + WS_K); bf16_t* Zb = (bf16_t*)(ws + WS_Z); bf16_t* VTb = (bf16_t*)(ws + WS_VT); bf16_t* OZb = (bf16_t*)(ws + WS_OZ);
    const int lo = a.ph_lo, hi = a.ph_hi;
#define IN(k) (lo <= (k) && (k) < hi)
    volatile LAS unsigned* bst = (volatile LAS unsigned*)(lds + LDS_BYTES - 64);
    if (tid < 4) bst[tid] = 0u;
    __syncthreads();
    XcdBarrier xbar; xbar.bar = (unsigned*)(ws + WS_CTL); xbar.x = 0; xbar.st = bst;
    if (hi - lo > 1) xbar = xcd_barrier_post((unsigned*)(ws + WS_CTL), bst);
#define SEAM(k) do { if (IN(k) && IN((k) + 1)) xcd_barrier(xbar); } while (0)

    if (IN(0)) {
        for (int task = bx; task < 192; task += G) {
            LAS float* sc_l = (LAS float*)lds; LAS float* red = sc_l + 2048;
            for (int i = tid; i < BATCH * D; i += NTHR) { const float v = a.c[i]; sc_l[i] = v / (1.0f + __expf(-v)); }
            __syncthreads();
            const int l = task / 96, n0 = (task % 96) * 32, kc = wave * 2 + (lane >> 5), n = n0 + (lane & 31);
            const float* W = a.ada_w + (size_t)l * D * 3072 + (size_t)(kc * 64) * 3072 + n;
            float a0 = 0.f, a1 = 0.f;
#pragma unroll
            for (int k = 0; k < 64; ++k) { const float wv = W[(size_t)k * 3072]; a0 += sc_l[kc * 64 + k] * wv; a1 += sc_l[D + kc * 64 + k] * wv; }
            red[(kc * 2 + 0) * 32 + (lane & 31)] = a0; red[(kc * 2 + 1) * 32 + (lane & 31)] = a1;
            __syncthreads();
            if (tid < 64) { const int b = tid >> 5, nn = tid & 31; float s = 0.f;
#pragma unroll
                for (int k = 0; k < 16; ++k) s += red[(k * 2 + b) * 32 + nn];
                MOD[(l * 2 + b) * 3072 + n0 + nn] = s + a.ada_b[l * 3072 + n0 + nn]; }
            __syncthreads();
        }
        for (int i = gw * 64 + lane; i < 8 * 128 * 128 / 8; i += NGW * 64) {
            const int e0 = 8 * i, t = (e0 >> 7) & 127, s0 = e0 & 127; const f32x4 p = *(const f32x4*)(a.sg_w + e0), q = *(const f32x4*)(a.sg_w + e0 + 4);
            float e[8] = {p.x, p.y, p.z, p.w, q.x, q.y, q.z, q.w};
#pragma unroll
            for (int k = 0; k < 8; ++k) if (s0 + k > t) e[k] = 0.f;
            u32x4 wv; wv.x = cvt_pk_bf16(e[0], e[1]); wv.y = cvt_pk_bf16(e[2], e[3]); wv.z = cvt_pk_bf16(e[4], e[5]); wv.w = cvt_pk_bf16(e[6], e[7]);
            *(u32x4*)((bf16_t*)(ws + WS_WTR) + e0) = wv; }
        LAS float* scr = (LAS float*)(lds + wave * 16384);
        constexpr int I_AB = (D / 64) * (IN_AB / 32), I_OAB = (2048 / 64) * (D / 32), I_C = (D / 64) * (IN_C / 32), I_OC = (D / 64) * (D / 32);
        for (int it = gw; it < I_AB + I_OAB + I_C + I_OC; it += NGW) {
            int r = it;
            if (r < I_AB) { p0_transpose_item<1>(a.w_in_ab, D, IN_AB, WAB, scr, r, lane); continue; } r -= I_AB;
            if (r < I_OAB) { p0_transpose_item<0>(a.w_out_ab, 2048, D, WOAB, scr, r, lane); continue; } r -= I_OAB;
            if (r < I_C) { p0_transpose_item<2>(a.w_in_c, D, IN_C, WC, scr, r, lane); continue; } r -= I_C;
            p0_transpose_item<0>(a.w_out_c, D, D, WOC, scr, r, lane);
        }
    }
    SEAM(0);
    if (IN(1)) {
        rms_phase(a.x, a.ln_g, MOD, H0, gw, NGW, lane);
        { f32x4 s0[2][2], s1[2][2];
#pragma unroll
          for (int c = 0; c < 2; ++c)
#pragma unroll
              for (int q = 0; q < 2; ++q) { s0[c][q] = *(const f32x4*)(MOD + 2 * 3072 + 512 * c + 8 * lane + 4 * q); s1[c][q] = *(const f32x4*)(MOD + 3 * 3072 + 512 * c + 8 * lane + 4 * q); }
          for (int n = gw; n < IN_C; n += NGW) {
              const bf16_t* wr_ = WC + (size_t)c_row(n) * D + 8 * lane; float a0 = 0.f, a1 = 0.f;
#pragma unroll
              for (int c = 0; c < 2; ++c) { const u32x4 t = *(const u32x4*)(wr_ + 512 * c);
                  const f32x4 w0 = (f32x4){bf_lo(t.x), bf_hi(t.x), bf_lo(t.y), bf_hi(t.y)}, w1 = (f32x4){bf_lo(t.z), bf_hi(t.z), bf_lo(t.w), bf_hi(t.w)};
                  const f32x4 p0 = w0 * s0[c][0] + w1 * s0[c][1], p1 = w0 * s1[c][0] + w1 * s1[c][1];
                  a0 += (p0[0] + p0[1]) + (p0[2] + p0[3]); a1 += (p1[0] + p1[1]) + (p1[2] + p1[3]); }
              a0 = wave_sum(a0); a1 = wave_sum(a1);
              if (lane == 0) { SWp[n] = a0; SWp[4096 + n] = a1; } } }
    }
    SEAM(1);
    if (IN(2)) { pg8::Sched2 S; S.init(H0, WAB, M, IN_AB, nullptr, nullptr, 0, 0, D, G, bx);
        pg8::EpiP1 E{Ub}; pg8::gemm_phase<pg8::EpiP1, true, true>(lds, S, E); }
    SEAM(2);
    if (IN(3)) mixer_phase(lds, Ub, Gb, UZb, Vb, a.conv_w, a.sg_norm, (const bf16_t*)(ws + WS_WTR), a.sg_b, Y, vcu, G);
    SEAM(3);
    if (IN(4)) { pg8::Sched2 S; S.init(Y, WOAB, M, D, nullptr, nullptr, 0, 0, 2048, G, bx);
        pg8::EpiRes<true> E{a.x, X1, MOD + 2048, a.ln_g + D, MOD + 2 * 3072 + 1024, H1, SSQ}; pg8::gemm_phase<pg8::EpiRes<true>, true, true>(lds, S, E); }
    if (IN(4) && IN(6)) xcd_barrier(xbar);
    if (IN(6)) { pg8::Sched2 S; S.init(H1, WC, M, 3072, WC + (size_t)3072 * D, H1, D, M, D, G, bx);
        pg8::EpiP5 E{Qb, VTb, a.q_norm, a.k_norm, SSQ, SWp}; pg8::gemm_phase<pg8::EpiP5, true, true>(lds, S, E); }
    SEAM(6);
    if (IN(7)) attn_phase(lds, Qb, Kb, VTb, Zb, OZb, vcu, G);
    SEAM(7);
    if (IN(8)) { pg8::Sched2 S; S.init(OZb, WOC, M, D, nullptr, nullptr, 0, 0, D, G, bx);
        pg8::EpiRes<false> E{X1, a.out, MOD + 2 * 3072 + 2048, nullptr, nullptr, nullptr, nullptr}; pg8::gemm_phase<pg8::EpiRes<false>, true, true>(lds, S, E); }
#undef IN
#undef SEAM
}

extern "C" void kernel_launch(void* const* d_in, const int* in_sizes, int n_in, void* d_out, int out_size, void* d_ws, size_t ws_size, hipStream_t stream) {
    static int grid = 0;
    if (grid == 0) {
        if (n_in != 15 || in_sizes[0] != M * D || out_size != M * D || ws_size < WS_END) { fprintf(stderr, "kernel_launch: unexpected problem geometry (n_in %d, ws %zu)\n", n_in, ws_size); grid = -1; return; }
        int dev = 0, cus = 0, per_cu = 0;
        (void)hipGetDevice(&dev); (void)hipDeviceGetAttribute(&cus, hipDeviceAttributeMultiprocessorCount, dev);
        if (hipFuncSetAttribute((const void*)hybrid_fwd, hipFuncAttributeMaxDynamicSharedMemorySize, LDS_BYTES) != hipSuccess) { fprintf(stderr, "kernel_launch: hipFuncSetAttribute failed\n"); grid = -1; return; }
        if (hipOccupancyMaxActiveBlocksPerMultiprocessor(&per_cu, (const void*)hybrid_fwd, NTHR, LDS_BYTES) != hipSuccess || per_cu < 1) { fprintf(stderr, "kernel_launch: occupancy query says %d\n", per_cu); per_cu = 1; }
        (void)hipGetLastError();
        grid = cus * per_cu;
    }
    if (grid < 0) return;
    Args a{};
    a.x = (const float*)d_in[0]; a.c = (const float*)d_in[1]; a.ln_g = (const float*)d_in[2]; a.ada_w = (const float*)d_in[3]; a.ada_b = (const float*)d_in[4];
    a.w_in_ab = (const float*)d_in[5]; a.conv_w = (const float*)d_in[6]; a.sg_norm = (const float*)d_in[7]; a.sg_w = (const float*)d_in[8]; a.sg_b = (const float*)d_in[9];
    a.w_out_ab = (const float*)d_in[10]; a.w_in_c = (const float*)d_in[11]; a.q_norm = (const float*)d_in[12]; a.k_norm = (const float*)d_in[13]; a.w_out_c = (const float*)d_in[14];
    a.out = (float*)d_out; a.ws = (unsigned char*)d_ws;
#if MK_MULTI
    for (int p = 0; p < N_PHASES; ++p) { a.ph_lo = p; a.ph_hi = p + 1; hipLaunchKernelGGL(hybrid_fwd, dim3(grid), dim3(NTHR), LDS_BYTES, stream, a); }
#else
    a.ph_lo = 0; a.ph_hi = N_PHASES;
    (void)hipMemsetAsync((char*)d_ws + WS_CTL, 0, CTL_ZERO_BYTES, stream);
    void* args[] = {&a};
    hipError_t e = hipLaunchCooperativeKernel((const void*)hybrid_fwd, dim3(grid), dim3(NTHR), args, LDS_BYTES, stream);
    if (e != hipSuccess) fprintf(stderr, "kernel_launch: cooperative launch failed: %s (grid %d)\n", hipGetErrorString(e), grid);
#endif
}
```

```cpp
#include <hip/hip_runtime.h>
#include <hip/hip_cooperative_groups.h>
#include <cstdio>
#include <cstdint>
namespace cg = cooperative_groups;

#ifndef MK_MULTI
#define MK_MULTI 0
#endif

#define LAS __attribute__((address_space(3)))
typedef unsigned short bf16_t;
typedef short bf16x8 __attribute__((ext_vector_type(8)));
typedef float f32x4 __attribute__((ext_vector_type(4)));
typedef float f32x16 __attribute__((ext_vector_type(16)));
typedef unsigned u32x4 __attribute__((ext_vector_type(4)));
typedef unsigned u32x2 __attribute__((ext_vector_type(2)));

constexpr int BATCH = 2, SEQ = 8192, D = 1024, M = BATCH * SEQ;
constexpr int IN_AB = 7168, IN_C = 4096;
constexpr float EPS = 1e-6f;
constexpr int NWAVES = 8, NTHR = 512;
constexpr float LOG2E = 1.4426950408889634f;

constexpr size_t MiB = 1u << 20;
constexpr size_t WS_CTL = 0, CTL_ZERO_BYTES = 64 * 1024;
constexpr size_t WS_MOD = 1 * MiB;
constexpr size_t WS_WAB = 2 * MiB;
constexpr size_t WS_WOAB = 16 * MiB;
constexpr size_t WS_WC = 20 * MiB;
constexpr size_t WS_WOC = 28 * MiB;
constexpr size_t WS_SSQ = 31 * MiB;
constexpr size_t WS_SW = 1 * MiB + 65536;
constexpr size_t WS_WTR = 30 * MiB;
constexpr size_t WS_U = 32 * MiB, WS_G = 64 * MiB, WS_UZ = 96 * MiB, WS_V = 128 * MiB;
constexpr size_t WS_H0 = 160 * MiB;
constexpr size_t WS_Y = 160 * MiB;
constexpr size_t WS_X1 = 32 * MiB;
constexpr size_t WS_H1 = 96 * MiB;
constexpr size_t WS_Q = 128 * MiB, WS_K = 160 * MiB, WS_Z = 192 * MiB, WS_VT = 224 * MiB;
constexpr size_t WS_OZ = 96 * MiB;
constexpr size_t WS_END = 256 * MiB;
static_assert(WS_G - WS_U == (size_t)M * D * 2 && WS_UZ - WS_G == (size_t)M * D * 2 && WS_V - WS_UZ == (size_t)M * D * 2 && WS_K - WS_Q == (size_t)M * D * 2 && WS_Z - WS_K == (size_t)M * D * 2, "contiguous activations");

constexpr int LDS_BYTES = 147456;

typedef float f32x2_t __attribute__((ext_vector_type(2))); typedef __bf16 bf16x2_t __attribute__((ext_vector_type(2)));
__device__ __forceinline__ unsigned cvt_pk_bf16(float lo, float hi) { f32x2_t v = {lo, hi}; bf16x2_t b = __builtin_convertvector(v, bf16x2_t); return __builtin_bit_cast(unsigned, b); }
__device__ __forceinline__ float bf_lo(unsigned u) { return __uint_as_float(u << 16); }
__device__ __forceinline__ float bf_hi(unsigned u) { return __uint_as_float(u & 0xffff0000u); }
__device__ __forceinline__ float fast_exp2(float x) { return __builtin_amdgcn_exp2f(x); }
__device__ __forceinline__ float fast_log2(float x) { return __builtin_amdgcn_logf(x); }
__device__ __forceinline__ float fast_rcp(float x) { return __builtin_amdgcn_rcpf(x); }
__device__ __forceinline__ float silu_f(float v) { return v * fast_rcp(1.0f + fast_exp2(-LOG2E * v)); }

namespace pg8 {
constexpr int BM = 256, BK = 64, HALF = 128, HTB = HALF * BK * 2, STAGE_BYTES = 8 * HTB, NXCD = 8, WGM = 4;
__host__ __device__ __forceinline__ int lds_byte(int r, int c) { const int st = (r >> 4) * 2 + (c >> 5), rr = r & 15, cc = c & 31, ob = rr * 64 + cc * 2; return st * 1024 + (ob ^ (((ob >> 9) & 1) << 5)); }
__host__ __device__ __forceinline__ void stage_rc(int b, int& R, int& C) { const int st = b / 1024, sb = b % 1024, swz = sb ^ (((sb >> 9) & 1) << 5); R = (st >> 1) * 16 + swz / 64; C = (st & 1) * 32 + (swz % 64) / 2; }
__host__ __device__ __forceinline__ int perm32(int rho) { const int n = rho >> 4, i = rho & 15; return 8 * (i >> 2) + 4 * n + (i & 3); }

struct Unit { int pm, pn, sel; };
struct Sched2 {
    const bf16_t *A0, *B0, *A1, *B1; int nM0, nN0, nwg0, nM1, nN1, nwg1, G, c, K;
    __device__ void init(const bf16_t* a0, const bf16_t* b0, int m0, int n0, const bf16_t* a1, const bf16_t* b1, int m1, int n1, int K_, int G_, int c_) {
        A0 = a0; B0 = b0; nM0 = m0 / BM; nN0 = n0 / BM; nwg0 = nM0 * nN0; A1 = a1; B1 = b1; nM1 = m1 / BM; nN1 = n1 / BM; nwg1 = nM1 * nN1; K = K_; G = G_; c = c_; }
    __device__ static void map(int wgid, int nM, int nN, int& pm, int& pn) {
        const int nwg = nM * nN; { const int q = nwg / NXCD, r = nwg % NXCD, xcd = wgid % NXCD, off = wgid / NXCD; wgid = (xcd < r ? xcd * (q + 1) : r * (q + 1) + (xcd - r) * q) + off; }
        const int nig = WGM * nN, gid = wgid / nig, fm = gid * WGM, gsz = (nM - fm) < WGM ? (nM - fm) : WGM;
        pm = fm + ((wgid % nig) % gsz); pn = (wgid % nig) / gsz; }
    __device__ bool next(int i, Unit& u) const {
        const int L = i * G + c;
        if (L < nwg0) { map(L, nM0, nN0, u.pm, u.pn); u.sel = 0; return true; }
        if (L < nwg0 + nwg1) { map(L - nwg0, nM1, nN1, u.pm, u.pn); u.sel = 1; return true; }
        return false; }
    __device__ __forceinline__ const char* baseA(const Unit& u) const { return (const char*)(u.sel ? A1 : A0) + (size_t)u.pm * BM * K * 2; }
    __device__ __forceinline__ const char* baseB(const Unit& u) const { return (const char*)(u.sel ? B1 : B0) + (size_t)u.pn * BM * K * 2; }
};

template <class Epi, bool ALIGN_EPI, bool SP2>
__device__ __forceinline__ void gemm_phase(LAS unsigned char* lds, const Sched2& S, const Epi& E) {
    const int tid = threadIdx.x, wid = __builtin_amdgcn_readfirstlane(tid >> 6), lane = tid & 63, wr = wid >> 2, wc = wid & 3, fr = lane & 15, fq = lane >> 4;
    const int K = S.K, nt = K / BK;
    unsigned voffA[2], voffB[2];
#pragma unroll
    for (int i = 0; i < 2; ++i) { int R, C; stage_rc(tid * 16 + i * 8192, R, C); const int Rb = Epi::PERM ? ((R & ~31) + perm32(R & 31)) : R;
        voffA[i] = (unsigned)(R * K + C) * 2u; voffB[i] = (unsigned)(Rb * K + C) * 2u; }
    const size_t kstep = (size_t)(BK * 2);
    const size_t hstep = (size_t)HALF * K * 2;
    const unsigned ldsw = (unsigned)wid * 1024u;
    const int aoff = lds_byte(wr * 64 + fr, fq * 8), boff = lds_byte(wc * 32 + fr, fq * 8);
#define PG8_SA(b, h) (((b) * 2 + (h)) * HTB)
#define PG8_SB(b, h) ((4 + (b) * 2 + (h)) * HTB)
#define PG8_STAGE(bufoff, gbase, voff) do { _Pragma("unroll") for (int _i = 0; _i < 2; ++_i) \
        __builtin_amdgcn_global_load_lds((const unsigned*)((const char*)(gbase) + (voff)[_i]), (LAS unsigned*)(lds + (bufoff) + ldsw + _i * 8192), 16, 0, 0); } while (0)
#define PG8_LDA(dst, b, h) do { _Pragma("unroll") for (int m = 0; m < 4; ++m) _Pragma("unroll") for (int k = 0; k < 2; ++k) dst[m][k] = *(const LAS bf16x8*)(lds + PG8_SA(b, h) + aoff + m * 2048 + k * 1024); } while (0)
#define PG8_LDB(dst, b, h) do { _Pragma("unroll") for (int n = 0; n < 2; ++n) _Pragma("unroll") for (int k = 0; k < 2; ++k) dst[n][k] = *(const LAS bf16x8*)(lds + PG8_SB(b, h) + boff + n * 2048 + k * 1024); } while (0)
#define PG8_MMA(ai, bj, At, Bt) do { __builtin_amdgcn_s_setprio(1); _Pragma("unroll") for (int m = 0; m < 4; ++m) _Pragma("unroll") for (int n = 0; n < 2; ++n) _Pragma("unroll") for (int k = 0; k < 2; ++k) \
        acc[ai][bj][m][n] = __builtin_amdgcn_mfma_f32_16x16x32_bf16(Bt[n][k], At[m][k], acc[ai][bj][m][n], 0, 0, 0); __builtin_amdgcn_s_setprio(0); } while (0)
#define PG8_WAIT_V(n) asm volatile("s_waitcnt vmcnt(" #n ")" ::: "memory")
#define PG8_WAIT_L(n) asm volatile("s_waitcnt lgkmcnt(" #n ")" ::: "memory")
#define PG8_BAR __builtin_amdgcn_s_barrier()
#define PG8_SCHED __builtin_amdgcn_sched_barrier(0)
    Unit cur, nxt; int ui = 0;
    if (!S.next(0, cur)) return;
    f32x4 acc[2][2][4][2];
#pragma unroll
    for (int a = 0; a < 2; ++a)
#pragma unroll
        for (int b = 0; b < 2; ++b)
#pragma unroll
            for (int m = 0; m < 4; ++m)
#pragma unroll
                for (int n = 0; n < 2; ++n) acc[a][b][m][n] = (f32x4){0.f, 0.f, 0.f, 0.f};
    bf16x8 At[4][2], B0[2][2], B1[2][2];
    const char* cA = S.baseA(cur); const char* cB = S.baseB(cur);
    if constexpr (SP2) {
        PG8_STAGE(PG8_SB(0, 0), cB, voffB); PG8_STAGE(PG8_SB(0, 1), cB + hstep, voffB); PG8_STAGE(PG8_SA(0, 0), cA, voffA); PG8_STAGE(PG8_SA(0, 1), cA + hstep, voffA);
        if (wr == 1) PG8_BAR;
        PG8_WAIT_V(2); PG8_BAR;
        PG8_STAGE(PG8_SB(1, 0), cB + kstep, voffB); PG8_STAGE(PG8_SA(1, 0), cA + kstep, voffA); PG8_STAGE(PG8_SB(1, 1), cB + hstep + kstep, voffB);
        PG8_WAIT_V(6); PG8_BAR;
    } else {
        PG8_STAGE(PG8_SB(0, 0), cB, voffB); PG8_STAGE(PG8_SA(0, 0), cA, voffA); PG8_STAGE(PG8_SB(0, 1), cB + hstep, voffB); PG8_STAGE(PG8_SA(0, 1), cA + hstep, voffA);
        if (wr == 1) PG8_BAR;
        PG8_WAIT_V(4); PG8_BAR;
        PG8_STAGE(PG8_SB(1, 0), cB + kstep, voffB); PG8_STAGE(PG8_SA(1, 0), cA + kstep, voffA); PG8_STAGE(PG8_SB(1, 1), cB + hstep + kstep, voffB);
        PG8_WAIT_V(6); PG8_BAR;
    }
    for (;;) {
        const bool has_next = S.next(ui + 1, nxt);
        const char* nA = has_next ? S.baseA(nxt) : cA; const char* nB = has_next ? S.baseB(nxt) : cB;
        for (int t = 0; t < nt; t += 2) {
            const bool last = (t == nt - 2);
            const char* a1 = cA + (size_t)(t + 1) * kstep;
            const char* a2 = last ? nA : cA + (size_t)(t + 2) * kstep; const char* b2 = last ? nB : cB + (size_t)(t + 2) * kstep;
            const char* a3 = a2 + kstep; const char* b3 = b2 + kstep;
            if constexpr (SP2) {
            PG8_LDB(B0, 0, 0); PG8_LDB(B1, 0, 1); PG8_SCHED; PG8_LDA(At, 0, 0); PG8_STAGE(PG8_SA(1, 1), a1 + hstep, voffA);
            PG8_WAIT_V(8); PG8_WAIT_L(0); PG8_BAR; PG8_MMA(0, 0, At, B0); PG8_MMA(0, 1, At, B1); PG8_BAR; PG8_SCHED;
            PG8_LDA(At, 0, 1); PG8_STAGE(PG8_SB(0, 0), b2, voffB); PG8_STAGE(PG8_SB(0, 1), b2 + hstep, voffB); PG8_STAGE(PG8_SA(0, 0), a2, voffA);
            PG8_WAIT_V(8); PG8_WAIT_L(0); PG8_BAR; PG8_MMA(1, 0, At, B0); PG8_MMA(1, 1, At, B1); PG8_BAR; PG8_SCHED;
            PG8_LDB(B0, 1, 0); PG8_LDB(B1, 1, 1); PG8_SCHED; PG8_LDA(At, 1, 0); PG8_STAGE(PG8_SA(0, 1), a2 + hstep, voffA);
            PG8_WAIT_V(8); PG8_WAIT_L(0); PG8_BAR; PG8_MMA(0, 0, At, B0); PG8_MMA(0, 1, At, B1); PG8_BAR; PG8_SCHED;
            PG8_LDA(At, 1, 1); PG8_STAGE(PG8_SB(1, 0), b3, voffB); PG8_STAGE(PG8_SB(1, 1), b3 + hstep, voffB); PG8_STAGE(PG8_SA(1, 0), a3, voffA);
            PG8_WAIT_V(8); PG8_WAIT_L(0); PG8_BAR; PG8_MMA(1, 0, At, B0); PG8_MMA(1, 1, At, B1); PG8_BAR; PG8_SCHED;
            } else {
            PG8_LDB(B0, 0, 0); PG8_SCHED; PG8_LDA(At, 0, 0); PG8_STAGE(PG8_SA(1, 1), a1 + hstep, voffA);
            PG8_WAIT_L(8); PG8_BAR; PG8_WAIT_L(0); PG8_MMA(0, 0, At, B0); PG8_BAR; PG8_SCHED;
            PG8_LDB(B1, 0, 1); PG8_STAGE(PG8_SB(0, 0), b2, voffB);
            PG8_BAR; PG8_WAIT_L(0); PG8_MMA(0, 1, At, B1); PG8_BAR;
            PG8_LDA(At, 0, 1); PG8_STAGE(PG8_SA(0, 0), a2, voffA);
            PG8_BAR; PG8_WAIT_L(0); PG8_MMA(1, 0, At, B0); PG8_BAR; PG8_SCHED;
            PG8_STAGE(PG8_SB(0, 1), b2 + hstep, voffB);
            PG8_WAIT_V(6); PG8_BAR; PG8_MMA(1, 1, At, B1); PG8_BAR;
            PG8_LDB(B0, 1, 0); PG8_SCHED; PG8_LDA(At, 1, 0); PG8_STAGE(PG8_SA(0, 1), a2 + hstep, voffA);
            PG8_WAIT_L(8); PG8_BAR; PG8_WAIT_L(0); PG8_MMA(0, 0, At, B0); PG8_BAR; PG8_SCHED;
            PG8_LDB(B1, 1, 1); PG8_STAGE(PG8_SB(1, 0), b3, voffB);
            PG8_BAR; PG8_WAIT_L(0); PG8_MMA(0, 1, At, B1); PG8_BAR;
            PG8_LDA(At, 1, 1); PG8_STAGE(PG8_SA(1, 0), a3, voffA);
            PG8_BAR; PG8_WAIT_L(0); PG8_MMA(1, 0, At, B0); PG8_BAR; PG8_SCHED;
            PG8_STAGE(PG8_SB(1, 1), b3 + hstep, voffB);
            PG8_WAIT_V(6); PG8_BAR; PG8_MMA(1, 1, At, B1); PG8_BAR;
            }
        }
        if constexpr (ALIGN_EPI) { if (wr == 0) PG8_BAR; }
        E(acc, cur, wr, wc, fr, fq);
        if (!has_next) break;
#pragma unroll
        for (int a = 0; a < 2; ++a)
#pragma unroll
            for (int b = 0; b < 2; ++b)
#pragma unroll
                for (int m = 0; m < 4; ++m)
#pragma unroll
                    for (int n = 0; n < 2; ++n) acc[a][b][m][n] = (f32x4){0.f, 0.f, 0.f, 0.f};
        cur = nxt; cA = nA; cB = nB; ++ui;
        if constexpr (ALIGN_EPI) { if (wr == 1) PG8_BAR; }
    }
    PG8_WAIT_V(0);
    if constexpr (!ALIGN_EPI) { if (wr == 0) PG8_BAR; }
    PG8_BAR;
#undef PG8_SA
#undef PG8_SB
#undef PG8_STAGE
#undef PG8_LDA
#undef PG8_LDB
#undef PG8_MMA
#undef PG8_WAIT_V
#undef PG8_WAIT_L
#undef PG8_BAR
#undef PG8_SCHED
}

struct EpiP1 {
    static constexpr bool PERM = true;
    bf16_t* U;
    __device__ __forceinline__ void operator()(const f32x4 (&acc)[2][2][4][2], const Unit& u, int wr, int wc, int fr, int fq) const {
        const int row0 = u.pm * BM + wr * 64 + fr;
        bf16_t* O = U + (size_t)(u.pn >> 3) * ((size_t)M * D);
        if (u.pn < 24) {
            const bool act = u.pn >= 8;
            const int col0 = (u.pn & 7) * 128 + wc * 32 + 8 * fq;
#pragma unroll
            for (int ai = 0; ai < 2; ++ai)
#pragma unroll
                for (int m = 0; m < 4; ++m) { bf16_t* rowp = O + (size_t)(row0 + ai * HALF + m * 16) * D + col0;
                    f32x4 a0 = acc[ai][0][m][0], a1 = acc[ai][0][m][1], b0 = acc[ai][1][m][0], b1 = acc[ai][1][m][1];
                    if (act) {
#pragma unroll
                        for (int j = 0; j < 4; ++j) { b0[j] = silu_f(b0[j]); b1[j] = silu_f(b1[j]); } }
                    a0 = a0 * b0; a1 = a1 * b1;
                    u32x4 w; w.x = cvt_pk_bf16(a0[0], a0[1]); w.y = cvt_pk_bf16(a0[2], a0[3]); w.z = cvt_pk_bf16(a1[0], a1[1]); w.w = cvt_pk_bf16(a1[2], a1[3]);
                    *(u32x4*)rowp = w; }
        } else {
            const int col0 = (u.pn - 24) * 256 + wc * 32 + 8 * fq;
#pragma unroll
            for (int ai = 0; ai < 2; ++ai)
#pragma unroll
                for (int m = 0; m < 4; ++m) { bf16_t* rowp = O + (size_t)(row0 + ai * HALF + m * 16) * D + col0;
#pragma unroll
                    for (int bj = 0; bj < 2; ++bj) { const f32x4 v0 = acc[ai][bj][m][0], v1 = acc[ai][bj][m][1];
                        u32x4 w; w.x = cvt_pk_bf16(v0[0], v0[1]); w.y = cvt_pk_bf16(v0[2], v0[3]); w.z = cvt_pk_bf16(v1[0], v1[1]); w.w = cvt_pk_bf16(v1[2], v1[3]);
                        *(u32x4*)(rowp + bj * HALF) = w; } }
        }
    }
};
struct EpiP5 {
    static constexpr bool PERM = true;
    bf16_t *Q, *VT; const float *qn, *kn;
    const float* ssq; const float* sw;
    __device__ __forceinline__ float rstd_of(int token, int part  ) const { const f32x4 p = *(const f32x4*)(ssq + (size_t)token * 16 + 4 * part); return (p[0] + p[1]) + (p[2] + p[3]); }
    __device__ __forceinline__ void operator()(const f32x4 (&acc)[2][2][4][2], const Unit& u, int wr, int wc, int fr, int fq) const {
        const int row0 = u.pm * BM + wr * 64 + fr;
        if (u.sel == 1) {
            const int col0 = u.pn * BM + wc * 32 + 8 * fq, bt = (u.pn * BM) / SEQ;
            float mine; { const int k = fr, tok = col0 + (k >> 3) * HALF + ((k >> 2) & 1) * 4 + (k & 3);
                const float t = (rstd_of(tok, 0) + rstd_of(tok, 1)) + (rstd_of(tok, 2) + rstd_of(tok, 3)); mine = __builtin_amdgcn_rsqf(t * (1.0f / D) + EPS); }
            f32x4 rs[2][2];
#pragma unroll
            for (int k = 0; k < 16; ++k) rs[k >> 3][(k >> 2) & 1][k & 3] = __shfl(mine, (fq << 4) | k);
#pragma unroll
            for (int ai = 0; ai < 2; ++ai)
#pragma unroll
                for (int m = 0; m < 4; ++m) { const int hd = row0 + ai * HALF + m * 16; const float swv = sw[bt * 4096 + 2048 + hd]; bf16_t* rowp = VT + (size_t)hd * M + col0;
#pragma unroll
                    for (int bj = 0; bj < 2; ++bj) { const f32x4 v0 = acc[ai][bj][m][0] * rs[bj][0] + swv, v1 = acc[ai][bj][m][1] * rs[bj][1] + swv;
                        u32x4 w; w.x = cvt_pk_bf16(v0[0], v0[1]); w.y = cvt_pk_bf16(v0[2], v0[3]); w.z = cvt_pk_bf16(v1[0], v1[1]); w.w = cvt_pk_bf16(v1[2], v1[3]);
                        *(u32x4*)(rowp + bj * HALF) = w; } }
            return;
        }
        const int bt = (u.pm * BM) / SEQ;
        float rs[2][4];
#pragma unroll
        for (int ai = 0; ai < 2; ++ai)
#pragma unroll
            for (int m = 0; m < 4; ++m) { float t = rstd_of(row0 + ai * HALF + m * 16, fq); t += __shfl_xor(t, 16); t += __shfl_xor(t, 32); rs[ai][m] = __builtin_amdgcn_rsqf(t * (1.0f / D) + EPS); }
        if (u.pn >= 8) {
            const int col0 = (u.pn - 8) * BM + wc * 32 + 8 * fq;
            f32x4 s4[2][2];
#pragma unroll
            for (int bj = 0; bj < 2; ++bj)
#pragma unroll
                for (int n = 0; n < 2; ++n) s4[bj][n] = *(const f32x4*)(sw + bt * 4096 + 3072 + col0 + bj * HALF + 4 * n);
#pragma unroll
            for (int ai = 0; ai < 2; ++ai)
#pragma unroll
                for (int m = 0; m < 4; ++m) { bf16_t* rowp = Q + 2 * (size_t)M * D + (size_t)(row0 + ai * HALF + m * 16) * D + col0;
#pragma unroll
                    for (int bj = 0; bj < 2; ++bj) { f32x4 v0 = acc[ai][bj][m][0] * rs[ai][m] + s4[bj][0], v1 = acc[ai][bj][m][1] * rs[ai][m] + s4[bj][1];
#pragma unroll
                        for (int j = 0; j < 4; ++j) { v0[j] = silu_f(v0[j]); v1[j] = silu_f(v1[j]); }
                        u32x4 w; w.x = cvt_pk_bf16(v0[0], v0[1]); w.y = cvt_pk_bf16(v0[2], v0[3]); w.z = cvt_pk_bf16(v1[0], v1[1]); w.w = cvt_pk_bf16(v1[2], v1[3]);
                        *(u32x4*)(rowp + bj * HALF) = w; } }
        } else {
            const bool isq = u.pn < 4; bf16_t* O = Q + (size_t)(u.pn >> 2) * ((size_t)M * D); const float* nw = qn; if (!isq) nw = kn; const float sc = isq ? (LOG2E * 0.125f) : 1.0f;
            const int col0 = (u.pn & 3) * BM + 64 * wc + 8 * fq;
            f32x4 w4[2][2], s4[2][2];
#pragma unroll
            for (int bj = 0; bj < 2; ++bj)
#pragma unroll
                for (int n = 0; n < 2; ++n) { w4[bj][n] = *(const f32x4*)(nw + 32 * bj + 8 * fq + 4 * n); s4[bj][n] = *(const f32x4*)(sw + bt * 4096 + (u.pn >> 2) * 1024 + col0 + 32 * bj + 4 * n); }
#pragma unroll
            for (int ai = 0; ai < 2; ++ai)
#pragma unroll
                for (int m = 0; m < 4; ++m) {
                    f32x4 v[2][2]; float ss = 0.f;
#pragma unroll
                    for (int bj = 0; bj < 2; ++bj)
#pragma unroll
                        for (int n = 0; n < 2; ++n) { v[bj][n] = acc[ai][bj][m][n] * rs[ai][m] + s4[bj][n]; const f32x4 t = v[bj][n]; ss += (t[0] * t[0] + t[1] * t[1]) + (t[2] * t[2] + t[3] * t[3]); }
                    ss += __shfl_xor(ss, 16); ss += __shfl_xor(ss, 32);
                    const float rq = __builtin_amdgcn_rsqf(ss * (1.0f / 64.0f) + EPS) * sc;
                    bf16_t* rowp = O + (size_t)(row0 + ai * HALF + m * 16) * D + col0;
#pragma unroll
                    for (int bj = 0; bj < 2; ++bj) { const f32x4 v0 = v[bj][0] * rq * w4[bj][0], v1 = v[bj][1] * rq * w4[bj][1];
                        u32x4 w; w.x = cvt_pk_bf16(v0[0], v0[1]); w.y = cvt_pk_bf16(v0[2], v0[3]); w.z = cvt_pk_bf16(v1[0], v1[1]); w.w = cvt_pk_bf16(v1[2], v1[3]);
                        *(u32x4*)(rowp + 32 * bj) = w; } }
        }
    }
};
template <bool STATS> struct EpiRes {
    static constexpr bool PERM = true;
    const void* base; void* out; const float* gate; const float* lng; const float* scale; bf16_t* xm; float* ssq;
    __device__ __forceinline__ void operator()(const f32x4 (&acc)[2][2][4][2], const Unit& u, int wr, int wc, int fr, int fq) const {
        const int row0 = u.pm * BM + wr * 64 + fr, col0 = u.pn * BM + wc * 32 + 8 * fq, bt = (u.pm * BM) / SEQ;
        f32x4 gv[2][2], mv[2][2];
#pragma unroll
        for (int bj = 0; bj < 2; ++bj)
#pragma unroll
            for (int n = 0; n < 2; ++n) { gv[bj][n] = *(const f32x4*)(gate + bt * 3072 + col0 + bj * HALF + 4 * n);
                if (STATS) mv[bj][n] = *(const f32x4*)(lng + col0 + bj * HALF + 4 * n) * (*(const f32x4*)(scale + bt * 3072 + col0 + bj * HALF + 4 * n) + 1.0f); }
        constexpr int MB = STATS ? 2 : 4;
#pragma unroll
        for (int ai = 0; ai < 2; ++ai)
#pragma unroll
        for (int mb = 0; mb < 4; mb += MB) {
            f32x4 bf[MB][2][2]; u32x4 bh[MB][2];
#pragma unroll
            for (int mm = 0; mm < MB; ++mm) { const size_t off = (size_t)(row0 + ai * HALF + (mb + mm) * 16) * D + col0;
#pragma unroll
                for (int bj = 0; bj < 2; ++bj) {
                    if (STATS) { bf[mm][bj][0] = *(const f32x4*)((const float*)base + off + bj * HALF); bf[mm][bj][1] = *(const f32x4*)((const float*)base + off + bj * HALF + 4); }
                    else bh[mm][bj] = *(const u32x4*)((const bf16_t*)base + off + bj * HALF); } }
#pragma unroll
            for (int mm = 0; mm < MB; ++mm) { const int m = mb + mm; const int row = row0 + ai * HALF + m * 16; const size_t off = (size_t)row * D + col0; float ss = 0.f;
#pragma unroll
                for (int bj = 0; bj < 2; ++bj) { f32x4 b0, b1;
                    if (STATS) { b0 = bf[mm][bj][0]; b1 = bf[mm][bj][1]; }
                    else { const u32x4 t = bh[mm][bj]; b0 = (f32x4){bf_lo(t.x), bf_hi(t.x), bf_lo(t.y), bf_hi(t.y)}; b1 = (f32x4){bf_lo(t.z), bf_hi(t.z), bf_lo(t.w), bf_hi(t.w)}; }
                    const f32x4 o0 = b0 + gv[bj][0] * acc[ai][bj][m][0], o1 = b1 + gv[bj][1] * acc[ai][bj][m][1];
                    if (STATS) { u32x4 w; w.x = cvt_pk_bf16(o0[0], o0[1]); w.y = cvt_pk_bf16(o0[2], o0[3]); w.z = cvt_pk_bf16(o1[0], o1[1]); w.w = cvt_pk_bf16(o1[2], o1[3]);
                        *(u32x4*)((bf16_t*)out + off + bj * HALF) = w;
                        ss += (o0[0] * o0[0] + o0[1] * o0[1]) + (o0[2] * o0[2] + o0[3] * o0[3]) + (o1[0] * o1[0] + o1[1] * o1[1]) + (o1[2] * o1[2] + o1[3] * o1[3]);
                        const f32x4 x0 = o0 * mv[bj][0], x1 = o1 * mv[bj][1];
                        u32x4 w2; w2.x = cvt_pk_bf16(x0[0], x0[1]); w2.y = cvt_pk_bf16(x0[2], x0[3]); w2.z = cvt_pk_bf16(x1[0], x1[1]); w2.w = cvt_pk_bf16(x1[2], x1[3]);
                        *(u32x4*)(xm + off + bj * HALF) = w2; }
                    else { *(f32x4*)((float*)out + off + bj * HALF) = o0; *(f32x4*)((float*)out + off + bj * HALF + 4) = o1; } }
                if (STATS) { ss += __shfl_xor(ss, 16); ss += __shfl_xor(ss, 32); if (fq == 0) ssq[(size_t)row * 16 + u.pn * 4 + wc] = ss; } }
        }
    }
};
}

#define XB_TMO      128
#define XB_XCNT(j)  (256  + 64 * (j))
#define XB_XSUB(j)  (1280 + 64 * (j))
#define XB_XGEN(j)  (2304 + 64 * (j))
#define XB_TOP      3328
#define XB_TOPGEN   3392
#define XCD_BAR_WORDS 3456
#define XB_SPIN_CAP (1u << 18)
__device__ __forceinline__ unsigned xb_ld(unsigned* p)              { return __hip_atomic_load(p, __ATOMIC_RELAXED, __HIP_MEMORY_SCOPE_AGENT); }
__device__ __forceinline__ unsigned xb_add(unsigned* p, unsigned v) { return __hip_atomic_fetch_add(p, v, __ATOMIC_RELAXED, __HIP_MEMORY_SCOPE_AGENT); }
__device__ __forceinline__ unsigned xb_xcc_id() { return (unsigned)__builtin_amdgcn_s_getreg((3 << 11) | 20) & 0xFu; }
#define XB_SPIN(cond, bar) do { unsigned _sp = 0; while (cond) { __builtin_amdgcn_s_sleep(1); \
    if ((++_sp & 255u) == 0u) { if (xb_ld(&(bar)[XB_TMO])) break; if (_sp > XB_SPIN_CAP) { atomicAdd(&(bar)[XB_TMO], 1u); break; } } } } while (0)
struct XcdBarrier { unsigned* bar; unsigned x; volatile LAS unsigned* st; };
__device__ __forceinline__ XcdBarrier xcd_barrier_post(unsigned* bar, volatile LAS unsigned* st) {
    XcdBarrier b; b.bar = bar; b.x = xb_xcc_id(); b.st = st;
    if (threadIdx.x == 0) (void)xb_add(&bar[XB_XCNT(b.x)], 1u);
    return b;
}
__device__ __forceinline__ void xcd_barrier_complete(unsigned* bar, unsigned x, unsigned& nloc, unsigned& nx) {
    const unsigned G = gridDim.x * gridDim.y * gridDim.z;
    unsigned sum, cnt, mine, sp = 0u;
    for (;;) {
        sum = 0u; cnt = 0u; mine = 0u;
#pragma unroll
        for (unsigned j = 0; j < 16; ++j) { const unsigned c = xb_ld(&bar[XB_XCNT(j)]); sum += c; cnt += (c > 0u) ? 1u : 0u; mine = (j == x) ? c : mine; }
        if (sum == G) break;
        __builtin_amdgcn_s_sleep(1);
        if ((++sp & 255u) == 0u) { if (xb_ld(&bar[XB_TMO])) break; if (sp > XB_SPIN_CAP) { atomicAdd(&bar[XB_TMO], 1u); break; } }
    }
    nloc = mine > 0u ? mine : 1u; nx = cnt > 0u ? cnt : 1u;
}
__device__ __forceinline__ void xcd_barrier(const XcdBarrier& b) {
    asm volatile("s_waitcnt vmcnt(0)" ::: "memory");
    __syncthreads();
    if (threadIdx.x == 0) {
        unsigned* bar = b.bar;
        __builtin_amdgcn_s_waitcnt(0);
        unsigned nloc = b.st[0], nx = b.st[1];
        if (nloc == 0u) { xcd_barrier_complete(bar, b.x, nloc, nx); b.st[0] = nloc; b.st[1] = nx; }
        const unsigned old = xb_add(&bar[XB_XSUB(b.x)], 1u);
        const unsigned gen = old / nloc;
        if (old + 1u == (gen + 1u) * nloc) {
            __builtin_amdgcn_fence(__ATOMIC_RELEASE, "agent");
            asm volatile("s_waitcnt vmcnt(0)" ::: "memory");
            const unsigned og = xb_add(&bar[XB_TOP], 1u);
            const unsigned tg = og / nx;
            if (og + 1u == (tg + 1u) * nx) xb_add(&bar[XB_TOPGEN], 1u);
            else XB_SPIN(xb_ld(&bar[XB_TOPGEN]) == tg, bar);
            __builtin_amdgcn_fence(__ATOMIC_ACQUIRE, "agent");
            xb_add(&bar[XB_XGEN(b.x)], 1u);
            asm volatile("s_waitcnt vmcnt(0)" ::: "memory");
        } else {
            XB_SPIN(xb_ld(&bar[XB_XGEN(b.x)]) == gen, bar);
            __builtin_amdgcn_fence(__ATOMIC_ACQUIRE, "agent");
            asm volatile("s_waitcnt vmcnt(0)" ::: "memory");
        }
    }
    __syncthreads();
}

struct Args {
    const float *x, *c, *ln_g, *ada_w, *ada_b, *w_in_ab, *conv_w, *sg_norm, *sg_w, *sg_b, *w_out_ab, *w_in_c, *q_norm, *k_norm, *w_out_c;
    float* out; unsigned char* ws; int ph_lo, ph_hi;
};

__device__ __forceinline__ int ab_row(int c) {
    const int seg = c >> 10, cc = c & 1023, t = cc >> 7, r = cc & 127;
    switch (seg) {
        case 1: return 256 * t + r;
        case 2: return 256 * t + 128 + r;
        case 0: return 256 * (8 + t) + r;
        case 3: return 256 * (8 + t) + 128 + r;
        case 4: return 256 * (16 + t) + r;
        case 6: return 256 * (16 + t) + 128 + r;
        default: return 256 * 24 + cc;
    }
}
__device__ __forceinline__ int c_row(int c) {
    const int seg = c >> 10, cc = c & 1023;
    if (seg == 2) return 3072 + cc;
    if (seg == 3) return 2048 + cc;
    const int tile = cc >> 8, ct = cc & 255, hh = ct >> 6, bj = (ct >> 5) & 1, i = ct & 31;
    return seg * 1024 + tile * 256 + 128 * bj + 32 * hh + i;
}
template <int MODE>
__device__ __forceinline__ void p0_transpose_item(const float* W, int K, int N, bf16_t* WT, LAS float* scr, int item, int lane) {
    const int nblk = N / 32, kb = item / nblk, nb = item % nblk, k0 = 64 * kb, n0 = 32 * nb;
    const int rb = MODE == 1 ? ab_row(n0) : (MODE == 2 ? c_row(n0) : n0);
#pragma unroll 8
    for (int i = 0; i < 32; ++i) { const int kk = 2 * i + (lane >> 5); scr[kk * 33 + (lane & 31)] = W[(size_t)(k0 + kk) * N + n0 + (lane & 31)]; }
    asm volatile("s_waitcnt lgkmcnt(0)" ::: "memory");
    const int c = lane & 7;
#pragma unroll
    for (int j = 0; j < 4; ++j) { const int n = (lane >> 3) + 8 * j; const LAS float* s = scr + (8 * c) * 33 + n;
        u32x4 o; o.x = cvt_pk_bf16(s[0 * 33], s[1 * 33]); o.y = cvt_pk_bf16(s[2 * 33], s[3 * 33]); o.z = cvt_pk_bf16(s[4 * 33], s[5 * 33]); o.w = cvt_pk_bf16(s[6 * 33], s[7 * 33]);
        *(u32x4*)(WT + (size_t)(rb + n) * K + k0 + 8 * c) = o; }
    asm volatile("s_waitcnt lgkmcnt(0)" ::: "memory");
}

__device__ __forceinline__ float wave_sum(float v) {
#pragma unroll
    for (int o = 1; o < 64; o <<= 1) v += __shfl_xor(v, o);
    return v;
}
__device__ __forceinline__ void rms_phase(const float* X, const float* g, const float* mod  , bf16_t* H, int gw, int NGW, int lane) {
    for (int b = 0; b < BATCH; ++b) {
        f32x4 mul[4], sh[4];
#pragma unroll
        for (int j = 0; j < 4; ++j) { const int col = 4 * lane + 256 * j; const f32x4 gg = *(const f32x4*)(g + col), sc = *(const f32x4*)(mod + b * 3072 + 1024 + col);
            sh[j] = *(const f32x4*)(mod + b * 3072 + col); mul[j] = gg * (sc + 1.0f); }
#pragma unroll 4
        for (int r = gw; r < SEQ; r += NGW) {
            const size_t m = (size_t)b * SEQ + r;
            const f32x4* xr = (const f32x4*)(X + m * D) + lane;
            f32x4 v[4]; float s = 0.f;
#pragma unroll
            for (int j = 0; j < 4; ++j) { v[j] = xr[64 * j]; s += (v[j].x * v[j].x + v[j].y * v[j].y) + (v[j].z * v[j].z + v[j].w * v[j].w); }
            const float rstd = __builtin_amdgcn_rsqf(wave_sum(s) * (1.f / D) + EPS);
            u32x2* o8 = (u32x2*)(H + m * D) + lane;
#pragma unroll
            for (int j = 0; j < 4; ++j) { const f32x4 o = v[j] * rstd * mul[j] + sh[j]; u32x2 w; w.x = cvt_pk_bf16(o.x, o.y); w.y = cvt_pk_bf16(o.z, o.w); o8[64 * j] = w; }
        }
    }
}

__device__ __forceinline__ void mixer_phase(LAS unsigned char* lds, const bf16_t* U, const bf16_t* Gt, const bf16_t* UZ, const bf16_t* V, const float* conv_w, const float* sg_norm,
                                            const bf16_t* WTR, const float* sg_b, bf16_t* Y, int vcu, int G) {
    const int tid = threadIdx.x, lane = tid & 63, w = __builtin_amdgcn_readfirstlane(tid >> 6), fr = lane & 15, fq = lane >> 4;
    constexpr int PT = 136;
    LAS bf16_t* VNT = (LAS bf16_t*)lds;
    LAS bf16_t* WL = (LAS bf16_t*)(lds + 128 * PT * 2);
    LAS float* SG = (LAS float*)(lds + 2 * 128 * PT * 2);
    int g_staged = -1;
    const int c8 = tid & 15, rg = tid >> 4;
    const int s = tid >> 2, qd = tid & 3;
    for (int unit = vcu; unit < BATCH * 64 * 8; unit += G) {
        const int g = unit & 7, cch = (unit >> 3) & 63, b = unit >> 9; const size_t r0 = (size_t)b * SEQ + cch * 128;
        const int ch = 128 * g + 8 * c8; const size_t row = r0 + 4 * rg;
        u32x4 ur[6], gv[4], vv[4], uz[4];
        const bool halo0 = (cch == 0 && rg == 0);
#pragma unroll
        for (int i = 0; i < 4; ++i) vv[i] = *(const u32x4*)(V + (r0 + s) * D + 128 * g + 32 * qd + 8 * i);
#pragma unroll
        for (int i = 0; i < 6; ++i) { if (i < 2 && halo0) ur[i] = (u32x4){0u, 0u, 0u, 0u}; else ur[i] = *(const u32x4*)(U + (row + i - 2) * D + ch); }
#pragma unroll
        for (int i = 0; i < 4; ++i) gv[i] = *(const u32x4*)(Gt + (row + i) * D + ch);
#pragma unroll
        for (int i = 0; i < 4; ++i) uz[i] = *(const u32x4*)(UZ + (r0 + s) * D + 128 * g + 32 * qd + 8 * i);
        if (g != g_staged) {
            __syncthreads();
            const bf16_t* wp = WTR + ((size_t)g * 128 + s) * 128 + 32 * qd;
#pragma unroll
            for (int i = 0; i < 4; ++i) *(LAS u32x4*)(WL + s * PT + 32 * qd + 8 * i) = *(const u32x4*)(wp + 8 * i);
            g_staged = g;
        }
        { float v[32]; float ss = 0.f;
#pragma unroll
          for (int i = 0; i < 4; ++i)
#pragma unroll
              for (int p = 0; p < 4; ++p) { v[8 * i + 2 * p] = bf_lo(vv[i][p]); v[8 * i + 2 * p + 1] = bf_hi(vv[i][p]); }
#pragma unroll
          for (int i = 0; i < 32; ++i) ss += v[i] * v[i];
          ss += __shfl_xor(ss, 1); ss += __shfl_xor(ss, 2);
          const float rs = __builtin_amdgcn_rsqf(ss * (1.0f / 128.0f) + EPS);
          const float* nw = sg_norm + g * 128 + 32 * qd;
#pragma unroll
          for (int i = 0; i < 32; i += 2) { const unsigned pk = cvt_pk_bf16(v[i] * rs * nw[i], v[i + 1] * rs * nw[i + 1]);
              VNT[(32 * qd + i) * PT + s] = (bf16_t)(pk & 0xffffu); VNT[(32 * qd + i + 1) * PT + s] = (bf16_t)(pk >> 16); }
        }
        { float cw[3][8];
#pragma unroll
          for (int k = 0; k < 3; ++k) { const f32x4 a = *(const f32x4*)(conv_w + k * D + ch), bq = *(const f32x4*)(conv_w + k * D + ch + 4);
              cw[k][0] = a.x; cw[k][1] = a.y; cw[k][2] = a.z; cw[k][3] = a.w; cw[k][4] = bq.x; cw[k][5] = bq.y; cw[k][6] = bq.z; cw[k][7] = bq.w; }
#pragma unroll
          for (int i = 0; i < 4; ++i) { float o[8];
#pragma unroll
              for (int p = 0; p < 4; ++p) { const unsigned u0 = ur[i][p], u1 = ur[i + 1][p], u2 = ur[i + 2][p];
                  o[2 * p] = bf_lo(gv[i][p]) * (cw[0][2 * p] * bf_lo(u0) + cw[1][2 * p] * bf_lo(u1) + cw[2][2 * p] * bf_lo(u2));
                  o[2 * p + 1] = bf_hi(gv[i][p]) * (cw[0][2 * p + 1] * bf_hi(u0) + cw[1][2 * p + 1] * bf_hi(u1) + cw[2][2 * p + 1] * bf_hi(u2)); }
              u32x4 wv; wv.x = cvt_pk_bf16(o[0], o[1]); wv.y = cvt_pk_bf16(o[2], o[3]); wv.z = cvt_pk_bf16(o[4], o[5]); wv.w = cvt_pk_bf16(o[6], o[7]);
              *(u32x4*)(Y + (row + i) * 2048 + ch) = wv; }
        }
        __syncthreads();
        f32x4 acc[8];
#pragma unroll
        for (int tt = 0; tt < 8; ++tt) acc[tt] = (f32x4){0.f, 0.f, 0.f, 0.f};
#pragma unroll
        for (int ks = 0; ks < 4; ++ks) { const bf16x8 a = *(const LAS bf16x8*)(VNT + (16 * w + fr) * PT + 32 * ks + 8 * fq);
#pragma unroll
            for (int tt = 2 * ks; tt < 8; ++tt) { const bf16x8 bw = *(const LAS bf16x8*)(WL + (16 * tt + fr) * PT + 32 * ks + 8 * fq);
                acc[tt] = __builtin_amdgcn_mfma_f32_16x16x32_bf16(a, bw, acc[tt], 0, 0, 0); } }
#pragma unroll
        for (int tt = 0; tt < 8; ++tt) { const int t = 16 * tt + fr; const float bb = sg_b[g * 128 + t];
            *(LAS f32x4*)(SG + t * 132 + 16 * w + 4 * fq) = acc[tt] + bb; }
        __syncthreads();
        { bf16_t* yp = Y + (r0 + s) * 2048 + 1024 + 128 * g + 32 * qd;
#pragma unroll
          for (int i = 0; i < 4; ++i) { const f32x4 s0 = *(const LAS f32x4*)(SG + s * 132 + 32 * qd + 8 * i), s1 = *(const LAS f32x4*)(SG + s * 132 + 32 * qd + 8 * i + 4);
              u32x4 wv; wv.x = cvt_pk_bf16(bf_lo(uz[i].x) * s0.x, bf_hi(uz[i].x) * s0.y); wv.y = cvt_pk_bf16(bf_lo(uz[i].y) * s0.z, bf_hi(uz[i].y) * s0.w);
              wv.z = cvt_pk_bf16(bf_lo(uz[i].z) * s1.x, bf_hi(uz[i].z) * s1.y); wv.w = cvt_pk_bf16(bf_lo(uz[i].w) * s1.z, bf_hi(uz[i].w) * s1.w);
              *(u32x4*)(yp + 8 * i) = wv; }
        }
    }
    __syncthreads();
}

__device__ __forceinline__ int crow(int i, int hi) { return (i & 3) + 8 * (i >> 2) + 4 * hi; }
__device__ __forceinline__ void attn_load_k(bf16x8 (&kf)[4], bool in_lds, LAS unsigned char* KL, int kl0, const bf16_t* kg, int ql, int hi) {
    if (in_lds) { const int r = kl0 + ql; LAS unsigned char* rp = KL + r * 128; const int sw = (r >> 1) & 7;
#pragma unroll
        for (int kk = 0; kk < 4; ++kk) kf[kk] = *(const LAS bf16x8*)(rp + (((2 * kk + hi) ^ sw) << 4));
    } else {
#pragma unroll
        for (int kk = 0; kk < 4; ++kk) kf[kk] = *(const bf16x8*)(kg + 16 * kk);
    }
}
__device__ __forceinline__ void attn_phase(LAS unsigned char* lds, const bf16_t* Q, const bf16_t* Kb, const bf16_t* VT, const bf16_t* Zs, bf16_t* OZ, int vcu, int G) {
    const int tid = threadIdx.x, lane = tid & 63, w = __builtin_amdgcn_readfirstlane(tid >> 6), ql = lane & 31, hi = lane >> 5;
    constexpr float STOP = 5.421010862427522e-20f;
    LAS unsigned char* KL = lds;
    LAS unsigned char* VL = lds + 49152;
    constexpr int NU = BATCH * 16 * (SEQ / 256);
    u32x4 sk[6], sv[6];
#define ATT_DECODE(u_, h_, rb_, q0b_, kw0_) const int h_ = ((u_) >> 5) & 15; const size_t rb_ = (size_t)((u_) >> 9) * SEQ; const int q0b_ = 256 * ((u_) & 31), kw0_ = q0b_ >= 128 ? q0b_ - 128 : 0;
#define ATT_LOAD_STAGE(u_) do { ATT_DECODE(u_, h__, rb__, q0b__, kw0__) \
        _Pragma("unroll") for (int i = 0; i < 6; ++i) { const int idx = tid + NTHR * i, r = idx >> 3, c = idx & 7; sk[i] = *(const u32x4*)(Kb + (rb__ + kw0__ + r) * D + h__ * 64 + 8 * c); } \
        _Pragma("unroll") for (int i = 0; i < 6; ++i) { const int idx = tid + NTHR * i, d = idx / 48, ch = idx % 48; sv[i] = *(const u32x4*)(VT + (size_t)(h__ * 64 + d) * M + rb__ + kw0__ + 8 * ch); } } while (0)
    if (vcu < NU) ATT_LOAD_STAGE(vcu);
    for (int unit = vcu; unit < NU; unit += G) {
        ATT_DECODE(unit, h, rowbase, q0b, kw0)
        const int qblk = unit & 31;
        const int qb = 8 * qblk + w, q0 = 32 * qb;
        bf16x8 qf[4];
        { const bf16_t* qp = Q + (rowbase + q0 + ql) * D + h * 64 + 8 * hi;
#pragma unroll
          for (int kk = 0; kk < 4; ++kk) qf[kk] = *(const bf16x8*)(qp + 16 * kk); }
        u32x2 zz[8];
        { const bf16_t* zp = Zs + (rowbase + q0 + ql) * D + h * 64 + 4 * hi;
#pragma unroll
          for (int g4 = 0; g4 < 4; ++g4) { zz[g4] = *(const u32x2*)(zp + 8 * g4); zz[4 + g4] = *(const u32x2*)(zp + 32 + 8 * g4); } }
        asm volatile("" ::: "memory");
#pragma unroll
        for (int i = 0; i < 6; ++i) { const int idx = tid + NTHR * i, r = idx >> 3, c = idx & 7;
            *(LAS u32x4*)(KL + r * 128 + ((c ^ ((r >> 1) & 7)) << 4)) = sk[i]; }
#pragma unroll
        for (int i = 0; i < 6; ++i) { const int idx = tid + NTHR * i, d = idx / 48, ch = idx % 48;
            { u32x4 v = sv[i]; const int gp = (2 * ch) ^ (d & 31);
                if (d & 1) { const u32x4 t = v; v.x = t.z; v.y = t.w; v.z = t.x; v.w = t.y; }
                *(LAS u32x4*)(VL + d * 768 + ((gp & ~1) << 3)) = v; } }
        __syncthreads();
        { const int nu_ = unit + G < NU ? unit + G : unit; ATT_LOAD_STAGE(nu_); }
        f32x16 o0, o1;
#pragma unroll
        for (int i = 0; i < 16; ++i) { o0[i] = 0.f; o1[i] = 0.f; }
        float carry = 1.f;
#define ATT_TILE(IN_LDS_) { const int key0 = 32 * kt; \
            u32x2 vf[2][2][2]; \
            if (IN_LDS_) { const int g0 = ((key0 - kw0) >> 2) + hi; \
_Pragma("unroll") \
                for (int dh = 0; dh < 2; ++dh) { LAS unsigned char* rp = VL + (32 * dh + ql) * 768; \
_Pragma("unroll") \
                    for (int s = 0; s < 2; ++s) { vf[dh][s][0] = *(const LAS u32x2*)(rp + (((g0 + 4 * s) ^ ql) << 3)); vf[dh][s][1] = *(const LAS u32x2*)(rp + (((g0 + 4 * s + 2) ^ ql) << 3)); } } \
            } else { const bf16_t* vp = VT + (size_t)(h * 64 + ql) * M + rowbase + key0 + 4 * hi; \
_Pragma("unroll") \
                for (int dh = 0; dh < 2; ++dh) \
_Pragma("unroll") \
                    for (int s = 0; s < 2; ++s) { vf[dh][s][0] = *(const u32x2*)(vp + (size_t)dh * 32 * M + 16 * s); vf[dh][s][1] = *(const u32x2*)(vp + (size_t)dh * 32 * M + 16 * s + 8); } } \
            bf16x8 kf[4]; \
            attn_load_k(kf, IN_LDS_, KL, key0 - kw0, Kb + (rowbase + key0 + ql) * D + h * 64 + 8 * hi, ql, hi); \
            f32x16 S; \
_Pragma("unroll") \
            for (int i = 0; i < 16; ++i) S[i] = 0.f; \
_Pragma("unroll") \
            for (int kk = 0; kk < 4; ++kk) S = __builtin_amdgcn_mfma_f32_32x32x16_bf16(kf[kk], qf[kk], S, 0, 0, 0); \
            float be[16], om[16]; \
            const bool diag = (kt == qb); \
_Pragma("unroll") \
            for (int i = 0; i < 16; ++i) { const float zc = __builtin_fmaxf(S[i], -126.0f); const float E = fast_exp2(-zc); float bv = fast_rcp(1.0f + E); float ov = E * bv; \
                if (diag) { const bool valid = crow(i, hi) < ql; bv = valid ? bv : 0.f; ov = valid ? ov : 1.f; } \
                be[i] = bv; om[i] = ov; } \
            float gs[4], pg[4]; \
_Pragma("unroll") \
            for (int gi = 0; gi < 4; ++gi) { gs[gi] = (om[4 * gi] * om[4 * gi + 1]) * (om[4 * gi + 2] * om[4 * gi + 3]); pg[gi] = __shfl_xor(gs[gi], 32); } \
            float run = carry; float wv[16]; \
_Pragma("unroll") \
            for (int gi = 3; gi >= 0; --gi) { const float base = hi == 0 ? run * pg[gi] : run; \
                const float s3 = base, s2 = s3 * om[4 * gi + 3], s1 = s2 * om[4 * gi + 2], s0 = s1 * om[4 * gi + 1]; \
                wv[4 * gi + 3] = be[4 * gi + 3] * s3; wv[4 * gi + 2] = be[4 * gi + 2] * s2; wv[4 * gi + 1] = be[4 * gi + 1] * s1; wv[4 * gi] = be[4 * gi] * s0; \
                run *= gs[gi] * pg[gi]; } \
            carry = run; \
_Pragma("unroll") \
            for (int s = 0; s < 2; ++s) { u32x4 pk; pk.x = cvt_pk_bf16(wv[8 * s], wv[8 * s + 1]); pk.y = cvt_pk_bf16(wv[8 * s + 2], wv[8 * s + 3]); pk.z = cvt_pk_bf16(wv[8 * s + 4], wv[8 * s + 5]); pk.w = cvt_pk_bf16(wv[8 * s + 6], wv[8 * s + 7]); \
                const bf16x8 pf = __builtin_bit_cast(bf16x8, pk); \
                { u32x4 a; a.x = vf[0][s][0].x; a.y = vf[0][s][0].y; a.z = vf[0][s][1].x; a.w = vf[0][s][1].y; o0 = __builtin_amdgcn_mfma_f32_32x32x16_bf16(__builtin_bit_cast(bf16x8, a), pf, o0, 0, 0, 0); } \
                { u32x4 a; a.x = vf[1][s][0].x; a.y = vf[1][s][0].y; a.z = vf[1][s][1].x; a.w = vf[1][s][1].y; o1 = __builtin_amdgcn_mfma_f32_32x32x16_bf16(__builtin_bit_cast(bf16x8, a), pf, o1, 0, 0, 0); } } }
        int kt = qb; bool done = false;
        for (; kt >= 0 && 32 * kt >= kw0; --kt) {
            ATT_TILE(true)
            if (__all(carry < STOP)) { done = true; break; }
        }
        if (!done) for (; kt >= 0; --kt) {
            ATT_TILE(false)
            if (__all(carry < STOP)) break;
        }
#undef ATT_TILE
        bf16_t* op = OZ + (rowbase + q0 + ql) * D + h * 64 + 4 * hi;
#pragma unroll
        for (int g4 = 0; g4 < 4; ++g4) {
            { const u32x2 z2 = zz[g4]; u32x2 wo; wo.x = cvt_pk_bf16(o0[4 * g4] * bf_lo(z2.x), o0[4 * g4 + 1] * bf_hi(z2.x)); wo.y = cvt_pk_bf16(o0[4 * g4 + 2] * bf_lo(z2.y), o0[4 * g4 + 3] * bf_hi(z2.y)); *(u32x2*)(op + 8 * g4) = wo; }
            { const u32x2 z2 = zz[4 + g4]; u32x2 wo; wo.x = cvt_pk_bf16(o1[4 * g4] * bf_lo(z2.x), o1[4 * g4 + 1] * bf_hi(z2.x)); wo.y = cvt_pk_bf16(o1[4 * g4 + 2] * bf_lo(z2.y), o1[4 * g4 + 3] * bf_hi(z2.y)); *(u32x2*)(op + 32 + 8 * g4) = wo; }
        }
        __syncthreads();
    }
#undef ATT_DECODE
#undef ATT_LOAD_STAGE
}

constexpr int N_PHASES = 9;
__global__ void __launch_bounds__(NTHR, 2) hybrid_fwd(Args a) {
    extern __shared__ __attribute__((aligned(16))) unsigned char lds_raw[];
    LAS unsigned char* lds = (LAS unsigned char*)lds_raw;
    const int tid = threadIdx.x, lane = tid & 63, wave = __builtin_amdgcn_readfirstlane(tid >> 6);
    const int G = gridDim.x, bx = blockIdx.x;
    const int vcu = (G % 8 == 0) ? (bx % 8) * (G / 8) + bx / 8 : bx;
    const int gw = vcu * NWAVES + wave, NGW = G * NWAVES;
    unsigned char* ws = a.ws;
    float* MOD = (float*)(ws + WS_MOD); float* SWp = (float*)(ws + WS_SW); float* SSQ = (float*)(ws + WS_SSQ);
    bf16_t* WAB = (bf16_t*)(ws + WS_WAB); bf16_t* WOAB = (bf16_t*)(ws + WS_WOAB); bf16_t* WC = (bf16_t*)(ws + WS_WC); bf16_t* WOC = (bf16_t*)(ws + WS_WOC);
    bf16_t* H0 = (bf16_t*)(ws + WS_H0); bf16_t* Y = (bf16_t*)(ws + WS_Y);
    bf16_t* Ub = (bf16_t*)(ws + WS_U); bf16_t* Gb = (bf16_t*)(ws + WS_G); bf16_t* UZb = (bf16_t*)(ws + WS_UZ); bf16_t* Vb = (bf16_t*)(ws + WS_V);
    bf16_t* X1 = (bf16_t*)(ws + WS_X1); bf16_t* H1 = (bf16_t*)(ws + WS_H1);
    bf16_t* Qb = (bf16_t*)(ws + WS_Q); bf16_t* Kb = (bf16_t*)(ws + WS_K); bf16_t* Zb = (bf16_t*)(ws + WS_Z); bf16_t* VTb = (bf16_t*)(ws + WS_VT); bf16_t* OZb = (bf16_t*)(ws + WS_OZ);
    const int lo = a.ph_lo, hi = a.ph_hi;
#define IN(k) (lo <= (k) && (k) < hi)
    volatile LAS unsigned* bst = (volatile LAS unsigned*)(lds + LDS_BYTES - 64);
    if (tid < 4) bst[tid] = 0u;
    __syncthreads();
    XcdBarrier xbar; xbar.bar = (unsigned*)(ws + WS_CTL); xbar.x = 0; xbar.st = bst;
    if (hi - lo > 1) xbar = xcd_barrier_post((unsigned*)(ws + WS_CTL), bst);
#define SEAM(k) do { if (IN(k) && IN((k) + 1)) xcd_barrier(xbar); } while (0)

    if (IN(0)) {
        for (int task = bx; task < 192; task += G) {
            LAS float* sc_l = (LAS float*)lds; LAS float* red = sc_l + 2048;
            for (int i = tid; i < BATCH * D; i += NTHR) { const float v = a.c[i]; sc_l[i] = v / (1.0f + __expf(-v)); }
            __syncthreads();
            const int l = task / 96, n0 = (task % 96) * 32, kc = wave * 2 + (lane >> 5), n = n0 + (lane & 31);
            const float* W = a.ada_w + (size_t)l * D * 3072 + (size_t)(kc * 64) * 3072 + n;
            float a0 = 0.f, a1 = 0.f;
#pragma unroll
            for (int k = 0; k < 64; ++k) { const float wv = W[(size_t)k * 3072]; a0 += sc_l[kc * 64 + k] * wv; a1 += sc_l[D + kc * 64 + k] * wv; }
            red[(kc * 2 + 0) * 32 + (lane & 31)] = a0; red[(kc * 2 + 1) * 32 + (lane & 31)] = a1;
            __syncthreads();
            if (tid < 64) { const int b = tid >> 5, nn = tid & 31; float s = 0.f;
#pragma unroll
                for (int k = 0; k < 16; ++k) s += red[(k * 2 + b) * 32 + nn];
                MOD[(l * 2 + b) * 3072 + n0 + nn] = s + a.ada_b[l * 3072 + n0 + nn]; }
            __syncthreads();
        }
        for (int i = gw * 64 + lane; i < 8 * 128 * 128 / 8; i += NGW * 64) {
            const int e0 = 8 * i, t = (e0 >> 7) & 127, s0 = e0 & 127; const f32x4 p = *(const f32x4*)(a.sg_w + e0), q = *(const f32x4*)(a.sg_w + e0 + 4);
            float e[8] = {p.x, p.y, p.z, p.w, q.x, q.y, q.z, q.w};
#pragma unroll
            for (int k = 0; k < 8; ++k) if (s0 + k > t) e[k] = 0.f;
            u32x4 wv; wv.x = cvt_pk_bf16(e[0], e[1]); wv.y = cvt_pk_bf16(e[2], e[3]); wv.z = cvt_pk_bf16(e[4], e[5]); wv.w = cvt_pk_bf16(e[6], e[7]);
            *(u32x4*)((bf16_t*)(ws + WS_WTR) + e0) = wv; }
        LAS float* scr = (LAS float*)(lds + wave * 16384);
        constexpr int I_AB = (D / 64) * (IN_AB / 32), I_OAB = (2048 / 64) * (D / 32), I_C = (D / 64) * (IN_C / 32), I_OC = (D / 64) * (D / 32);
        for (int it = gw; it < I_AB + I_OAB + I_C + I_OC; it += NGW) {
            int r = it;
            if (r < I_AB) { p0_transpose_item<1>(a.w_in_ab, D, IN_AB, WAB, scr, r, lane); continue; } r -= I_AB;
            if (r < I_OAB) { p0_transpose_item<0>(a.w_out_ab, 2048, D, WOAB, scr, r, lane); continue; } r -= I_OAB;
            if (r < I_C) { p0_transpose_item<2>(a.w_in_c, D, IN_C, WC, scr, r, lane); continue; } r -= I_C;
            p0_transpose_item<0>(a.w_out_c, D, D, WOC, scr, r, lane);
        }
    }
    SEAM(0);
    if (IN(1)) {
        rms_phase(a.x, a.ln_g, MOD, H0, gw, NGW, lane);
        { f32x4 s0[2][2], s1[2][2];
#pragma unroll
          for (int c = 0; c < 2; ++c)
#pragma unroll
              for (int q = 0; q < 2; ++q) { s0[c][q] = *(const f32x4*)(MOD + 2 * 3072 + 512 * c + 8 * lane + 4 * q); s1[c][q] = *(const f32x4*)(MOD + 3 * 3072 + 512 * c + 8 * lane + 4 * q); }
          for (int n = gw; n < IN_C; n += NGW) {
              const bf16_t* wr_ = WC + (size_t)c_row(n) * D + 8 * lane; float a0 = 0.f, a1 = 0.f;
#pragma unroll
              for (int c = 0; c < 2; ++c) { const u32x4 t = *(const u32x4*)(wr_ + 512 * c);
                  const f32x4 w0 = (f32x4){bf_lo(t.x), bf_hi(t.x), bf_lo(t.y), bf_hi(t.y)}, w1 = (f32x4){bf_lo(t.z), bf_hi(t.z), bf_lo(t.w), bf_hi(t.w)};
                  const f32x4 p0 = w0 * s0[c][0] + w1 * s0[c][1], p1 = w0 * s1[c][0] + w1 * s1[c][1];
                  a0 += (p0[0] + p0[1]) + (p0[2] + p0[3]); a1 += (p1[0] + p1[1]) + (p1[2] + p1[3]); }
              a0 = wave_sum(a0); a1 = wave_sum(a1);
              if (lane == 0) { SWp[n] = a0; SWp[4096 + n] = a1; } } }
    }
    SEAM(1);
    if (IN(2)) { pg8::Sched2 S; S.init(H0, WAB, M, IN_AB, nullptr, nullptr, 0, 0, D, G, bx);
        pg8::EpiP1 E{Ub}; pg8::gemm_phase<pg8::EpiP1, true, true>(lds, S, E); }
    SEAM(2);
    if (IN(3)) mixer_phase(lds, Ub, Gb, UZb, Vb, a.conv_w, a.sg_norm, (const bf16_t*)(ws + WS_WTR), a.sg_b, Y, vcu, G);
    SEAM(3);
    if (IN(4)) { pg8::Sched2 S; S.init(Y, WOAB, M, D, nullptr, nullptr, 0, 0, 2048, G, bx);
        pg8::EpiRes<true> E{a.x, X1, MOD + 2048, a.ln_g + D, MOD + 2 * 3072 + 1024, H1, SSQ}; pg8::gemm_phase<pg8::EpiRes<true>, true, true>(lds, S, E); }
    if (IN(4) && IN(6)) xcd_barrier(xbar);
    if (IN(6)) { pg8::Sched2 S; S.init(H1, WC, M, 3072, WC + (size_t)3072 * D, H1, D, M, D, G, bx);
        pg8::EpiP5 E{Qb, VTb, a.q_norm, a.k_norm, SSQ, SWp}; pg8::gemm_phase<pg8::EpiP5, true, true>(lds, S, E); }
    SEAM(6);
    if (IN(7)) attn_phase(lds, Qb, Kb, VTb, Zb, OZb, vcu, G);
    SEAM(7);
    if (IN(8)) { pg8::Sched2 S; S.init(OZb, WOC, M, D, nullptr, nullptr, 0, 0, D, G, bx);
        pg8::EpiRes<false> E{X1, a.out, MOD + 2 * 3072 + 2048, nullptr, nullptr, nullptr, nullptr}; pg8::gemm_phase<pg8::EpiRes<false>, true, true>(lds, S, E); }
#undef IN
#undef SEAM
}

extern "C" void kernel_launch(void* const* d_in, const int* in_sizes, int n_in, void* d_out, int out_size, void* d_ws, size_t ws_size, hipStream_t stream) {
    static int grid = 0;
    if (grid == 0) {
        if (n_in != 15 || in_sizes[0] != M * D || out_size != M * D || ws_size < WS_END) { fprintf(stderr, "kernel_launch: unexpected problem geometry (n_in %d, ws %zu)\n", n_in, ws_size); grid = -1; return; }
        int dev = 0, cus = 0, per_cu = 0;
        (void)hipGetDevice(&dev); (void)hipDeviceGetAttribute(&cus, hipDeviceAttributeMultiprocessorCount, dev);
        if (hipFuncSetAttribute((const void*)hybrid_fwd, hipFuncAttributeMaxDynamicSharedMemorySize, LDS_BYTES) != hipSuccess) { fprintf(stderr, "kernel_launch: hipFuncSetAttribute failed\n"); grid = -1; return; }
        if (hipOccupancyMaxActiveBlocksPerMultiprocessor(&per_cu, (const void*)hybrid_fwd, NTHR, LDS_BYTES) != hipSuccess || per_cu < 1) { fprintf(stderr, "kernel_launch: occupancy query says %d\n", per_cu); per_cu = 1; }
        (void)hipGetLastError();
        grid = cus * per_cu;
    }
    if (grid < 0) return;
    Args a{};
    a.x = (const float*)d_in[0]; a.c = (const float*)d_in[1]; a.ln_g = (const float*)d_in[2]; a.ada_w = (const float*)d_in[3]; a.ada_b = (const float*)d_in[4];
    a.w_in_ab = (const float*)d_in[5]; a.conv_w = (const float*)d_in[6]; a.sg_norm = (const float*)d_in[7]; a.sg_w = (const float*)d_in[8]; a.sg_b = (const float*)d_in[9];
    a.w_out_ab = (const float*)d_in[10]; a.w_in_c = (const float*)d_in[11]; a.q_norm = (const float*)d_in[12]; a.k_norm = (const float*)d_in[13]; a.w_out_c = (const float*)d_in[14];
    a.out = (float*)d_out; a.ws = (unsigned char*)d_ws;
#if MK_MULTI
    for (int p = 0; p < N_PHASES; ++p) { a.ph_lo = p; a.ph_hi = p + 1; hipLaunchKernelGGL(hybrid_fwd, dim3(grid), dim3(NTHR), LDS_BYTES, stream, a); }
#else
    a.ph_lo = 0; a.ph_hi = N_PHASES;
    (void)hipMemsetAsync((char*)d_ws + WS_CTL, 0, CTL_ZERO_BYTES, stream);
    void* args[] = {&a};
    hipError_t e = hipLaunchCooperativeKernel((const void*)hybrid_fwd, dim3(grid), dim3(NTHR), args, LDS_BYTES, stream);
    if (e != hipSuccess) fprintf(stderr, "kernel_launch: cooperative launch failed: %s (grid %d)\n", hipGetErrorString(e), grid);
#endif
}
```

```cpp
#include <hip/hip_runtime.h>
#include <hip/hip_cooperative_groups.h>
#include <cstdio>
#include <cstdint>
namespace cg = cooperative_groups;

#ifndef MK_MULTI
#define MK_MULTI 0
#endif

#define LAS __attribute__((address_space(3)))
typedef unsigned short bf16_t;
typedef short bf16x8 __attribute__((ext_vector_type(8)));
typedef float f32x4 __attribute__((ext_vector_type(4)));
typedef float f32x16 __attribute__((ext_vector_type(16)));
typedef unsigned u32x4 __attribute__((ext_vector_type(4)));
typedef unsigned u32x2 __attribute__((ext_vector_type(2)));

constexpr int BATCH = 2, SEQ = 8192, D = 1024, M = BATCH * SEQ;
constexpr int IN_AB = 7168, IN_C = 4096;
constexpr float EPS = 1e-6f;
constexpr int NWAVES = 8, NTHR = 512;
constexpr float LOG2E = 1.4426950408889634f;

constexpr size_t MiB = 1u << 20;
constexpr size_t WS_CTL = 0, CTL_ZERO_BYTES = 64 * 1024;
constexpr size_t WS_MOD = 1 * MiB;
constexpr size_t WS_WAB = 2 * MiB;
constexpr size_t WS_WOAB = 16 * MiB;
constexpr size_t WS_WC = 20 * MiB;
constexpr size_t WS_WOC = 28 * MiB;
constexpr size_t WS_SSQ = 31 * MiB;
constexpr size_t WS_SW = 1 * MiB + 65536;
constexpr size_t WS_WTR = 30 * MiB;
constexpr size_t WS_U = 32 * MiB, WS_G = 64 * MiB, WS_UZ = 96 * MiB, WS_V = 128 * MiB;
constexpr size_t WS_H0 = 160 * MiB;
constexpr size_t WS_Y = 160 * MiB;
constexpr size_t WS_X1 = 32 * MiB;
constexpr size_t WS_H1 = 96 * MiB;
constexpr size_t WS_Q = 128 * MiB, WS_K = 160 * MiB, WS_Z = 192 * MiB, WS_VT = 224 * MiB;
constexpr size_t WS_OZ = 96 * MiB;
constexpr size_t WS_END = 256 * MiB;
static_assert(WS_G - WS_U == (size_t)M * D * 2 && WS_UZ - WS_G == (size_t)M * D * 2 && WS_V - WS_UZ == (size_t)M * D * 2 && WS_K - WS_Q == (size_t)M * D * 2 && WS_Z - WS_K == (size_t)M * D * 2, "contiguous activations");

constexpr int LDS_BYTES = 147456;

typedef float f32x2_t __attribute__((ext_vector_type(2))); typedef __bf16 bf16x2_t __attribute__((ext_vector_type(2)));
__device__ __forceinline__ unsigned cvt_pk_bf16(float lo, float hi) { f32x2_t v = {lo, hi}; bf16x2_t b = __builtin_convertvector(v, bf16x2_t); return __builtin_bit_cast(unsigned, b); }
__device__ __forceinline__ float bf_lo(unsigned u) { return __uint_as_float(u << 16); }
__device__ __forceinline__ float bf_hi(unsigned u) { return __uint_as_float(u & 0xffff0000u); }
__device__ __forceinline__ float fast_exp2(float x) { return __builtin_amdgcn_exp2f(x); }
__device__ __forceinline__ float fast_log2(float x) { return __builtin_amdgcn_logf(x); }
__device__ __forceinline__ float fast_rcp(float x) { return __builtin_amdgcn_rcpf(x); }
__device__ __forceinline__ float silu_f(float v) { return v * fast_rcp(1.0f + fast_exp2(-LOG2E * v)); }

namespace pg8 {
constexpr int BM = 256, BK = 64, HALF = 128, HTB = HALF * BK * 2, STAGE_BYTES = 8 * HTB, NXCD = 8, WGM = 4;
__host__ __device__ __forceinline__ int lds_byte(int r, int c) { const int st = (r >> 4) * 2 + (c >> 5), rr = r & 15, cc = c & 31, ob = rr * 64 + cc * 2; return st * 1024 + (ob ^ (((ob >> 9) & 1) << 5)); }
__host__ __device__ __forceinline__ void stage_rc(int b, int& R, int& C) { const int st = b / 1024, sb = b % 1024, swz = sb ^ (((sb >> 9) & 1) << 5); R = (st >> 1) * 16 + swz / 64; C = (st & 1) * 32 + (swz % 64) / 2; }
__host__ __device__ __forceinline__ int perm32(int rho) { const int n = rho >> 4, i = rho & 15; return 8 * (i >> 2) + 4 * n + (i & 3); }

struct Unit { int pm, pn, sel; };
struct Sched2 {
    const bf16_t *A0, *B0, *A1, *B1; int nM0, nN0, nwg0, nM1, nN1, nwg1, G, c, K;
    __device__ void init(const bf16_t* a0, const bf16_t* b0, int m0, int n0, const bf16_t* a1, const bf16_t* b1, int m1, int n1, int K_, int G_, int c_) {
        A0 = a0; B0 = b0; nM0 = m0 / BM; nN0 = n0 / BM; nwg0 = nM0 * nN0; A1 = a1; B1 = b1; nM1 = m1 / BM; nN1 = n1 / BM; nwg1 = nM1 * nN1; K = K_; G = G_; c = c_; }
    __device__ static void map(int wgid, int nM, int nN, int& pm, int& pn) {
        const int nwg = nM * nN; { const int q = nwg / NXCD, r = nwg % NXCD, xcd = wgid % NXCD, off = wgid / NXCD; wgid = (xcd < r ? xcd * (q + 1) : r * (q + 1) + (xcd - r) * q) + off; }
        const int nig = WGM * nN, gid = wgid / nig, fm = gid * WGM, gsz = (nM - fm) < WGM ? (nM - fm) : WGM;
        pm = fm + ((wgid % nig) % gsz); pn = (wgid % nig) / gsz; }
    __device__ bool next(int i, Unit& u) const {
        const int L = i * G + c;
        if (L < nwg0) { map(L, nM0, nN0, u.pm, u.pn); u.sel = 0; return true; }
        if (L < nwg0 + nwg1) { map(L - nwg0, nM1, nN1, u.pm, u.pn); u.sel = 1; return true; }
        return false; }
    __device__ __forceinline__ const char* baseA(const Unit& u) const { return (const char*)(u.sel ? A1 : A0) + (size_t)u.pm * BM * K * 2; }
    __device__ __forceinline__ const char* baseB(const Unit& u) const { return (const char*)(u.sel ? B1 : B0) + (size_t)u.pn * BM * K * 2; }
};

template <class Epi, bool ALIGN_EPI, bool SP2>
__device__ __forceinline__ void gemm_phase(LAS unsigned char* lds, const Sched2& S, const Epi& E) {
    const int tid = threadIdx.x, wid = __builtin_amdgcn_readfirstlane(tid >> 6), lane = tid & 63, wr = wid >> 2, wc = wid & 3, fr = lane & 15, fq = lane >> 4;
    const int K = S.K, nt = K / BK;
    unsigned voffA[2], voffB[2];
#pragma unroll
    for (int i = 0; i < 2; ++i) { int R, C; stage_rc(tid * 16 + i * 8192, R, C); const int Rb = Epi::PERM ? ((R & ~31) + perm32(R & 31)) : R;
        voffA[i] = (unsigned)(R * K + C) * 2u; voffB[i] = (unsigned)(Rb * K + C) * 2u; }
    const size_t kstep = (size_t)(BK * 2);
    const size_t hstep = (size_t)HALF * K * 2;
    const unsigned ldsw = (unsigned)wid * 1024u;
    const int aoff = lds_byte(wr * 64 + fr, fq * 8), boff = lds_byte(wc * 32 + fr, fq * 8);
#define PG8_SA(b, h) (((b) * 2 + (h)) * HTB)
#define PG8_SB(b, h) ((4 + (b) * 2 + (h)) * HTB)
#define PG8_STAGE(bufoff, gbase, voff) do { _Pragma("unroll") for (int _i = 0; _i < 2; ++_i) \
        __builtin_amdgcn_global_load_lds((const unsigned*)((const char*)(gbase) + (voff)[_i]), (LAS unsigned*)(lds + (bufoff) + ldsw + _i * 8192), 16, 0, 0); } while (0)
#define PG8_LDA(dst, b, h) do { _Pragma("unroll") for (int m = 0; m < 4; ++m) _Pragma("unroll") for (int k = 0; k < 2; ++k) dst[m][k] = *(const LAS bf16x8*)(lds + PG8_SA(b, h) + aoff + m * 2048 + k * 1024); } while (0)
#define PG8_LDB(dst, b, h) do { _Pragma("unroll") for (int n = 0; n < 2; ++n) _Pragma("unroll") for (int k = 0; k < 2; ++k) dst[n][k] = *(const LAS bf16x8*)(lds + PG8_SB(b, h) + boff + n * 2048 + k * 1024); } while (0)
#define PG8_MMA(ai, bj, At, Bt) do { __builtin_amdgcn_s_setprio(1); _Pragma("unroll") for (int m = 0; m < 4; ++m) _Pragma("unroll") for (int n = 0; n < 2; ++n) _Pragma("unroll") for (int k = 0; k < 2; ++k) \
        acc[ai][bj][m][n] = __builtin_amdgcn_mfma_f32_16x16x32_bf16(Bt[n][k], At[m][k], acc[ai][bj][m][n], 0, 0, 0); __builtin_amdgcn_s_setprio(0); } while (0)
#define PG8_WAIT_V(n) asm volatile("s_waitcnt vmcnt(" #n ")" ::: "memory")
#define PG8_WAIT_L(n) asm volatile("s_waitcnt lgkmcnt(" #n ")" ::: "memory")
#define PG8_BAR __builtin_amdgcn_s_barrier()
#define PG8_SCHED __builtin_amdgcn_sched_barrier(0)
    Unit cur, nxt; int ui = 0;
    if (!S.next(0, cur)) return;
    f32x4 acc[2][2][4][2];
#pragma unroll
    for (int a = 0; a < 2; ++a)
#pragma unroll
        for (int b = 0; b < 2; ++b)
#pragma unroll
            for (int m = 0; m < 4; ++m)
#pragma unroll
                for (int n = 0; n < 2; ++n) acc[a][b][m][n] = (f32x4){0.f, 0.f, 0.f, 0.f};
    bf16x8 At[4][2], B0[2][2], B1[2][2];
    const char* cA = S.baseA(cur); const char* cB = S.baseB(cur);
    if constexpr (SP2) {
        PG8_STAGE(PG8_SB(0, 0), cB, voffB); PG8_STAGE(PG8_SB(0, 1), cB + hstep, voffB); PG8_STAGE(PG8_SA(0, 0), cA, voffA); PG8_STAGE(PG8_SA(0, 1), cA + hstep, voffA);
        if (wr == 1) PG8_BAR;
        PG8_WAIT_V(2); PG8_BAR;
        PG8_STAGE(PG8_SB(1, 0), cB + kstep, voffB); PG8_STAGE(PG8_SA(1, 0), cA + kstep, voffA); PG8_STAGE(PG8_SB(1, 1), cB + hstep + kstep, voffB);
        PG8_WAIT_V(6); PG8_BAR;
    } else {
        PG8_STAGE(PG8_SB(0, 0), cB, voffB); PG8_STAGE(PG8_SA(0, 0), cA, voffA); PG8_STAGE(PG8_SB(0, 1), cB + hstep, voffB); PG8_STAGE(PG8_SA(0, 1), cA + hstep, voffA);
        if (wr == 1) PG8_BAR;
        PG8_WAIT_V(4); PG8_BAR;
        PG8_STAGE(PG8_SB(1, 0), cB + kstep, voffB); PG8_STAGE(PG8_SA(1, 0), cA + kstep, voffA); PG8_STAGE(PG8_SB(1, 1), cB + hstep + kstep, voffB);
        PG8_WAIT_V(6); PG8_BAR;
    }
    for (;;) {
        const bool has_next = S.next(ui + 1, nxt);
        const char* nA = has_next ? S.baseA(nxt) : cA; const char* nB = has_next ? S.baseB(nxt) : cB;
        for (int t = 0; t < nt; t += 2) {
            const bool last = (t == nt - 2);
            const char* a1 = cA + (size_t)(t + 1) * kstep;
            const char* a2 = last ? nA : cA + (size_t)(t + 2) * kstep; const char* b2 = last ? nB : cB + (size_t)(t + 2) * kstep;
            const char* a3 = a2 + kstep; const char* b3 = b2 + kstep;
            if constexpr (SP2) {
            PG8_LDB(B0, 0, 0); PG8_LDB(B1, 0, 1); PG8_SCHED; PG8_LDA(At, 0, 0); PG8_STAGE(PG8_SA(1, 1), a1 + hstep, voffA);
            PG8_WAIT_V(8); PG8_WAIT_L(0); PG8_BAR; PG8_MMA(0, 0, At, B0); PG8_MMA(0, 1, At, B1); PG8_BAR; PG8_SCHED;
            PG8_LDA(At, 0, 1); PG8_STAGE(PG8_SB(0, 0), b2, voffB); PG8_STAGE(PG8_SB(0, 1), b2 + hstep, voffB); PG8_STAGE(PG8_SA(0, 0), a2, voffA);
            PG8_WAIT_V(8); PG8_WAIT_L(0); PG8_BAR; PG8_MMA(1, 0, At, B0); PG8_MMA(1, 1, At, B1); PG8_BAR; PG8_SCHED;
            PG8_LDB(B0, 1, 0); PG8_LDB(B1, 1, 1); PG8_SCHED; PG8_LDA(At, 1, 0); PG8_STAGE(PG8_SA(0, 1), a2 + hstep, voffA);
            PG8_WAIT_V(8); PG8_WAIT_L(0); PG8_BAR; PG8_MMA(0, 0, At, B0); PG8_MMA(0, 1, At, B1); PG8_BAR; PG8_SCHED;
            PG8_LDA(At, 1, 1); PG8_STAGE(PG8_SB(1, 0), b3, voffB); PG8_STAGE(PG8_SB(1, 1), b3 + hstep, voffB); PG8_STAGE(PG8_SA(1, 0), a3, voffA);
            PG8_WAIT_V(8); PG8_WAIT_L(0); PG8_BAR; PG8_MMA(1, 0, At, B0); PG8_MMA(1, 1, At, B1); PG8_BAR; PG8_SCHED;
            } else {
            PG8_LDB(B0, 0, 0); PG8_SCHED; PG8_LDA(At, 0, 0); PG8_STAGE(PG8_SA(1, 1), a1 + hstep, voffA);
            PG8_WAIT_L(8); PG8_BAR; PG8_WAIT_L(0); PG8_MMA(0, 0, At, B0); PG8_BAR; PG8_SCHED;
            PG8_LDB(B1, 0, 1); PG8_STAGE(PG8_SB(0, 0), b2, voffB);
            PG8_BAR; PG8_WAIT_L(0); PG8_MMA(0, 1, At, B1); PG8_BAR;
            PG8_LDA(At, 0, 1); PG8_STAGE(PG8_SA(0, 0), a2, voffA);
            PG8_BAR; PG8_WAIT_L(0); PG8_MMA(1, 0, At, B0); PG8_BAR; PG8_SCHED;
            PG8_STAGE(PG8_SB(0, 1), b2 + hstep, voffB);
            PG8_WAIT_V(6); PG8_BAR; PG8_MMA(1, 1, At, B1); PG8_BAR;
            PG8_LDB(B0, 1, 0); PG8_SCHED; PG8_LDA(At, 1, 0); PG8_STAGE(PG8_SA(0, 1), a2 + hstep, voffA);
            PG8_WAIT_L(8); PG8_BAR; PG8_WAIT_L(0); PG8_MMA(0, 0, At, B0); PG8_BAR; PG8_SCHED;
            PG8_LDB(B1, 1, 1); PG8_STAGE(PG8_SB(1, 0), b3, voffB);
            PG8_BAR; PG8_WAIT_L(0); PG8_MMA(0, 1, At, B1); PG8_BAR;
            PG8_LDA(At, 1, 1); PG8_STAGE(PG8_SA(1, 0), a3, voffA);
            PG8_BAR; PG8_WAIT_L(0); PG8_MMA(1, 0, At, B0); PG8_BAR; PG8_SCHED;
            PG8_STAGE(PG8_SB(1, 1), b3 + hstep, voffB);
            PG8_WAIT_V(6); PG8_BAR; PG8_MMA(1, 1, At, B1); PG8_BAR;
            }
        }
        if constexpr (ALIGN_EPI) { if (wr == 0) PG8_BAR; }
        E(acc, cur, wr, wc, fr, fq);
        if (!has_next) break;
#pragma unroll
        for (int a = 0; a < 2; ++a)
#pragma unroll
            for (int b = 0; b < 2; ++b)
#pragma unroll
                for (int m = 0; m < 4; ++m)
#pragma unroll
                    for (int n = 0; n < 2; ++n) acc[a][b][m][n] = (f32x4){0.f, 0.f, 0.f, 0.f};
        cur = nxt; cA = nA; cB = nB; ++ui;
        if constexpr (ALIGN_EPI) { if (wr == 1) PG8_BAR; }
    }
    PG8_WAIT_V(0);
    if constexpr (!ALIGN_EPI) { if (wr == 0) PG8_BAR; }
    PG8_BAR;
#undef PG8_SA
#undef PG8_SB
#undef PG8_STAGE
#undef PG8_LDA
#undef PG8_LDB
#undef PG8_MMA
#undef PG8_WAIT_V
#undef PG8_WAIT_L
#undef PG8_BAR
#undef PG8_SCHED
}

struct EpiP1 {
    static constexpr bool PERM = true;
    bf16_t* U;
    __device__ __forceinline__ void operator()(const f32x4 (&acc)[2][2][4][2], const Unit& u, int wr, int wc, int fr, int fq) const {
        const int row0 = u.pm * BM + wr * 64 + fr;
        bf16_t* O = U + (size_t)(u.pn >> 3) * ((size_t)M * D);
        if (u.pn < 24) {
            const bool act = u.pn >= 8;
            const int col0 = (u.pn & 7) * 128 + wc * 32 + 8 * fq;
#pragma unroll
            for (int ai = 0; ai < 2; ++ai)
#pragma unroll
                for (int m = 0; m < 4; ++m) { bf16_t* rowp = O + (size_t)(row0 + ai * HALF + m * 16) * D + col0;
                    f32x4 a0 = acc[ai][0][m][0], a1 = acc[ai][0][m][1], b0 = acc[ai][1][m][0], b1 = acc[ai][1][m][1];
                    if (act) {
#pragma unroll
                        for (int j = 0; j < 4; ++j) { b0[j] = silu_f(b0[j]); b1[j] = silu_f(b1[j]); } }
                    a0 = a0 * b0; a1 = a1 * b1;
                    u32x4 w; w.x = cvt_pk_bf16(a0[0], a0[1]); w.y = cvt_pk_bf16(a0[2], a0[3]); w.z = cvt_pk_bf16(a1[0], a1[1]); w.w = cvt_pk_bf16(a1[2], a1[3]);
                    *(u32x4*)rowp = w; }
        } else {
            const int col0 = (u.pn - 24) * 256 + wc * 32 + 8 * fq;
#pragma unroll
            for (int ai = 0; ai < 2; ++ai)
#pragma unroll
                for (int m = 0; m < 4; ++m) { bf16_t* rowp = O + (size_t)(row0 + ai * HALF + m * 16) * D + col0;
#pragma unroll
                    for (int bj = 0; bj < 2; ++bj) { const f32x4 v0 = acc[ai][bj][m][0], v1 = acc[ai][bj][m][1];
                        u32x4 w; w.x = cvt_pk_bf16(v0[0], v0[1]); w.y = cvt_pk_bf16(v0[2], v0[3]); w.z = cvt_pk_bf16(v1[0], v1[1]); w.w = cvt_pk_bf16(v1[2], v1[3]);
                        *(u32x4*)(rowp + bj * HALF) = w; } }
        }
    }
};
struct EpiP5 {
    static constexpr bool PERM = true;
    bf16_t *Q, *VT; const float *qn, *kn;
    const float* ssq; const float* sw;
    __device__ __forceinline__ float rstd_of(int token, int part  ) const { const f32x4 p = *(const f32x4*)(ssq + (size_t)token * 16 + 4 * part); return (p[0] + p[1]) + (p[2] + p[3]); }
    __device__ __forceinline__ void operator()(const f32x4 (&acc)[2][2][4][2], const Unit& u, int wr, int wc, int fr, int fq) const {
        const int row0 = u.pm * BM + wr * 64 + fr;
        if (u.sel == 1) {
            const int col0 = u.pn * BM + wc * 32 + 8 * fq, bt = (u.pn * BM) / SEQ;
            float mine; { const int k = fr, tok = col0 + (k >> 3) * HALF + ((k >> 2) & 1) * 4 + (k & 3);
                const float t = (rstd_of(tok, 0) + rstd_of(tok, 1)) + (rstd_of(tok, 2) + rstd_of(tok, 3)); mine = __builtin_amdgcn_rsqf(t * (1.0f / D) + EPS); }
            f32x4 rs[2][2];
#pragma unroll
            for (int k = 0; k < 16; ++k) rs[k >> 3][(k >> 2) & 1][k & 3] = __shfl(mine, (fq << 4) | k);
#pragma unroll
            for (int ai = 0; ai < 2; ++ai)
#pragma unroll
                for (int m = 0; m < 4; ++m) { const int hd = row0 + ai * HALF + m * 16; const float swv = sw[bt * 4096 + 2048 + hd]; bf16_t* rowp = VT + (size_t)hd * M + col0;
#pragma unroll
                    for (int bj = 0; bj < 2; ++bj) { const f32x4 v0 = acc[ai][bj][m][0] * rs[bj][0] + swv, v1 = acc[ai][bj][m][1] * rs[bj][1] + swv;
                        u32x4 w; w.x = cvt_pk_bf16(v0[0], v0[1]); w.y = cvt_pk_bf16(v0[2], v0[3]); w.z = cvt_pk_bf16(v1[0], v1[1]); w.w = cvt_pk_bf16(v1[2], v1[3]);
                        *(u32x4*)(rowp + bj * HALF) = w; } }
            return;
        }
        const int bt = (u.pm * BM) / SEQ;
        float rs[2][4];
#pragma unroll
        for (int ai = 0; ai < 2; ++ai)
#pragma unroll
            for (int m = 0; m < 4; ++m) { float t = rstd_of(row0 + ai * HALF + m * 16, fq); t += __shfl_xor(t, 16); t += __shfl_xor(t, 32); rs[ai][m] = __builtin_amdgcn_rsqf(t * (1.0f / D) + EPS); }
        if (u.pn >= 8) {
            const int col0 = (u.pn - 8) * BM + wc * 32 + 8 * fq;
            f32x4 s4[2][2];
#pragma unroll
            for (int bj = 0; bj < 2; ++bj)
#pragma unroll
                for (int n = 0; n < 2; ++n) s4[bj][n] = *(const f32x4*)(sw + bt * 4096 + 3072 + col0 + bj * HALF + 4 * n);
#pragma unroll
            for (int ai = 0; ai < 2; ++ai)
#pragma unroll
                for (int m = 0; m < 4; ++m) { bf16_t* rowp = Q + 2 * (size_t)M * D + (size_t)(row0 + ai * HALF + m * 16) * D + col0;
#pragma unroll
                    for (int bj = 0; bj < 2; ++bj) { f32x4 v0 = acc[ai][bj][m][0] * rs[ai][m] + s4[bj][0], v1 = acc[ai][bj][m][1] * rs[ai][m] + s4[bj][1];
#pragma unroll
                        for (int j = 0; j < 4; ++j) { v0[j] = silu_f(v0[j]); v1[j] = silu_f(v1[j]); }
                        u32x4 w; w.x = cvt_pk_bf16(v0[0], v0[1]); w.y = cvt_pk_bf16(v0[2], v0[3]); w.z = cvt_pk_bf16(v1[0], v1[1]); w.w = cvt_pk_bf16(v1[2], v1[3]);
                        *(u32x4*)(rowp + bj * HALF) = w; } }
        } else {
            const bool isq = u.pn < 4; bf16_t* O = Q + (size_t)(u.pn >> 2) * ((size_t)M * D); const float* nw = qn; if (!isq) nw = kn; const float sc = isq ? (LOG2E * 0.125f) : 1.0f;
            const int col0 = (u.pn & 3) * BM + 64 * wc + 8 * fq;
            f32x4 w4[2][2], s4[2][2];
#pragma unroll
            for (int bj = 0; bj < 2; ++bj)
#pragma unroll
                for (int n = 0; n < 2; ++n) { w4[bj][n] = *(const f32x4*)(nw + 32 * bj + 8 * fq + 4 * n); s4[bj][n] = *(const f32x4*)(sw + bt * 4096 + (u.pn >> 2) * 1024 + col0 + 32 * bj + 4 * n); }
#pragma unroll
            for (int ai = 0; ai < 2; ++ai)
#pragma unroll
                for (int m = 0; m < 4; ++m) {
                    f32x4 v[2][2]; float ss = 0.f;
#pragma unroll
                    for (int bj = 0; bj < 2; ++bj)
#pragma unroll
                        for (int n = 0; n < 2; ++n) { v[bj][n] = acc[ai][bj][m][n] * rs[ai][m] + s4[bj][n]; const f32x4 t = v[bj][n]; ss += (t[0] * t[0] + t[1] * t[1]) + (t[2] * t[2] + t[3] * t[3]); }
                    ss += __shfl_xor(ss, 16); ss += __shfl_xor(ss, 32);
                    const float rq = __builtin_amdgcn_rsqf(ss * (1.0f / 64.0f) + EPS) * sc;
                    bf16_t* rowp = O + (size_t)(row0 + ai * HALF + m * 16) * D + col0;
#pragma unroll
                    for (int bj = 0; bj < 2; ++bj) { const f32x4 v0 = v[bj][0] * rq * w4[bj][0], v1 = v[bj][1] * rq * w4[bj][1];
                        u32x4 w; w.x = cvt_pk_bf16(v0[0], v0[1]); w.y = cvt_pk_bf16(v0[2], v0[3]); w.z = cvt_pk_bf16(v1[0], v1[1]); w.w = cvt_pk_bf16(v1[2], v1[3]);
                        *(u32x4*)(rowp + 32 * bj) = w; } }
        }
    }
};
template <bool STATS> struct EpiRes {
    static constexpr bool PERM = true;
    const void* base; void* out; const float* gate; const float* lng; const float* scale; bf16_t* xm; float* ssq;
    __device__ __forceinline__ void operator()(const f32x4 (&acc)[2][2][4][2], const Unit& u, int wr, int wc, int fr, int fq) const {
        const int row0 = u.pm * BM + wr * 64 + fr, col0 = u.pn * BM + wc * 32 + 8 * fq, bt = (u.pm * BM) / SEQ;
        f32x4 gv[2][2], mv[2][2];
#pragma unroll
        for (int bj = 0; bj < 2; ++bj)
#pragma unroll
            for (int n = 0; n < 2; ++n) { gv[bj][n] = *(const f32x4*)(gate + bt * 3072 + col0 + bj * HALF + 4 * n);
                if (STATS) mv[bj][n] = *(const f32x4*)(lng + col0 + bj * HALF + 4 * n) * (*(const f32x4*)(scale + bt * 3072 + col0 + bj * HALF + 4 * n) + 1.0f); }
        constexpr int MB = STATS ? 2 : 4;
#pragma unroll
        for (int ai = 0; ai < 2; ++ai)
#pragma unroll
        for (int mb = 0; mb < 4; mb += MB) {
            f32x4 bf[MB][2][2]; u32x4 bh[MB][2];
#pragma unroll
            for (int mm = 0; mm < MB; ++mm) { const size_t off = (size_t)(row0 + ai * HALF + (mb + mm) * 16) * D + col0;
#pragma unroll
                for (int bj = 0; bj < 2; ++bj) {
                    if (STATS) { bf[mm][bj][0] = *(const f32x4*)((const float*)base + off + bj * HALF); bf[mm][bj][1] = *(const f32x4*)((const float*)base + off + bj * HALF + 4); }
                    else bh[mm][bj] = *(const u32x4*)((const bf16_t*)base + off + bj * HALF); } }
#pragma unroll
            for (int mm = 0; mm < MB; ++mm) { const int m = mb + mm; const int row = row0 + ai * HALF + m * 16; const size_t off = (size_t)row * D + col0; float ss = 0.f;
#pragma unroll
                for (int bj = 0; bj < 2; ++bj) { f32x4 b0, b1;
                    if (STATS) { b0 = bf[mm][bj][0]; b1 = bf[mm][bj][1]; }
                    else { const u32x4 t = bh[mm][bj]; b0 = (f32x4){bf_lo(t.x), bf_hi(t.x), bf_lo(t.y), bf_hi(t.y)}; b1 = (f32x4){bf_lo(t.z), bf_hi(t.z), bf_lo(t.w), bf_hi(t.w)}; }
                    const f32x4 o0 = b0 + gv[bj][0] * acc[ai][bj][m][0], o1 = b1 + gv[bj][1] * acc[ai][bj][m][1];
                    if (STATS) { u32x4 w; w.x = cvt_pk_bf16(o0[0], o0[1]); w.y = cvt_pk_bf16(o0[2], o0[3]); w.z = cvt_pk_bf16(o1[0], o1[1]); w.w = cvt_pk_bf16(o1[2], o1[3]);
                        *(u32x4*)((bf16_t*)out + off + bj * HALF) = w;
                        ss += (o0[0] * o0[0] + o0[1] * o0[1]) + (o0[2] * o0[2] + o0[3] * o0[3]) + (o1[0] * o1[0] + o1[1] * o1[1]) + (o1[2] * o1[2] + o1[3] * o1[3]);
                        const f32x4 x0 = o0 * mv[bj][0], x1 = o1 * mv[bj][1];
                        u32x4 w2; w2.x = cvt_pk_bf16(x0[0], x0[1]); w2.y = cvt_pk_bf16(x0[2], x0[3]); w2.z = cvt_pk_bf16(x1[0], x1[1]); w2.w = cvt_pk_bf16(x1[2], x1[3]);
                        *(u32x4*)(xm + off + bj * HALF) = w2; }
                    else { *(f32x4*)((float*)out + off + bj * HALF) = o0; *(f32x4*)((float*)out + off + bj * HALF + 4) = o1; } }
                if (STATS) { ss += __shfl_xor(ss, 16); ss += __shfl_xor(ss, 32); if (fq == 0) ssq[(size_t)row * 16 + u.pn * 4 + wc] = ss; } }
        }
    }
};
}

#define XB_TMO      128
#define XB_XCNT(j)  (256  + 64 * (j))
#define XB_XSUB(j)  (1280 + 64 * (j))
#define XB_XGEN(j)  (2304 + 64 * (j))
#define XB_TOP      3328
#define XB_TOPGEN   3392
#define XCD_BAR_WORDS 3456
#define XB_SPIN_CAP (1u << 18)
__device__ __forceinline__ unsigned xb_ld(unsigned* p)              { return __hip_atomic_load(p, __ATOMIC_RELAXED, __HIP_MEMORY_SCOPE_AGENT); }
__device__ __forceinline__ unsigned xb_add(unsigned* p, unsigned v) { return __hip_atomic_fetch_add(p, v, __ATOMIC_RELAXED, __HIP_MEMORY_SCOPE_AGENT); }
__device__ __forceinline__ unsigned xb_xcc_id() { return (unsigned)__builtin_amdgcn_s_getreg((3 << 11) | 20) & 0xFu; }
#define XB_SPIN(cond, bar) do { unsigned _sp = 0; while (cond) { __builtin_amdgcn_s_sleep(1); \
    if ((++_sp & 255u) == 0u) { if (xb_ld(&(bar)[XB_TMO])) break; if (_sp > XB_SPIN_CAP) { atomicAdd(&(bar)[XB_TMO], 1u); break; } } } } while (0)
struct XcdBarrier { unsigned* bar; unsigned x; volatile LAS unsigned* st; };
__device__ __forceinline__ XcdBarrier xcd_barrier_post(unsigned* bar, volatile LAS unsigned* st) {
    XcdBarrier b; b.bar = bar; b.x = xb_xcc_id(); b.st = st;
    if (threadIdx.x == 0) (void)xb_add(&bar[XB_XCNT(b.x)], 1u);
    return b;
}
__device__ __forceinline__ void xcd_barrier_complete(unsigned* bar, unsigned x, unsigned& nloc, unsigned& nx) {
    const unsigned G = gridDim.x * gridDim.y * gridDim.z;
    unsigned sum, cnt, mine, sp = 0u;
    for (;;) {
        sum = 0u; cnt = 0u; mine = 0u;
#pragma unroll
        for (unsigned j = 0; j < 16; ++j) { const unsigned c = xb_ld(&bar[XB_XCNT(j)]); sum += c; cnt += (c > 0u) ? 1u : 0u; mine = (j == x) ? c : mine; }
        if (sum == G) break;
        __builtin_amdgcn_s_sleep(1);
        if ((++sp & 255u) == 0u) { if (xb_ld(&bar[XB_TMO])) break; if (sp > XB_SPIN_CAP) { atomicAdd(&bar[XB_TMO], 1u); break; } }
    }
    nloc = mine > 0u ? mine : 1u; nx = cnt > 0u ? cnt : 1u;
}
__device__ __forceinline__ void xcd_barrier(const XcdBarrier& b) {
    asm volatile("s_waitcnt vmcnt(0)" ::: "memory");
    __syncthreads();
    if (threadIdx.x == 0) {
        unsigned* bar = b.bar;
        __builtin_amdgcn_s_waitcnt(0);
        unsigned nloc = b.st[0], nx = b.st[1];
        if (nloc == 0u) { xcd_barrier_complete(bar, b.x, nloc, nx); b.st[0] = nloc; b.st[1] = nx; }
        const unsigned old = xb_add(&bar[XB_XSUB(b.x)], 1u);
        const unsigned gen = old / nloc;
        if (old + 1u == (gen + 1u) * nloc) {
            __builtin_amdgcn_fence(__ATOMIC_RELEASE, "agent");
            asm volatile("s_waitcnt vmcnt(0)" ::: "memory");
            const unsigned og = xb_add(&bar[XB_TOP], 1u);
            const unsigned tg = og / nx;
            if (og + 1u == (tg + 1u) * nx) xb_add(&bar[XB_TOPGEN], 1u);
            else XB_SPIN(xb_ld(&bar[XB_TOPGEN]) == tg, bar);
            __builtin_amdgcn_fence(__ATOMIC_ACQUIRE, "agent");
            xb_add(&bar[XB_XGEN(b.x)], 1u);
            asm volatile("s_waitcnt vmcnt(0)" ::: "memory");
        } else {
            XB_SPIN(xb_ld(&bar[XB_XGEN(b.x)]) == gen, bar);
            __builtin_amdgcn_fence(__ATOMIC_ACQUIRE, "agent");
            asm volatile("s_waitcnt vmcnt(0)" ::: "memory");
        }
    }
    __syncthreads();
}

struct Args {
    const float *x, *c, *ln_g, *ada_w, *ada_b, *w_in_ab, *conv_w, *sg_norm, *sg_w, *sg_b, *w_out_ab, *w_in_c, *q_norm, *k_norm, *w_out_c;
    float* out; unsigned char* ws; int ph_lo, ph_hi;
};

__device__ __forceinline__ int ab_row(int c) {
    const int seg = c >> 10, cc = c & 1023, t = cc >> 7, r = cc & 127;
    switch (seg) {
        case 1: return 256 * t + r;
        case 2: return 256 * t + 128 + r;
        case 0: return 256 * (8 + t) + r;
        case 3: return 256 * (8 + t) + 128 + r;
        case 4: return 256 * (16 + t) + r;
        case 6: return 256 * (16 + t) + 128 + r;
        default: return 256 * 24 + cc;
    }
}
__device__ __forceinline__ int c_row(int c) {
    const int seg = c >> 10, cc = c & 1023;
    if (seg == 2) return 3072 + cc;
    if (seg == 3) return 2048 + cc;
    const int tile = cc >> 8, ct = cc & 255, hh = ct >> 6, bj = (ct >> 5) & 1, i = ct & 31;
    return seg * 1024 + tile * 256 + 128 * bj + 32 * hh + i;
}
template <int MODE>
__device__ __forceinline__ void p0_transpose_item(const float* W, int K, int N, bf16_t* WT, LAS float* scr, int item, int lane) {
    const int nblk = N / 32, kb = item / nblk, nb = item % nblk, k0 = 64 * kb, n0 = 32 * nb;
    const int rb = MODE == 1 ? ab_row(n0) : (MODE == 2 ? c_row(n0) : n0);
#pragma unroll 8
    for (int i = 0; i < 32; ++i) { const int kk = 2 * i + (lane >> 5); scr[kk * 33 + (lane & 31)] = W[(size_t)(k0 + kk) * N + n0 + (lane & 31)]; }
    asm volatile("s_waitcnt lgkmcnt(0)" ::: "memory");
    const int c = lane & 7;
#pragma unroll
    for (int j = 0; j < 4; ++j) { const int n = (lane >> 3) + 8 * j; const LAS float* s = scr + (8 * c) * 33 + n;
        u32x4 o; o.x = cvt_pk_bf16(s[0 * 33], s[1 * 33]); o.y = cvt_pk_bf16(s[2 * 33], s[3 * 33]); o.z = cvt_pk_bf16(s[4 * 33], s[5 * 33]); o.w = cvt_pk_bf16(s[6 * 33], s[7 * 33]);
        *(u32x4*)(WT + (size_t)(rb + n) * K + k0 + 8 * c) = o; }
    asm volatile("s_waitcnt lgkmcnt(0)" ::: "memory");
}

__device__ __forceinline__ float wave_sum(float v) {
#pragma unroll
    for (int o = 1; o < 64; o <<= 1) v += __shfl_xor(v, o);
    return v;
}
__device__ __forceinline__ void rms_phase(const float* X, const float* g, const float* mod  , bf16_t* H, int gw, int NGW, int lane) {
    for (int b = 0; b < BATCH; ++b) {
        f32x4 mul[4], sh[4];
#pragma unroll
        for (int j = 0; j < 4; ++j) { const int col = 4 * lane + 256 * j; const f32x4 gg = *(const f32x4*)(g + col), sc = *(const f32x4*)(mod + b * 3072 + 1024 + col);
            sh[j] = *(const f32x4*)(mod + b * 3072 + col); mul[j] = gg * (sc + 1.0f); }
#pragma unroll 4
        for (int r = gw; r < SEQ; r += NGW) {
            const size_t m = (size_t)b * SEQ + r;
            const f32x4* xr = (const f32x4*)(X + m * D) + lane;
            f32x4 v[4]; float s = 0.f;
#pragma unroll
            for (int j = 0; j < 4; ++j) { v[j] = xr[64 * j]; s += (v[j].x * v[j].x + v[j].y * v[j].y) + (v[j].z * v[j].z + v[j].w * v[j].w); }
            const float rstd = __builtin_amdgcn_rsqf(wave_sum(s) * (1.f / D) + EPS);
            u32x2* o8 = (u32x2*)(H + m * D) + lane;
#pragma unroll
            for (int j = 0; j < 4; ++j) { const f32x4 o = v[j] * rstd * mul[j] + sh[j]; u32x2 w; w.x = cvt_pk_bf16(o.x, o.y); w.y = cvt_pk_bf16(o.z, o.w); o8[64 * j] = w; }
        }
    }
}

__device__ __forceinline__ void mixer_phase(LAS unsigned char* lds, const bf16_t* U, const bf16_t* Gt, const bf16_t* UZ, const bf16_t* V, const float* conv_w, const float* sg_norm,
                                            const bf16_t* WTR, const float* sg_b, bf16_t* Y, int vcu, int G) {
    const int tid = threadIdx.x, lane = tid & 63, w = __builtin_amdgcn_readfirstlane(tid >> 6), fr = lane & 15, fq = lane >> 4;
    constexpr int PT = 136;
    LAS bf16_t* VNT = (LAS bf16_t*)lds;
    LAS bf16_t* WL = (LAS bf16_t*)(lds + 128 * PT * 2);
    LAS float* SG = (LAS float*)(lds + 2 * 128 * PT * 2);
    int g_staged = -1;
    const int c8 = tid & 15, rg = tid >> 4;
    const int s = tid >> 2, qd = tid & 3;
    for (int unit = vcu; unit < BATCH * 64 * 8; unit += G) {
        const int g = unit & 7, cch = (unit >> 3) & 63, b = unit >> 9; const size_t r0 = (size_t)b * SEQ + cch * 128;
        const int ch = 128 * g + 8 * c8; const size_t row = r0 + 4 * rg;
        u32x4 ur[6], gv[4], vv[4], uz[4];
        const bool halo0 = (cch == 0 && rg == 0);
#pragma unroll
        for (int i = 0; i < 4; ++i) vv[i] = *(const u32x4*)(V + (r0 + s) * D + 128 * g + 32 * qd + 8 * i);
#pragma unroll
        for (int i = 0; i < 6; ++i) { if (i < 2 && halo0) ur[i] = (u32x4){0u, 0u, 0u, 0u}; else ur[i] = *(const u32x4*)(U + (row + i - 2) * D + ch); }
#pragma unroll
        for (int i = 0; i < 4; ++i) gv[i] = *(const u32x4*)(Gt + (row + i) * D + ch);
#pragma unroll
        for (int i = 0; i < 4; ++i) uz[i] = *(const u32x4*)(UZ + (r0 + s) * D + 128 * g + 32 * qd + 8 * i);
        if (g != g_staged) {
            __syncthreads();
            const bf16_t* wp = WTR + ((size_t)g * 128 + s) * 128 + 32 * qd;
#pragma unroll
            for (int i = 0; i < 4; ++i) *(LAS u32x4*)(WL + s * PT + 32 * qd + 8 * i) = *(const u32x4*)(wp + 8 * i);
            g_staged = g;
        }
        { float v[32]; float ss = 0.f;
#pragma unroll
          for (int i = 0; i < 4; ++i)
#pragma unroll
              for (int p = 0; p < 4; ++p) { v[8 * i + 2 * p] = bf_lo(vv[i][p]); v[8 * i + 2 * p + 1] = bf_hi(vv[i][p]); }
#pragma unroll
          for (int i = 0; i < 32; ++i) ss += v[i] * v[i];
          ss += __shfl_xor(ss, 1); ss += __shfl_xor(ss, 2);
          const float rs = __builtin_amdgcn_rsqf(ss * (1.0f / 128.0f) + EPS);
          const float* nw = sg_norm + g * 128 + 32 * qd;
#pragma unroll
          for (int i = 0; i < 32; i += 2) { const unsigned pk = cvt_pk_bf16(v[i] * rs * nw[i], v[i + 1] * rs * nw[i + 1]);
              VNT[(32 * qd + i) * PT + s] = (bf16_t)(pk & 0xffffu); VNT[(32 * qd + i + 1) * PT + s] = (bf16_t)(pk >> 16); }
        }
        { float cw[3][8];
#pragma unroll
          for (int k = 0; k < 3; ++k) { const f32x4 a = *(const f32x4*)(conv_w + k * D + ch), bq = *(const f32x4*)(conv_w + k * D + ch + 4);
              cw[k][0] = a.x; cw[k][1] = a.y; cw[k][2] = a.z; cw[k][3] = a.w; cw[k][4] = bq.x; cw[k][5] = bq.y; cw[k][6] = bq.z; cw[k][7] = bq.w; }
#pragma unroll
          for (int i = 0; i < 4; ++i) { float o[8];
#pragma unroll
              for (int p = 0; p < 4; ++p) { const unsigned u0 = ur[i][p], u1 = ur[i + 1][p], u2 = ur[i + 2][p];
                  o[2 * p] = bf_lo(gv[i][p]) * (cw[0][2 * p] * bf_lo(u0) + cw[1][2 * p] * bf_lo(u1) + cw[2][2 * p] * bf_lo(u2));
                  o[2 * p + 1] = bf_hi(gv[i][p]) * (cw[0][2 * p + 1] * bf_hi(u0) + cw[1][2 * p + 1] * bf_hi(u1) + cw[2][2 * p + 1] * bf_hi(u2)); }
              u32x4 wv; wv.x = cvt_pk_bf16(o[0], o[1]); wv.y = cvt_pk_bf16(o[2], o[3]); wv.z = cvt_pk_bf16(o[4], o[5]); wv.w = cvt_pk_bf16(o[6], o[7]);
              *(u32x4*)(Y + (row + i) * 2048 + ch) = wv; }
        }
        __syncthreads();
        f32x4 acc[8];
#pragma unroll
        for (int tt = 0; tt < 8; ++tt) acc[tt] = (f32x4){0.f, 0.f, 0.f, 0.f};
#pragma unroll
        for (int ks = 0; ks < 4; ++ks) { const bf16x8 a = *(const LAS bf16x8*)(VNT + (16 * w + fr) * PT + 32 * ks + 8 * fq);
#pragma unroll
            for (int tt = 2 * ks; tt < 8; ++tt) { const bf16x8 bw = *(const LAS bf16x8*)(WL + (16 * tt + fr) * PT + 32 * ks + 8 * fq);
                acc[tt] = __builtin_amdgcn_mfma_f32_16x16x32_bf16(a, bw, acc[tt], 0, 0, 0); } }
#pragma unroll
        for (int tt = 0; tt < 8; ++tt) { const int t = 16 * tt + fr; const float bb = sg_b[g * 128 + t];
            *(LAS f32x4*)(SG + t * 132 + 16 * w + 4 * fq) = acc[tt] + bb; }
        __syncthreads();
        { bf16_t* yp = Y + (r0 + s) * 2048 + 1024 + 128 * g + 32 * qd;
#pragma unroll
          for (int i = 0; i < 4; ++i) { const f32x4 s0 = *(const LAS f32x4*)(SG + s * 132 + 32 * qd + 8 * i), s1 = *(const LAS f32x4*)(SG + s * 132 + 32 * qd + 8 * i + 4);
              u32x4 wv; wv.x = cvt_pk_bf16(bf_lo(uz[i].x) * s0.x, bf_hi(uz[i].x) * s0.y); wv.y = cvt_pk_bf16(bf_lo(uz[i].y) * s0.z, bf_hi(uz[i].y) * s0.w);
              wv.z = cvt_pk_bf16(bf_lo(uz[i].z) * s1.x, bf_hi(uz[i].z) * s1.y); wv.w = cvt_pk_bf16(bf_lo(uz[i].w) * s1.z, bf_hi(uz[i].w) * s1.w);
              *(u32x4*)(yp + 8 * i) = wv; }
        }
    }
    __syncthreads();
}

__device__ __forceinline__ int crow(int i, int hi) { return (i & 3) + 8 * (i >> 2) + 4 * hi; }
__device__ __forceinline__ void attn_load_k(bf16x8 (&kf)[4], bool in_lds, LAS unsigned char* KL, int kl0, const bf16_t* kg, int ql, int hi) {
    if (in_lds) { const int r = kl0 + ql; LAS unsigned char* rp = KL + r * 128; const int sw = (r >> 1) & 7;
#pragma unroll
        for (int kk = 0; kk < 4; ++kk) kf[kk] = *(const LAS bf16x8*)(rp + (((2 * kk + hi) ^ sw) << 4));
    } else {
#pragma unroll
        for (int kk = 0; kk < 4; ++kk) kf[kk] = *(const bf16x8*)(kg + 16 * kk);
    }
}
__device__ __forceinline__ void attn_phase(LAS unsigned char* lds, const bf16_t* Q, const bf16_t* Kb, const bf16_t* VT, const bf16_t* Zs, bf16_t* OZ, int vcu, int G) {
    const int tid = threadIdx.x, lane = tid & 63, w = __builtin_amdgcn_readfirstlane(tid >> 6), ql = lane & 31, hi = lane >> 5;
    constexpr float STOP = 5.421010862427522e-20f;
    LAS unsigned char* KL = lds;
    LAS unsigned char* VL = lds + 49152;
    constexpr int NU = BATCH * 16 * (SEQ / 256);
    u32x4 sk[6], sv[6];
#define ATT_DECODE(u_, h_, rb_, q0b_, kw0_) const int h_ = ((u_) >> 5) & 15; const size_t rb_ = (size_t)((u_) >> 9) * SEQ; const int q0b_ = 256 * ((u_) & 31), kw0_ = q0b_ >= 128 ? q0b_ - 128 : 0;
#define ATT_LOAD_STAGE(u_) do { ATT_DECODE(u_, h__, rb__, q0b__, kw0__) \
        _Pragma("unroll") for (int i = 0; i < 6; ++i) { const int idx = tid + NTHR * i, r = idx >> 3, c = idx & 7; sk[i] = *(const u32x4*)(Kb + (rb__ + kw0__ + r) * D + h__ * 64 + 8 * c); } \
        _Pragma("unroll") for (int i = 0; i < 6; ++i) { const int idx = tid + NTHR * i, d = idx / 48, ch = idx % 48; sv[i] = *(const u32x4*)(VT + (size_t)(h__ * 64 + d) * M + rb__ + kw0__ + 8 * ch); } } while (0)
    if (vcu < NU) ATT_LOAD_STAGE(vcu);
    for (int unit = vcu; unit < NU; unit += G) {
        ATT_DECODE(unit, h, rowbase, q0b, kw0)
        const int qblk = unit & 31;
        const int qb = 8 * qblk + w, q0 = 32 * qb;
        bf16x8 qf[4];
        { const bf16_t* qp = Q + (rowbase + q0 + ql) * D + h * 64 + 8 * hi;
#pragma unroll
          for (int kk = 0; kk < 4; ++kk) qf[kk] = *(const bf16x8*)(qp + 16 * kk); }
        u32x2 zz[8];
        { const bf16_t* zp = Zs + (rowbase + q0 + ql) * D + h * 64 + 4 * hi;
#pragma unroll
          for (int g4 = 0; g4 < 4; ++g4) { zz[g4] = *(const u32x2*)(zp + 8 * g4); zz[4 + g4] = *(const u32x2*)(zp + 32 + 8 * g4); } }
        asm volatile("" ::: "memory");
#pragma unroll
        for (int i = 0; i < 6; ++i) { const int idx = tid + NTHR * i, r = idx >> 3, c = idx & 7;
            *(LAS u32x4*)(KL + r * 128 + ((c ^ ((r >> 1) & 7)) << 4)) = sk[i]; }
#pragma unroll
        for (int i = 0; i < 6; ++i) { const int idx = tid + NTHR * i, d = idx / 48, ch = idx % 48;
            { u32x4 v = sv[i]; const int gp = (2 * ch) ^ (d & 31);
                if (d & 1) { const u32x4 t = v; v.x = t.z; v.y = t.w; v.z = t.x; v.w = t.y; }
                *(LAS u32x4*)(VL + d * 768 + ((gp & ~1) << 3)) = v; } }
        __syncthreads();
        { const int nu_ = unit + G < NU ? unit + G : unit; ATT_LOAD_STAGE(nu_); }
        f32x16 o0, o1;
#pragma unroll
        for (int i = 0; i < 16; ++i) { o0[i] = 0.f; o1[i] = 0.f; }
        float carry = 1.f;
#define ATT_TILE(IN_LDS_) { const int key0 = 32 * kt; \
            u32x2 vf[2][2][2]; \
            if (IN_LDS_) { const int g0 = ((key0 - kw0) >> 2) + hi; \
_Pragma("unroll") \
                for (int dh = 0; dh < 2; ++dh) { LAS unsigned char* rp = VL + (32 * dh + ql) * 768; \
_Pragma("unroll") \
                    for (int s = 0; s < 2; ++s) { vf[dh][s][0] = *(const LAS u32x2*)(rp + (((g0 + 4 * s) ^ ql) << 3)); vf[dh][s][1] = *(const LAS u32x2*)(rp + (((g0 + 4 * s + 2) ^ ql) << 3)); } } \
            } else { const bf16_t* vp = VT + (size_t)(h * 64 + ql) * M + rowbase + key0 + 4 * hi; \
_Pragma("unroll") \
                for (int dh = 0; dh < 2; ++dh) \
_Pragma("unroll") \
                    for (int s = 0; s < 2; ++s) { vf[dh][s][0] = *(const u32x2*)(vp + (size_t)dh * 32 * M + 16 * s); vf[dh][s][1] = *(const u32x2*)(vp + (size_t)dh * 32 * M + 16 * s + 8); } } \
            bf16x8 kf[4]; \
            attn_load_k(kf, IN_LDS_, KL, key0 - kw0, Kb + (rowbase + key0 + ql) * D + h * 64 + 8 * hi, ql, hi); \
            f32x16 S; \
_Pragma("unroll") \
            for (int i = 0; i < 16; ++i) S[i] = 0.f; \
_Pragma("unroll") \
            for (int kk = 0; kk < 4; ++kk) S = __builtin_amdgcn_mfma_f32_32x32x16_bf16(kf[kk], qf[kk], S, 0, 0, 0); \
            float be[16], om[16]; \
            const bool diag = (kt == qb); \
_Pragma("unroll") \
            for (int i = 0; i < 16; ++i) { const float zc = __builtin_fmaxf(S[i], -126.0f); const float E = fast_exp2(-zc); float bv = fast_rcp(1.0f + E); float ov = E * bv; \
                if (diag) { const bool valid = crow(i, hi) < ql; bv = valid ? bv : 0.f; ov = valid ? ov : 1.f; } \
                be[i] = bv; om[i] = ov; } \
            float gs[4], pg[4]; \
_Pragma("unroll") \
            for (int gi = 0; gi < 4; ++gi) { gs[gi] = (om[4 * gi] * om[4 * gi + 1]) * (om[4 * gi + 2] * om[4 * gi + 3]); pg[gi] = __shfl_xor(gs[gi], 32); } \
            float run = carry; float wv[16]; \
_Pragma("unroll") \
            for (int gi = 3; gi >= 0; --gi) { const float base = hi == 0 ? run * pg[gi] : run; \
                const float s3 = base, s2 = s3 * om[4 * gi + 3], s1 = s2 * om[4 * gi + 2], s0 = s1 * om[4 * gi + 1]; \
                wv[4 * gi + 3] = be[4 * gi + 3] * s3; wv[4 * gi + 2] = be[4 * gi + 2] * s2; wv[4 * gi + 1] = be[4 * gi + 1] * s1; wv[4 * gi] = be[4 * gi] * s0; \
                run *= gs[gi] * pg[gi]; } \
            carry = run; \
_Pragma("unroll") \
            for (int s = 0; s < 2; ++s) { u32x4 pk; pk.x = cvt_pk_bf16(wv[8 * s], wv[8 * s + 1]); pk.y = cvt_pk_bf16(wv[8 * s + 2], wv[8 * s + 3]); pk.z = cvt_pk_bf16(wv[8 * s + 4], wv[8 * s + 5]); pk.w = cvt_pk_bf16(wv[8 * s + 6], wv[8 * s + 7]); \
                const bf16x8 pf = __builtin_bit_cast(bf16x8, pk); \
                { u32x4 a; a.x = vf[0][s][0].x; a.y = vf[0][s][0].y; a.z = vf[0][s][1].x; a.w = vf[0][s][1].y; o0 = __builtin_amdgcn_mfma_f32_32x32x16_bf16(__builtin_bit_cast(bf16x8, a), pf, o0, 0, 0, 0); } \
                { u32x4 a; a.x = vf[1][s][0].x; a.y = vf[1][s][0].y; a.z = vf[1][s][1].x; a.w = vf[1][s][1].y; o1 = __builtin_amdgcn_mfma_f32_32x32x16_bf16(__builtin_bit_cast(bf16x8, a), pf, o1, 0, 0, 0); } } }
        int kt = qb; bool done = false;
        for (; kt >= 0 && 32 * kt >= kw0; --kt) {
            ATT_TILE(true)
            if (__all(carry < STOP)) { done = true; break; }
        }
        if (!done) for (; kt >= 0; --kt) {
            ATT_TILE(false)
            if (__all(carry < STOP)) break;
        }
#undef ATT_TILE
        bf16_t* op = OZ + (rowbase + q0 + ql) * D + h * 64 + 4 * hi;
#pragma unroll
        for (int g4 = 0; g4 < 4; ++g4) {
            { const u32x2 z2 = zz[g4]; u32x2 wo; wo.x = cvt_pk_bf16(o0[4 * g4] * bf_lo(z2.x), o0[4 * g4 + 1] * bf_hi(z2.x)); wo.y = cvt_pk_bf16(o0[4 * g4 + 2] * bf_lo(z2.y), o0[4 * g4 + 3] * bf_hi(z2.y)); *(u32x2*)(op + 8 * g4) = wo; }
            { const u32x2 z2 = zz[4 + g4]; u32x2 wo; wo.x = cvt_pk_bf16(o1[4 * g4] * bf_lo(z2.x), o1[4 * g4 + 1] * bf_hi(z2.x)); wo.y = cvt_pk_bf16(o1[4 * g4 + 2] * bf_lo(z2.y), o1[4 * g4 + 3] * bf_hi(z2.y)); *(u32x2*)(op + 32 + 8 * g4) = wo; }
        }
        __syncthreads();
    }
#undef ATT_DECODE
#undef ATT_LOAD_STAGE
}

constexpr int N_PHASES = 9;
__global__ void __launch_bounds__(NTHR, 2) hybrid_fwd(Args a) {
    extern __shared__ __attribute__((aligned(16))) unsigned char lds_raw[];
    LAS unsigned char* lds = (LAS unsigned char*)lds_raw;
    const int tid = threadIdx.x, lane = tid & 63, wave = __builtin_amdgcn_readfirstlane(tid >> 6);
    const int G = gridDim.x, bx = blockIdx.x;
    const int vcu = (G % 8 == 0) ? (bx % 8) * (G / 8) + bx / 8 : bx;
    const int gw = vcu * NWAVES + wave, NGW = G * NWAVES;
    unsigned char* ws = a.ws;
    float* MOD = (float*)(ws + WS_MOD); float* SWp = (float*)(ws + WS_SW); float* SSQ = (float*)(ws + WS_SSQ);
    bf16_t* WAB = (bf16_t*)(ws + WS_WAB); bf16_t* WOAB = (bf16_t*)(ws + WS_WOAB); bf16_t* WC = (bf16_t*)(ws + WS_WC); bf16_t* WOC = (bf16_t*)(ws + WS_WOC);
    bf16_t* H0 = (bf16_t*)(ws + WS_H0); bf16_t* Y = (bf16_t*)(ws + WS_Y);
    bf16_t* Ub = (bf16_t*)(ws + WS_U); bf16_t* Gb = (bf16_t*)(ws + WS_G); bf16_t* UZb = (bf16_t*)(ws + WS_UZ); bf16_t* Vb = (bf16_t*)(ws + WS_V);
    bf16_t* X1 = (bf16_t*)(ws + WS_X1); bf16_t* H1 = (bf16_t*)(ws + WS_H1);
    bf16_t* Qb = (bf16_t*)(ws + WS_Q); bf16_t* Kb = (bf16_t*)(ws + WS_K); bf16_t* Zb = (bf16_t*)(ws + WS_Z); bf16_t* VTb = (bf16_t*)(ws + WS_VT); bf16_t* OZb = (bf16_t*)(ws + WS_OZ);
    const int lo = a.ph_lo, hi = a.ph_hi;
#define IN(k) (lo <= (k) && (k) < hi)
    volatile LAS unsigned* bst = (volatile LAS unsigned*)(lds + LDS_BYTES - 64);
    if (tid < 4) bst[tid] = 0u;
    __syncthreads();
    XcdBarrier xbar; xbar.bar = (unsigned*)(ws + WS_CTL); xbar.x = 0; xbar.st = bst;
    if (hi - lo > 1) xbar = xcd_barrier_post((unsigned*)(ws + WS_CTL), bst);
#define SEAM(k) do { if (IN(k) && IN((k) + 1)) xcd_barrier(xbar); } while (0)

    if (IN(0)) {
        for (int task = bx; task < 192; task += G) {
            LAS float* sc_l = (LAS float*)lds; LAS float* red = sc_l + 2048;
            for (int i = tid; i < BATCH * D; i += NTHR) { const float v = a.c[i]; sc_l[i] = v / (1.0f + __expf(-v)); }
            __syncthreads();
            const int l = task / 96, n0 = (task % 96) * 32, kc = wave * 2 + (lane >> 5), n = n0 + (lane & 31);
            const float* W = a.ada_w + (size_t)l * D * 3072 + (size_t)(kc * 64) * 3072 + n;
            float a0 = 0.f, a1 = 0.f;
#pragma unroll
            for (int k = 0; k < 64; ++k) { const float wv = W[(size_t)k * 3072]; a0 += sc_l[kc * 64 + k] * wv; a1 += sc_l[D + kc * 64 + k] * wv; }
            red[(kc * 2 + 0) * 32 + (lane & 31)] = a0; red[(kc * 2 + 1) * 32 + (lane & 31)] = a1;
            __syncthreads();
            if (tid < 64) { const int b = tid >> 5, nn = tid & 31; float s = 0.f;
#pragma unroll
                for (int k = 0; k < 16; ++k) s += red[(k * 2 + b) * 32 + nn];
                MOD[(l * 2 + b) * 3072 + n0 + nn] = s + a.ada_b[l * 3072 + n0 + nn]; }
            __syncthreads();
        }
        for (int i = gw * 64 + lane; i < 8 * 128 * 128 / 8; i += NGW * 64) {
            const int e0 = 8 * i, t = (e0 >> 7) & 127, s0 = e0 & 127; const f32x4 p = *(const f32x4*)(a.sg_w + e0), q = *(const f32x4*)(a.sg_w + e0 + 4);
            float e[8] = {p.x, p.y, p.z, p.w, q.x, q.y, q.z, q.w};
#pragma unroll
            for (int k = 0; k < 8; ++k) if (s0 + k > t) e[k] = 0.f;
            u32x4 wv; wv.x = cvt_pk_bf16(e[0], e[1]); wv.y = cvt_pk_bf16(e[2], e[3]); wv.z = cvt_pk_bf16(e[4], e[5]); wv.w = cvt_pk_bf16(e[6], e[7]);
            *(u32x4*)((bf16_t*)(ws + WS_WTR) + e0) = wv; }
        LAS float* scr = (LAS float*)(lds + wave * 16384);
        constexpr int I_AB = (D / 64) * (IN_AB / 32), I_OAB = (2048 / 64) * (D / 32), I_C = (D / 64) * (IN_C / 32), I_OC = (D / 64) * (D / 32);
        for (int it = gw; it < I_AB; it += NGW) p0_transpose_item<1>(a.w_in_ab, D, IN_AB, WAB, scr, it, lane);
    }
    SEAM(0);
    if (IN(1)) {
        rms_phase(a.x, a.ln_g, MOD, H0, gw, NGW, lane);
        { LAS float* scr = (LAS float*)(lds + wave * 16384);
          constexpr int I_OAB = (2048 / 64) * (D / 32), I_C = (D / 64) * (IN_C / 32), I_OC = (D / 64) * (D / 32);
          for (int it = gw; it < I_OAB + I_C + I_OC; it += NGW) {
              int r = it;
              if (r < I_OAB) { p0_transpose_item<0>(a.w_out_ab, 2048, D, WOAB, scr, r, lane); continue; } r -= I_OAB;
              if (r < I_C) { p0_transpose_item<2>(a.w_in_c, D, IN_C, WC, scr, r, lane); continue; } r -= I_C;
              p0_transpose_item<0>(a.w_out_c, D, D, WOC, scr, r, lane);
          } }
    }
    SEAM(1);
    if (IN(2)) { pg8::Sched2 S; S.init(H0, WAB, M, IN_AB, nullptr, nullptr, 0, 0, D, G, bx);
        pg8::EpiP1 E{Ub}; pg8::gemm_phase<pg8::EpiP1, true, true>(lds, S, E); }
    SEAM(2);
    if (IN(3)) {
        { f32x4 s0[2][2], s1[2][2];
#pragma unroll
          for (int c = 0; c < 2; ++c)
#pragma unroll
              for (int q = 0; q < 2; ++q) { s0[c][q] = *(const f32x4*)(MOD + 2 * 3072 + 512 * c + 8 * lane + 4 * q); s1[c][q] = *(const f32x4*)(MOD + 3 * 3072 + 512 * c + 8 * lane + 4 * q); }
          for (int n = gw; n < IN_C; n += NGW) {
              const bf16_t* wr_ = WC + (size_t)c_row(n) * D + 8 * lane; float a0 = 0.f, a1 = 0.f;
#pragma unroll
              for (int c = 0; c < 2; ++c) { const u32x4 t = *(const u32x4*)(wr_ + 512 * c);
                  const f32x4 w0 = (f32x4){bf_lo(t.x), bf_hi(t.x), bf_lo(t.y), bf_hi(t.y)}, w1 = (f32x4){bf_lo(t.z), bf_hi(t.z), bf_lo(t.w), bf_hi(t.w)};
                  const f32x4 p0 = w0 * s0[c][0] + w1 * s0[c][1], p1 = w0 * s1[c][0] + w1 * s1[c][1];
                  a0 += (p0[0] + p0[1]) + (p0[2] + p0[3]); a1 += (p1[0] + p1[1]) + (p1[2] + p1[3]); }
              a0 = wave_sum(a0); a1 = wave_sum(a1);
              if (lane == 0) { SWp[n] = a0; SWp[4096 + n] = a1; } } }
    }
    if (IN(3)) mixer_phase(lds, Ub, Gb, UZb, Vb, a.conv_w, a.sg_norm, (const bf16_t*)(ws + WS_WTR), a.sg_b, Y, vcu, G);
    SEAM(3);
    if (IN(4)) { pg8::Sched2 S; S.init(Y, WOAB, M, D, nullptr, nullptr, 0, 0, 2048, G, bx);
        pg8::EpiRes<true> E{a.x, X1, MOD + 2048, a.ln_g + D, MOD + 2 * 3072 + 1024, H1, SSQ}; pg8::gemm_phase<pg8::EpiRes<true>, true, true>(lds, S, E); }
    if (IN(4) && IN(6)) xcd_barrier(xbar);
    if (IN(6)) { pg8::Sched2 S; S.init(H1, WC, M, 3072, WC + (size_t)3072 * D, H1, D, M, D, G, bx);
        pg8::EpiP5 E{Qb, VTb, a.q_norm, a.k_norm, SSQ, SWp}; pg8::gemm_phase<pg8::EpiP5, true, true>(lds, S, E); }
    SEAM(6);
    if (IN(7)) attn_phase(lds, Qb, Kb, VTb, Zb, OZb, vcu, G);
    SEAM(7);
    if (IN(8)) { pg8::Sched2 S; S.init(OZb, WOC, M, D, nullptr, nullptr, 0, 0, D, G, bx);
        pg8::EpiRes<false> E{X1, a.out, MOD + 2 * 3072 + 2048, nullptr, nullptr, nullptr, nullptr}; pg8::gemm_phase<pg8::EpiRes<false>, true, true>(lds, S, E); }
#undef IN
#undef SEAM
}

extern "C" void kernel_launch(void* const* d_in, const int* in_sizes, int n_in, void* d_out, int out_size, void* d_ws, size_t ws_size, hipStream_t stream) {
    static int grid = 0;
    if (grid == 0) {
        if (n_in != 15 || in_sizes[0] != M * D || out_size != M * D || ws_size < WS_END) { fprintf(stderr, "kernel_launch: unexpected problem geometry (n_in %d, ws %zu)\n", n_in, ws_size); grid = -1; return; }
        int dev = 0, cus = 0, per_cu = 0;
        (void)hipGetDevice(&dev); (void)hipDeviceGetAttribute(&cus, hipDeviceAttributeMultiprocessorCount, dev);
        if (hipFuncSetAttribute((const void*)hybrid_fwd, hipFuncAttributeMaxDynamicSharedMemorySize, LDS_BYTES) != hipSuccess) { fprintf(stderr, "kernel_launch: hipFuncSetAttribute failed\n"); grid = -1; return; }
        if (hipOccupancyMaxActiveBlocksPerMultiprocessor(&per_cu, (const void*)hybrid_fwd, NTHR, LDS_BYTES) != hipSuccess || per_cu < 1) { fprintf(stderr, "kernel_launch: occupancy query says %d\n", per_cu); per_cu = 1; }
        (void)hipGetLastError();
        grid = cus * per_cu;
    }
    if (grid < 0) return;
    Args a{};
    a.x = (const float*)d_in[0]; a.c = (const float*)d_in[1]; a.ln_g = (const float*)d_in[2]; a.ada_w = (const float*)d_in[3]; a.ada_b = (const float*)d_in[4];
    a.w_in_ab = (const float*)d_in[5]; a.conv_w = (const float*)d_in[6]; a.sg_norm = (const float*)d_in[7]; a.sg_w = (const float*)d_in[8]; a.sg_b = (const float*)d_in[9];
    a.w_out_ab = (const float*)d_in[10]; a.w_in_c = (const float*)d_in[11]; a.q_norm = (const float*)d_in[12]; a.k_norm = (const float*)d_in[13]; a.w_out_c = (const float*)d_in[14];
    a.out = (float*)d_out; a.ws = (unsigned char*)d_ws;
#if MK_MULTI
    for (int p = 0; p < N_PHASES; ++p) { a.ph_lo = p; a.ph_hi = p + 1; hipLaunchKernelGGL(hybrid_fwd, dim3(grid), dim3(NTHR), LDS_BYTES, stream, a); }
#else
    a.ph_lo = 0; a.ph_hi = N_PHASES;
    (void)hipMemsetAsync((char*)d_ws + WS_CTL, 0, CTL_ZERO_BYTES, stream);
    void* args[] = {&a};
    hipError_t e = hipLaunchCooperativeKernel((const void*)hybrid_fwd, dim3(grid), dim3(NTHR), args, LDS_BYTES, stream);
    if (e != hipSuccess) fprintf(stderr, "kernel_launch: cooperative launch failed: %s (grid %d)\n", hipGetErrorString(e), grid);
#endif
}
```

```cpp
#include <hip/hip_runtime.h>
#include <hip/hip_cooperative_groups.h>
#include <cstdio>
#include <cstdint>
namespace cg = cooperative_groups;

#ifndef MK_MULTI
#define MK_MULTI 0
#endif

#define LAS __attribute__((address_space(3)))
typedef unsigned short bf16_t;
typedef short bf16x8 __attribute__((ext_vector_type(8)));
typedef float f32x4 __attribute__((ext_vector_type(4)));
typedef float f32x16 __attribute__((ext_vector_type(16)));
typedef unsigned u32x4 __attribute__((ext_vector_type(4)));
typedef unsigned u32x2 __attribute__((ext_vector_type(2)));

constexpr int BATCH = 2, SEQ = 8192, D = 1024, M = BATCH * SEQ;
constexpr int IN_AB = 7168, IN_C = 4096;
constexpr float EPS = 1e-6f;
constexpr int NWAVES = 8, NTHR = 512;
constexpr float LOG2E = 1.4426950408889634f;

constexpr size_t MiB = 1u << 20;
constexpr size_t WS_CTL = 0, CTL_ZERO_BYTES = 64 * 1024;
constexpr size_t WS_MOD = 1 * MiB;
constexpr size_t WS_WAB = 2 * MiB;
constexpr size_t WS_WOAB = 16 * MiB;
constexpr size_t WS_WC = 20 * MiB;
constexpr size_t WS_WOC = 28 * MiB;
constexpr size_t WS_SSQ = 31 * MiB;
constexpr size_t WS_SW = 1 * MiB + 65536;
constexpr size_t WS_WTR = 30 * MiB;
constexpr size_t WS_U = 32 * MiB, WS_G = 64 * MiB, WS_UZ = 96 * MiB, WS_V = 128 * MiB;
constexpr size_t WS_H0 = 160 * MiB;
constexpr size_t WS_Y = 160 * MiB;
constexpr size_t WS_X1 = 32 * MiB;
constexpr size_t WS_H1 = 96 * MiB;
constexpr size_t WS_Q = 128 * MiB, WS_K = 160 * MiB, WS_Z = 192 * MiB, WS_VT = 224 * MiB;
constexpr size_t WS_OZ = 96 * MiB;
constexpr size_t WS_END = 256 * MiB;
static_assert(WS_G - WS_U == (size_t)M * D * 2 && WS_UZ - WS_G == (size_t)M * D * 2 && WS_V - WS_UZ == (size_t)M * D * 2 && WS_K - WS_Q == (size_t)M * D * 2 && WS_Z - WS_K == (size_t)M * D * 2, "contiguous activations");

constexpr int LDS_BYTES = 147456;

typedef float f32x2_t __attribute__((ext_vector_type(2))); typedef __bf16 bf16x2_t __attribute__((ext_vector_type(2)));
__device__ __forceinline__ unsigned cvt_pk_bf16(float lo, float hi) { f32x2_t v = {lo, hi}; bf16x2_t b = __builtin_convertvector(v, bf16x2_t); return __builtin_bit_cast(unsigned, b); }
__device__ __forceinline__ float bf_lo(unsigned u) { return __uint_as_float(u << 16); }
__device__ __forceinline__ float bf_hi(unsigned u) { return __uint_as_float(u & 0xffff0000u); }
__device__ __forceinline__ float fast_exp2(float x) { return __builtin_amdgcn_exp2f(x); }
__device__ __forceinline__ float fast_log2(float x) { return __builtin_amdgcn_logf(x); }
__device__ __forceinline__ float fast_rcp(float x) { return __builtin_amdgcn_rcpf(x); }
__device__ __forceinline__ float silu_f(float v) { return v * fast_rcp(1.0f + fast_exp2(-LOG2E * v)); }

namespace pg8 {
constexpr int BM = 256, BK = 64, HALF = 128, HTB = HALF * BK * 2, STAGE_BYTES = 8 * HTB, NXCD = 8, WGM = 4;
__host__ __device__ __forceinline__ int lds_byte(int r, int c) { const int st = (r >> 4) * 2 + (c >> 5), rr = r & 15, cc = c & 31, ob = rr * 64 + cc * 2; return st * 1024 + (ob ^ (((ob >> 9) & 1) << 5)); }
__host__ __device__ __forceinline__ void stage_rc(int b, int& R, int& C) { const int st = b / 1024, sb = b % 1024, swz = sb ^ (((sb >> 9) & 1) << 5); R = (st >> 1) * 16 + swz / 64; C = (st & 1) * 32 + (swz % 64) / 2; }
__host__ __device__ __forceinline__ int perm32(int rho) { const int n = rho >> 4, i = rho & 15; return 8 * (i >> 2) + 4 * n + (i & 3); }

struct Unit { int pm, pn, sel; };
struct Sched2 {
    const bf16_t *A0, *B0, *A1, *B1; int nM0, nN0, nwg0, nM1, nN1, nwg1, G, c, K;
    __device__ void init(const bf16_t* a0, const bf16_t* b0, int m0, int n0, const bf16_t* a1, const bf16_t* b1, int m1, int n1, int K_, int G_, int c_) {
        A0 = a0; B0 = b0; nM0 = m0 / BM; nN0 = n0 / BM; nwg0 = nM0 * nN0; A1 = a1; B1 = b1; nM1 = m1 / BM; nN1 = n1 / BM; nwg1 = nM1 * nN1; K = K_; G = G_; c = c_; }
    __device__ static void map(int wgid, int nM, int nN, int& pm, int& pn) {
        const int nwg = nM * nN; { const int q = nwg / NXCD, r = nwg % NXCD, xcd = wgid % NXCD, off = wgid / NXCD; wgid = (xcd < r ? xcd * (q + 1) : r * (q + 1) + (xcd - r) * q) + off; }
        const int nig = WGM * nN, gid = wgid / nig, fm = gid * WGM, gsz = (nM - fm) < WGM ? (nM - fm) : WGM;
        pm = fm + ((wgid % nig) % gsz); pn = (wgid % nig) / gsz; }
    __device__ bool next(int i, Unit& u) const {
        const int L = i * G + c;
        if (L < nwg0) { map(L, nM0, nN0, u.pm, u.pn); u.sel = 0; return true; }
        if (L < nwg0 + nwg1) { map(L - nwg0, nM1, nN1, u.pm, u.pn); u.sel = 1; return true; }
        return false; }
    __device__ __forceinline__ const char* baseA(const Unit& u) const { return (const char*)(u.sel ? A1 : A0) + (size_t)u.pm * BM * K * 2; }
    __device__ __forceinline__ const char* baseB(const Unit& u) const { return (const char*)(u.sel ? B1 : B0) + (size_t)u.pn * BM * K * 2; }
};

template <class Epi, bool ALIGN_EPI, bool SP2>
__device__ __forceinline__ void gemm_phase(LAS unsigned char* lds, const Sched2& S, const Epi& E) {
    const int tid = threadIdx.x, wid = __builtin_amdgcn_readfirstlane(tid >> 6), lane = tid & 63, wr = wid >> 2, wc = wid & 3, fr = lane & 15, fq = lane >> 4;
    const int K = S.K, nt = K / BK;
    unsigned voffA[2], voffB[2];
#pragma unroll
    for (int i = 0; i < 2; ++i) { int R, C; stage_rc(tid * 16 + i * 8192, R, C); const int Rb = Epi::PERM ? ((R & ~31) + perm32(R & 31)) : R;
        voffA[i] = (unsigned)(R * K + C) * 2u; voffB[i] = (unsigned)(Rb * K + C) * 2u; }
    const size_t kstep = (size_t)(BK * 2);
    const size_t hstep = (size_t)HALF * K * 2;
    const unsigned ldsw = (unsigned)wid * 1024u;
    const int aoff = lds_byte(wr * 64 + fr, fq * 8), boff = lds_byte(wc * 32 + fr, fq * 8);
#define PG8_SA(b, h) (((b) * 2 + (h)) * HTB)
#define PG8_SB(b, h) ((4 + (b) * 2 + (h)) * HTB)
#define PG8_STAGE(bufoff, gbase, voff) do { _Pragma("unroll") for (int _i = 0; _i < 2; ++_i) \
        __builtin_amdgcn_global_load_lds((const unsigned*)((const char*)(gbase) + (voff)[_i]), (LAS unsigned*)(lds + (bufoff) + ldsw + _i * 8192), 16, 0, 0); } while (0)
#define PG8_LDA(dst, b, h) do { _Pragma("unroll") for (int m = 0; m < 4; ++m) _Pragma("unroll") for (int k = 0; k < 2; ++k) dst[m][k] = *(const LAS bf16x8*)(lds + PG8_SA(b, h) + aoff + m * 2048 + k * 1024); } while (0)
#define PG8_LDB(dst, b, h) do { _Pragma("unroll") for (int n = 0; n < 2; ++n) _Pragma("unroll") for (int k = 0; k < 2; ++k) dst[n][k] = *(const LAS bf16x8*)(lds + PG8_SB(b, h) + boff + n * 2048 + k * 1024); } while (0)
#define PG8_MMA(ai, bj, At, Bt) do { __builtin_amdgcn_s_setprio(1); _Pragma("unroll") for (int m = 0; m < 4; ++m) _Pragma("unroll") for (int n = 0; n < 2; ++n) _Pragma("unroll") for (int k = 0; k < 2; ++k) \
        acc[ai][bj][m][n] = __builtin_amdgcn_mfma_f32_16x16x32_bf16(Bt[n][k], At[m][k], acc[ai][bj][m][n], 0, 0, 0); __builtin_amdgcn_s_setprio(0); } while (0)
#define PG8_WAIT_V(n) asm volatile("s_waitcnt vmcnt(" #n ")" ::: "memory")
#define PG8_WAIT_L(n) asm volatile("s_waitcnt lgkmcnt(" #n ")" ::: "memory")
#define PG8_BAR __builtin_amdgcn_s_barrier()
#define PG8_SCHED __builtin_amdgcn_sched_barrier(0)
    Unit cur, nxt; int ui = 0;
    if (!S.next(0, cur)) return;
    f32x4 acc[2][2][4][2];
#pragma unroll
    for (int a = 0; a < 2; ++a)
#pragma unroll
        for (int b = 0; b < 2; ++b)
#pragma unroll
            for (int m = 0; m < 4; ++m)
#pragma unroll
                for (int n = 0; n < 2; ++n) acc[a][b][m][n] = (f32x4){0.f, 0.f, 0.f, 0.f};
    bf16x8 At[4][2], B0[2][2], B1[2][2];
    const char* cA = S.baseA(cur); const char* cB = S.baseB(cur);
    if constexpr (SP2) {
        PG8_STAGE(PG8_SB(0, 0), cB, voffB); PG8_STAGE(PG8_SB(0, 1), cB + hstep, voffB); PG8_STAGE(PG8_SA(0, 0), cA, voffA); PG8_STAGE(PG8_SA(0, 1), cA + hstep, voffA);
        if (wr == 1) PG8_BAR;
        PG8_WAIT_V(2); PG8_BAR;
        PG8_STAGE(PG8_SB(1, 0), cB + kstep, voffB); PG8_STAGE(PG8_SA(1, 0), cA + kstep, voffA); PG8_STAGE(PG8_SB(1, 1), cB + hstep + kstep, voffB);
        PG8_WAIT_V(6); PG8_BAR;
    } else {
        PG8_STAGE(PG8_SB(0, 0), cB, voffB); PG8_STAGE(PG8_SA(0, 0), cA, voffA); PG8_STAGE(PG8_SB(0, 1), cB + hstep, voffB); PG8_STAGE(PG8_SA(0, 1), cA + hstep, voffA);
        if (wr == 1) PG8_BAR;
        PG8_WAIT_V(4); PG8_BAR;
        PG8_STAGE(PG8_SB(1, 0), cB + kstep, voffB); PG8_STAGE(PG8_SA(1, 0), cA + kstep, voffA); PG8_STAGE(PG8_SB(1, 1), cB + hstep + kstep, voffB);
        PG8_WAIT_V(6); PG8_BAR;
    }
    for (;;) {
        const bool has_next = S.next(ui + 1, nxt);
        const char* nA = has_next ? S.baseA(nxt) : cA; const char* nB = has_next ? S.baseB(nxt) : cB;
        for (int t = 0; t < nt; t += 2) {
            const bool last = (t == nt - 2);
            const char* a1 = cA + (size_t)(t + 1) * kstep;
            const char* a2 = last ? nA : cA + (size_t)(t + 2) * kstep; const char* b2 = last ? nB : cB + (size_t)(t + 2) * kstep;
            const char* a3 = a2 + kstep; const char* b3 = b2 + kstep;
            if constexpr (SP2) {
            PG8_LDB(B0, 0, 0); PG8_LDB(B1, 0, 1); PG8_SCHED; PG8_LDA(At, 0, 0); PG8_STAGE(PG8_SA(1, 1), a1 + hstep, voffA);
            PG8_WAIT_V(8); PG8_WAIT_L(0); PG8_BAR; PG8_MMA(0, 0, At, B0); PG8_MMA(0, 1, At, B1); PG8_BAR; PG8_SCHED;
            PG8_LDA(At, 0, 1); PG8_STAGE(PG8_SB(0, 0), b2, voffB); PG8_STAGE(PG8_SB(0, 1), b2 + hstep, voffB); PG8_STAGE(PG8_SA(0, 0), a2, voffA);
            PG8_WAIT_V(8); PG8_WAIT_L(0); PG8_BAR; PG8_MMA(1, 0, At, B0); PG8_MMA(1, 1, At, B1); PG8_BAR; PG8_SCHED;
            PG8_LDB(B0, 1, 0); PG8_LDB(B1, 1, 1); PG8_SCHED; PG8_LDA(At, 1, 0); PG8_STAGE(PG8_SA(0, 1), a2 + hstep, voffA);
            PG8_WAIT_V(8); PG8_WAIT_L(0); PG8_BAR; PG8_MMA(0, 0, At, B0); PG8_MMA(0, 1, At, B1); PG8_BAR; PG8_SCHED;
            PG8_LDA(At, 1, 1); PG8_STAGE(PG8_SB(1, 0), b3, voffB); PG8_STAGE(PG8_SB(1, 1), b3 + hstep, voffB); PG8_STAGE(PG8_SA(1, 0), a3, voffA);
            PG8_WAIT_V(8); PG8_WAIT_L(0); PG8_BAR; PG8_MMA(1, 0, At, B0); PG8_MMA(1, 1, At, B1); PG8_BAR; PG8_SCHED;
            } else {
            PG8_LDB(B0, 0, 0); PG8_SCHED; PG8_LDA(At, 0, 0); PG8_STAGE(PG8_SA(1, 1), a1 + hstep, voffA);
            PG8_WAIT_L(8); PG8_BAR; PG8_WAIT_L(0); PG8_MMA(0, 0, At, B0); PG8_BAR; PG8_SCHED;
            PG8_LDB(B1, 0, 1); PG8_STAGE(PG8_SB(0, 0), b2, voffB);
            PG8_BAR; PG8_WAIT_L(0); PG8_MMA(0, 1, At, B1); PG8_BAR;
            PG8_LDA(At, 0, 1); PG8_STAGE(PG8_SA(0, 0), a2, voffA);
            PG8_BAR; PG8_WAIT_L(0); PG8_MMA(1, 0, At, B0); PG8_BAR; PG8_SCHED;
            PG8_STAGE(PG8_SB(0, 1), b2 + hstep, voffB);
            PG8_WAIT_V(6); PG8_BAR; PG8_MMA(1, 1, At, B1); PG8_BAR;
            PG8_LDB(B0, 1, 0); PG8_SCHED; PG8_LDA(At, 1, 0); PG8_STAGE(PG8_SA(0, 1), a2 + hstep, voffA);
            PG8_WAIT_L(8); PG8_BAR; PG8_WAIT_L(0); PG8_MMA(0, 0, At, B0); PG8_BAR; PG8_SCHED;
            PG8_LDB(B1, 1, 1); PG8_STAGE(PG8_SB(1, 0), b3, voffB);
            PG8_BAR; PG8_WAIT_L(0); PG8_MMA(0, 1, At, B1); PG8_BAR;
            PG8_LDA(At, 1, 1); PG8_STAGE(PG8_SA(1, 0), a3, voffA);
            PG8_BAR; PG8_WAIT_L(0); PG8_MMA(1, 0, At, B0); PG8_BAR; PG8_SCHED;
            PG8_STAGE(PG8_SB(1, 1), b3 + hstep, voffB);
            PG8_WAIT_V(6); PG8_BAR; PG8_MMA(1, 1, At, B1); PG8_BAR;
            }
        }
        if constexpr (ALIGN_EPI) { if (wr == 0) PG8_BAR; }
        E(acc, cur, wr, wc, fr, fq);
        if (!has_next) break;
#pragma unroll
        for (int a = 0; a < 2; ++a)
#pragma unroll
            for (int b = 0; b < 2; ++b)
#pragma unroll
                for (int m = 0; m < 4; ++m)
#pragma unroll
                    for (int n = 0; n < 2; ++n) acc[a][b][m][n] = (f32x4){0.f, 0.f, 0.f, 0.f};
        cur = nxt; cA = nA; cB = nB; ++ui;
        if constexpr (ALIGN_EPI) { if (wr == 1) PG8_BAR; }
    }
    PG8_WAIT_V(0);
    if constexpr (!ALIGN_EPI) { if (wr == 0) PG8_BAR; }
    PG8_BAR;
#undef PG8_SA
#undef PG8_SB
#undef PG8_STAGE
#undef PG8_LDA
#undef PG8_LDB
#undef PG8_MMA
#undef PG8_WAIT_V
#undef PG8_WAIT_L
#undef PG8_BAR
#undef PG8_SCHED
}

struct EpiP1 {
    static constexpr bool PERM = true;
    bf16_t* U;
    __device__ __forceinline__ void operator()(const f32x4 (&acc)[2][2][4][2], const Unit& u, int wr, int wc, int fr, int fq) const {
        const int row0 = u.pm * BM + wr * 64 + fr;
        bf16_t* O = U + (size_t)(u.pn >> 3) * ((size_t)M * D);
        if (u.pn < 24) {
            const bool act = u.pn >= 8;
            const int col0 = (u.pn & 7) * 128 + wc * 32 + 8 * fq;
#pragma unroll
            for (int ai = 0; ai < 2; ++ai)
#pragma unroll
                for (int m = 0; m < 4; ++m) { bf16_t* rowp = O + (size_t)(row0 + ai * HALF + m * 16) * D + col0;
                    f32x4 a0 = acc[ai][0][m][0], a1 = acc[ai][0][m][1], b0 = acc[ai][1][m][0], b1 = acc[ai][1][m][1];
                    if (act) {
#pragma unroll
                        for (int j = 0; j < 4; ++j) { b0[j] = silu_f(b0[j]); b1[j] = silu_f(b1[j]); } }
                    a0 = a0 * b0; a1 = a1 * b1;
                    u32x4 w; w.x = cvt_pk_bf16(a0[0], a0[1]); w.y = cvt_pk_bf16(a0[2], a0[3]); w.z = cvt_pk_bf16(a1[0], a1[1]); w.w = cvt_pk_bf16(a1[2], a1[3]);
                    *(u32x4*)rowp = w; }
        } else {
            const int col0 = (u.pn - 24) * 256 + wc * 32 + 8 * fq;
#pragma unroll
            for (int ai = 0; ai < 2; ++ai)
#pragma unroll
                for (int m = 0; m < 4; ++m) { bf16_t* rowp = O + (size_t)(row0 + ai * HALF + m * 16) * D + col0;
#pragma unroll
                    for (int bj = 0; bj < 2; ++bj) { const f32x4 v0 = acc[ai][bj][m][0], v1 = acc[ai][bj][m][1];
                        u32x4 w; w.x = cvt_pk_bf16(v0[0], v0[1]); w.y = cvt_pk_bf16(v0[2], v0[3]); w.z = cvt_pk_bf16(v1[0], v1[1]); w.w = cvt_pk_bf16(v1[2], v1[3]);
                        *(u32x4*)(rowp + bj * HALF) = w; } }
        }
    }
};
struct EpiP5 {
    static constexpr bool PERM = true;
    bf16_t *Q, *VT; const float *qn, *kn;
    const float* ssq; const float* sw;
    __device__ __forceinline__ float rstd_of(int token, int part  ) const { const f32x4 p = *(const f32x4*)(ssq + (size_t)token * 16 + 4 * part); return (p[0] + p[1]) + (p[2] + p[3]); }
    __device__ __forceinline__ void operator()(const f32x4 (&acc)[2][2][4][2], const Unit& u, int wr, int wc, int fr, int fq) const {
        const int row0 = u.pm * BM + wr * 64 + fr;
        if (u.sel == 1) {
            const int col0 = u.pn * BM + wc * 32 + 8 * fq, bt = (u.pn * BM) / SEQ;
            float mine; { const int k = fr, tok = col0 + (k >> 3) * HALF + ((k >> 2) & 1) * 4 + (k & 3);
                const float t = (rstd_of(tok, 0) + rstd_of(tok, 1)) + (rstd_of(tok, 2) + rstd_of(tok, 3)); mine = __builtin_amdgcn_rsqf(t * (1.0f / D) + EPS); }
            f32x4 rs[2][2];
#pragma unroll
            for (int k = 0; k < 16; ++k) rs[k >> 3][(k >> 2) & 1][k & 3] = __shfl(mine, (fq << 4) | k);
#pragma unroll
            for (int ai = 0; ai < 2; ++ai)
#pragma unroll
                for (int m = 0; m < 4; ++m) { const int hd = row0 + ai * HALF + m * 16; const float swv = sw[bt * 4096 + 2048 + hd]; bf16_t* rowp = VT + (size_t)hd * M + col0;
#pragma unroll
                    for (int bj = 0; bj < 2; ++bj) { const f32x4 v0 = acc[ai][bj][m][0] * rs[bj][0] + swv, v1 = acc[ai][bj][m][1] * rs[bj][1] + swv;
                        u32x4 w; w.x = cvt_pk_bf16(v0[0], v0[1]); w.y = cvt_pk_bf16(v0[2], v0[3]); w.z = cvt_pk_bf16(v1[0], v1[1]); w.w = cvt_pk_bf16(v1[2], v1[3]);
                        *(u32x4*)(rowp + bj * HALF) = w; } }
            return;
        }
        const int bt = (u.pm * BM) / SEQ;
        float rs[2][4];
#pragma unroll
        for (int ai = 0; ai < 2; ++ai)
#pragma unroll
            for (int m = 0; m < 4; ++m) { float t = rstd_of(row0 + ai * HALF + m * 16, fq); t += __shfl_xor(t, 16); t += __shfl_xor(t, 32); rs[ai][m] = __builtin_amdgcn_rsqf(t * (1.0f / D) + EPS); }
        if (u.pn >= 8) {
            const int col0 = (u.pn - 8) * BM + wc * 32 + 8 * fq;
            f32x4 s4[2][2];
#pragma unroll
            for (int bj = 0; bj < 2; ++bj)
#pragma unroll
                for (int n = 0; n < 2; ++n) s4[bj][n] = *(const f32x4*)(sw + bt * 4096 + 3072 + col0 + bj * HALF + 4 * n);
#pragma unroll
            for (int ai = 0; ai < 2; ++ai)
#pragma unroll
                for (int m = 0; m < 4; ++m) { bf16_t* rowp = Q + 2 * (size_t)M * D + (size_t)(row0 + ai * HALF + m * 16) * D + col0;
#pragma unroll
                    for (int bj = 0; bj < 2; ++bj) { f32x4 v0 = acc[ai][bj][m][0] * rs[ai][m] + s4[bj][0], v1 = acc[ai][bj][m][1] * rs[ai][m] + s4[bj][1];
#pragma unroll
                        for (int j = 0; j < 4; ++j) { v0[j] = silu_f(v0[j]); v1[j] = silu_f(v1[j]); }
                        u32x4 w; w.x = cvt_pk_bf16(v0[0], v0[1]); w.y = cvt_pk_bf16(v0[2], v0[3]); w.z = cvt_pk_bf16(v1[0], v1[1]); w.w = cvt_pk_bf16(v1[2], v1[3]);
                        *(u32x4*)(rowp + bj * HALF) = w; } }
        } else {
            const bool isq = u.pn < 4; bf16_t* O = Q + (size_t)(u.pn >> 2) * ((size_t)M * D); const float* nw = qn; if (!isq) nw = kn; const float sc = isq ? (LOG2E * 0.125f) : 1.0f;
            const int col0 = (u.pn & 3) * BM + 64 * wc + 8 * fq;
            f32x4 w4[2][2], s4[2][2];
#pragma unroll
            for (int bj = 0; bj < 2; ++bj)
#pragma unroll
                for (int n = 0; n < 2; ++n) { w4[bj][n] = *(const f32x4*)(nw + 32 * bj + 8 * fq + 4 * n); s4[bj][n] = *(const f32x4*)(sw + bt * 4096 + (u.pn >> 2) * 1024 + col0 + 32 * bj + 4 * n); }
#pragma unroll
            for (int ai = 0; ai < 2; ++ai)
#pragma unroll
                for (int m = 0; m < 4; ++m) {
                    f32x4 v[2][2]; float ss = 0.f;
#pragma unroll
                    for (int bj = 0; bj < 2; ++bj)
#pragma unroll
                        for (int n = 0; n < 2; ++n) { v[bj][n] = acc[ai][bj][m][n] * rs[ai][m] + s4[bj][n]; const f32x4 t = v[bj][n]; ss += (t[0] * t[0] + t[1] * t[1]) + (t[2] * t[2] + t[3] * t[3]); }
                    ss += __shfl_xor(ss, 16); ss += __shfl_xor(ss, 32);
                    const float rq = __builtin_amdgcn_rsqf(ss * (1.0f / 64.0f) + EPS) * sc;
                    bf16_t* rowp = O + (size_t)(row0 + ai * HALF + m * 16) * D + col0;
#pragma unroll
                    for (int bj = 0; bj < 2; ++bj) { const f32x4 v0 = v[bj][0] * rq * w4[bj][0], v1 = v[bj][1] * rq * w4[bj][1];
                        u32x4 w; w.x = cvt_pk_bf16(v0[0], v0[1]); w.y = cvt_pk_bf16(v0[2], v0[3]); w.z = cvt_pk_bf16(v1[0], v1[1]); w.w = cvt_pk_bf16(v1[2], v1[3]);
                        *(u32x4*)(rowp + 32 * bj) = w; } }
        }
    }
};
template <bool STATS> struct EpiRes {
    static constexpr bool PERM = true;
    const void* base; void* out; const float* gate; const float* lng; const float* scale; bf16_t* xm; float* ssq;
    __device__ __forceinline__ void operator()(const f32x4 (&acc)[2][2][4][2], const Unit& u, int wr, int wc, int fr, int fq) const {
        const int row0 = u.pm * BM + wr * 64 + fr, col0 = u.pn * BM + wc * 32 + 8 * fq, bt = (u.pm * BM) / SEQ;
        f32x4 gv[2][2], mv[2][2];
#pragma unroll
        for (int bj = 0; bj < 2; ++bj)
#pragma unroll
            for (int n = 0; n < 2; ++n) { gv[bj][n] = *(const f32x4*)(gate + bt * 3072 + col0 + bj * HALF + 4 * n);
                if (STATS) mv[bj][n] = *(const f32x4*)(lng + col0 + bj * HALF + 4 * n) * (*(const f32x4*)(scale + bt * 3072 + col0 + bj * HALF + 4 * n) + 1.0f); }
        constexpr int MB = STATS ? 2 : 4;
#pragma unroll
        for (int ai = 0; ai < 2; ++ai)
#pragma unroll
        for (int mb = 0; mb < 4; mb += MB) {
            f32x4 bf[MB][2][2]; u32x4 bh[MB][2];
#pragma unroll
            for (int mm = 0; mm < MB; ++mm) { const size_t off = (size_t)(row0 + ai * HALF + (mb + mm) * 16) * D + col0;
#pragma unroll
                for (int bj = 0; bj < 2; ++bj) {
                    if (STATS) { bf[mm][bj][0] = *(const f32x4*)((const float*)base + off + bj * HALF); bf[mm][bj][1] = *(const f32x4*)((const float*)base + off + bj * HALF + 4); }
                    else bh[mm][bj] = *(const u32x4*)((const bf16_t*)base + off + bj * HALF); } }
#pragma unroll
            for (int mm = 0; mm < MB; ++mm) { const int m = mb + mm; const int row = row0 + ai * HALF + m * 16; const size_t off = (size_t)row * D + col0; float ss = 0.f;
#pragma unroll
                for (int bj = 0; bj < 2; ++bj) { f32x4 b0, b1;
                    if (STATS) { b0 = bf[mm][bj][0]; b1 = bf[mm][bj][1]; }
                    else { const u32x4 t = bh[mm][bj]; b0 = (f32x4){bf_lo(t.x), bf_hi(t.x), bf_lo(t.y), bf_hi(t.y)}; b1 = (f32x4){bf_lo(t.z), bf_hi(t.z), bf_lo(t.w), bf_hi(t.w)}; }
                    const f32x4 o0 = b0 + gv[bj][0] * acc[ai][bj][m][0], o1 = b1 + gv[bj][1] * acc[ai][bj][m][1];
                    if (STATS) { u32x4 w; w.x = cvt_pk_bf16(o0[0], o0[1]); w.y = cvt_pk_bf16(o0[2], o0[3]); w.z = cvt_pk_bf16(o1[0], o1[1]); w.w = cvt_pk_bf16(o1[2], o1[3]);
                        *(u32x4*)((bf16_t*)out + off + bj * HALF) = w;
                        ss += (o0[0] * o0[0] + o0[1] * o0[1]) + (o0[2] * o0[2] + o0[3] * o0[3]) + (o1[0] * o1[0] + o1[1] * o1[1]) + (o1[2] * o1[2] + o1[3] * o1[3]);
                        const f32x4 x0 = o0 * mv[bj][0], x1 = o1 * mv[bj][1];
                        u32x4 w2; w2.x = cvt_pk_bf16(x0[0], x0[1]); w2.y = cvt_pk_bf16(x0[2], x0[3]); w2.z = cvt_pk_bf16(x1[0], x1[1]); w2.w = cvt_pk_bf16(x1[2], x1[3]);
                        *(u32x4*)(xm + off + bj * HALF) = w2; }
                    else { *(f32x4*)((float*)out + off + bj * HALF) = o0; *(f32x4*)((float*)out + off + bj * HALF + 4) = o1; } }
                if (STATS) { ss += __shfl_xor(ss, 16); ss += __shfl_xor(ss, 32); if (fq == 0) ssq[(size_t)row * 16 + u.pn * 4 + wc] = ss; } }
        }
    }
};
}

#define XB_TMO      128
#define XB_XCNT(j)  (256  + 64 * (j))
#define XB_XSUB(j)  (1280 + 64 * (j))
#define XB_XGEN(j)  (2304 + 64 * (j))
#define XB_TOP      3328
#define XB_TOPGEN   3392
#define XCD_BAR_WORDS 3456
#define XB_SPIN_CAP (1u << 18)
__device__ __forceinline__ unsigned xb_ld(unsigned* p)              { return __hip_atomic_load(p, __ATOMIC_RELAXED, __HIP_MEMORY_SCOPE_AGENT); }
__device__ __forceinline__ unsigned xb_add(unsigned* p, unsigned v) { return __hip_atomic_fetch_add(p, v, __ATOMIC_RELAXED, __HIP_MEMORY_SCOPE_AGENT); }
__device__ __forceinline__ unsigned xb_xcc_id() { return (unsigned)__builtin_amdgcn_s_getreg((3 << 11) | 20) & 0xFu; }
#define XB_SPIN(cond, bar) do { unsigned _sp = 0; while (cond) { __builtin_amdgcn_s_sleep(1); \
    if ((++_sp & 255u) == 0u) { if (xb_ld(&(bar)[XB_TMO])) break; if (_sp > XB_SPIN_CAP) { atomicAdd(&(bar)[XB_TMO], 1u); break; } } } } while (0)
struct XcdBarrier { unsigned* bar; unsigned x; volatile LAS unsigned* st; };
__device__ __forceinline__ XcdBarrier xcd_barrier_post(unsigned* bar, volatile LAS unsigned* st) {
    XcdBarrier b; b.bar = bar; b.x = xb_xcc_id(); b.st = st;
    if (threadIdx.x == 0) (void)xb_add(&bar[XB_XCNT(b.x)], 1u);
    return b;
}
__device__ __forceinline__ void xcd_barrier_complete(unsigned* bar, unsigned x, unsigned& nloc, unsigned& nx) {
    const unsigned G = gridDim.x * gridDim.y * gridDim.z;
    unsigned sum, cnt, mine, sp = 0u;
    for (;;) {
        sum = 0u; cnt = 0u; mine = 0u;
#pragma unroll
        for (unsigned j = 0; j < 16; ++j) { const unsigned c = xb_ld(&bar[XB_XCNT(j)]); sum += c; cnt += (c > 0u) ? 1u : 0u; mine = (j == x) ? c : mine; }
        if (sum == G) break;
        __builtin_amdgcn_s_sleep(1);
        if ((++sp & 255u) == 0u) { if (xb_ld(&bar[XB_TMO])) break; if (sp > XB_SPIN_CAP) { atomicAdd(&bar[XB_TMO], 1u); break; } }
    }
    nloc = mine > 0u ? mine : 1u; nx = cnt > 0u ? cnt : 1u;
}
__device__ __forceinline__ void xcd_barrier(const XcdBarrier& b) {
    asm volatile("s_waitcnt vmcnt(0)" ::: "memory");
    __syncthreads();
    if (threadIdx.x == 0) {
        unsigned* bar = b.bar;
        __builtin_amdgcn_s_waitcnt(0);
        unsigned nloc = b.st[0], nx = b.st[1];
        if (nloc == 0u) { xcd_barrier_complete(bar, b.x, nloc, nx); b.st[0] = nloc; b.st[1] = nx; }
        const unsigned old = xb_add(&bar[XB_XSUB(b.x)], 1u);
        const unsigned gen = old / nloc;
        if (old + 1u == (gen + 1u) * nloc) {
            __builtin_amdgcn_fence(__ATOMIC_RELEASE, "agent");
            asm volatile("s_waitcnt vmcnt(0)" ::: "memory");
            const unsigned og = xb_add(&bar[XB_TOP], 1u);
            const unsigned tg = og / nx;
            if (og + 1u == (tg + 1u) * nx) xb_add(&bar[XB_TOPGEN], 1u);
            else XB_SPIN(xb_ld(&bar[XB_TOPGEN]) == tg, bar);
            __builtin_amdgcn_fence(__ATOMIC_ACQUIRE, "agent");
            xb_add(&bar[XB_XGEN(b.x)], 1u);
            asm volatile("s_waitcnt vmcnt(0)" ::: "memory");
        } else {
            XB_SPIN(xb_ld(&bar[XB_XGEN(b.x)]) <= gen, bar);
            __builtin_amdgcn_fence(__ATOMIC_ACQUIRE, "agent");
            asm volatile("s_waitcnt vmcnt(0)" ::: "memory");
        }
    }
    __syncthreads();
}

__device__ __forceinline__ void xcd_barrier_arrive(const XcdBarrier& b) {
    asm volatile("s_waitcnt vmcnt(0)" ::: "memory");
    __syncthreads();
    if (threadIdx.x == 0) {
        unsigned* bar = b.bar;
        __builtin_amdgcn_s_waitcnt(0);
        unsigned nloc = b.st[0], nx = b.st[1];
        if (nloc == 0u) { xcd_barrier_complete(bar, b.x, nloc, nx); b.st[0] = nloc; b.st[1] = nx; }
        const unsigned old = xb_add(&bar[XB_XSUB(b.x)], 1u);
        const unsigned gen = old / nloc;
        unsigned lead = 0u;
        if (old + 1u == (gen + 1u) * nloc) {
            lead = 1u;
            __builtin_amdgcn_fence(__ATOMIC_RELEASE, "agent");
            asm volatile("s_waitcnt vmcnt(0)" ::: "memory");
            const unsigned og = xb_add(&bar[XB_TOP], 1u);
            const unsigned tg = og / nx;
            if (og + 1u == (tg + 1u) * nx) xb_add(&bar[XB_TOPGEN], 1u);
        }
        b.st[2] = lead;
    }
}
__device__ __forceinline__ void xcd_barrier_wait(const XcdBarrier& b, unsigned k) {
    asm volatile("s_waitcnt vmcnt(0)" ::: "memory");
    __syncthreads();
    if (threadIdx.x == 0) {
        unsigned* bar = b.bar;
        XB_SPIN(xb_ld(&bar[XB_TOPGEN]) <= k, bar);
        __builtin_amdgcn_fence(__ATOMIC_ACQUIRE, "agent");
        if (b.st[2]) xb_add(&bar[XB_XGEN(b.x)], 1u);
        asm volatile("s_waitcnt vmcnt(0)" ::: "memory");
    }
    __syncthreads();
}

struct Args {
    const float *x, *c, *ln_g, *ada_w, *ada_b, *w_in_ab, *conv_w, *sg_norm, *sg_w, *sg_b, *w_out_ab, *w_in_c, *q_norm, *k_norm, *w_out_c;
    float* out; unsigned char* ws; int ph_lo, ph_hi;
};

__device__ __forceinline__ int ab_row(int c) {
    const int seg = c >> 10, cc = c & 1023, t = cc >> 7, r = cc & 127;
    switch (seg) {
        case 1: return 256 * t + r;
        case 2: return 256 * t + 128 + r;
        case 0: return 256 * (8 + t) + r;
        case 3: return 256 * (8 + t) + 128 + r;
        case 4: return 256 * (16 + t) + r;
        case 6: return 256 * (16 + t) + 128 + r;
        default: return 256 * 24 + cc;
    }
}
__device__ __forceinline__ int c_row(int c) {
    const int seg = c >> 10, cc = c & 1023;
    if (seg == 2) return 3072 + cc;
    if (seg == 3) return 2048 + cc;
    const int tile = cc >> 8, ct = cc & 255, hh = ct >> 6, bj = (ct >> 5) & 1, i = ct & 31;
    return seg * 1024 + tile * 256 + 128 * bj + 32 * hh + i;
}
template <int MODE>
__device__ __forceinline__ void p0_transpose_item(const float* W, int K, int N, bf16_t* WT, LAS float* scr, int item, int lane) {
    const int nblk = N / 32, kb = item / nblk, nb = item % nblk, k0 = 64 * kb, n0 = 32 * nb;
    const int rb = MODE == 1 ? ab_row(n0) : (MODE == 2 ? c_row(n0) : n0);
#pragma unroll 8
    for (int i = 0; i < 32; ++i) { const int kk = 2 * i + (lane >> 5); scr[kk * 33 + (lane & 31)] = W[(size_t)(k0 + kk) * N + n0 + (lane & 31)]; }
    asm volatile("s_waitcnt lgkmcnt(0)" ::: "memory");
    const int c = lane & 7;
#pragma unroll
    for (int j = 0; j < 4; ++j) { const int n = (lane >> 3) + 8 * j; const LAS float* s = scr + (8 * c) * 33 + n;
        u32x4 o; o.x = cvt_pk_bf16(s[0 * 33], s[1 * 33]); o.y = cvt_pk_bf16(s[2 * 33], s[3 * 33]); o.z = cvt_pk_bf16(s[4 * 33], s[5 * 33]); o.w = cvt_pk_bf16(s[6 * 33], s[7 * 33]);
        *(u32x4*)(WT + (size_t)(rb + n) * K + k0 + 8 * c) = o; }
    asm volatile("s_waitcnt lgkmcnt(0)" ::: "memory");
}

__device__ __forceinline__ float wave_sum(float v) {
#pragma unroll
    for (int o = 1; o < 64; o <<= 1) v += __shfl_xor(v, o);
    return v;
}
__device__ __forceinline__ void rms_phase(const float* X, const float* g, const float* mod  , bf16_t* H, int gw, int NGW, int lane) {
    for (int b = 0; b < BATCH; ++b) {
        f32x4 mul[4], sh[4];
#pragma unroll
        for (int j = 0; j < 4; ++j) { const int col = 4 * lane + 256 * j; const f32x4 gg = *(const f32x4*)(g + col), sc = *(const f32x4*)(mod + b * 3072 + 1024 + col);
            sh[j] = *(const f32x4*)(mod + b * 3072 + col); mul[j] = gg * (sc + 1.0f); }
#pragma unroll 4
        for (int r = gw; r < SEQ; r += NGW) {
            const size_t m = (size_t)b * SEQ + r;
            const f32x4* xr = (const f32x4*)(X + m * D) + lane;
            f32x4 v[4]; float s = 0.f;
#pragma unroll
            for (int j = 0; j < 4; ++j) { v[j] = xr[64 * j]; s += (v[j].x * v[j].x + v[j].y * v[j].y) + (v[j].z * v[j].z + v[j].w * v[j].w); }
            const float rstd = __builtin_amdgcn_rsqf(wave_sum(s) * (1.f / D) + EPS);
            u32x2* o8 = (u32x2*)(H + m * D) + lane;
#pragma unroll
            for (int j = 0; j < 4; ++j) { const f32x4 o = v[j] * rstd * mul[j] + sh[j]; u32x2 w; w.x = cvt_pk_bf16(o.x, o.y); w.y = cvt_pk_bf16(o.z, o.w); o8[64 * j] = w; }
        }
    }
}

__device__ __forceinline__ void mixer_phase(LAS unsigned char* lds, const bf16_t* U, const bf16_t* Gt, const bf16_t* UZ, const bf16_t* V, const float* conv_w, const float* sg_norm,
                                            const bf16_t* WTR, const float* sg_b, bf16_t* Y, int vcu, int G) {
    const int tid = threadIdx.x, lane = tid & 63, w = __builtin_amdgcn_readfirstlane(tid >> 6), fr = lane & 15, fq = lane >> 4;
    constexpr int PT = 136;
    LAS bf16_t* VNT = (LAS bf16_t*)lds;
    LAS bf16_t* WL = (LAS bf16_t*)(lds + 128 * PT * 2);
    LAS float* SG = (LAS float*)(lds + 2 * 128 * PT * 2);
    int g_staged = -1;
    const int c8 = tid & 15, rg = tid >> 4;
    const int s = tid >> 2, qd = tid & 3;
    for (int unit = vcu; unit < BATCH * 64 * 8; unit += G) {
        const int g = unit & 7, cch = (unit >> 3) & 63, b = unit >> 9; const size_t r0 = (size_t)b * SEQ + cch * 128;
        const int ch = 128 * g + 8 * c8; const size_t row = r0 + 4 * rg;
        u32x4 ur[6], gv[4], vv[4], uz[4];
        const bool halo0 = (cch == 0 && rg == 0);
#pragma unroll
        for (int i = 0; i < 4; ++i) vv[i] = *(const u32x4*)(V + (r0 + s) * D + 128 * g + 32 * qd + 8 * i);
#pragma unroll
        for (int i = 0; i < 6; ++i) { if (i < 2 && halo0) ur[i] = (u32x4){0u, 0u, 0u, 0u}; else ur[i] = *(const u32x4*)(U + (row + i - 2) * D + ch); }
#pragma unroll
        for (int i = 0; i < 4; ++i) gv[i] = *(const u32x4*)(Gt + (row + i) * D + ch);
#pragma unroll
        for (int i = 0; i < 4; ++i) uz[i] = *(const u32x4*)(UZ + (r0 + s) * D + 128 * g + 32 * qd + 8 * i);
        if (g != g_staged) {
            __syncthreads();
            const bf16_t* wp = WTR + ((size_t)g * 128 + s) * 128 + 32 * qd;
#pragma unroll
            for (int i = 0; i < 4; ++i) *(LAS u32x4*)(WL + s * PT + 32 * qd + 8 * i) = *(const u32x4*)(wp + 8 * i);
            g_staged = g;
        }
        { float v[32]; float ss = 0.f;
#pragma unroll
          for (int i = 0; i < 4; ++i)
#pragma unroll
              for (int p = 0; p < 4; ++p) { v[8 * i + 2 * p] = bf_lo(vv[i][p]); v[8 * i + 2 * p + 1] = bf_hi(vv[i][p]); }
#pragma unroll
          for (int i = 0; i < 32; ++i) ss += v[i] * v[i];
          ss += __shfl_xor(ss, 1); ss += __shfl_xor(ss, 2);
          const float rs = __builtin_amdgcn_rsqf(ss * (1.0f / 128.0f) + EPS);
          const float* nw = sg_norm + g * 128 + 32 * qd;
#pragma unroll
          for (int i = 0; i < 32; i += 2) { const unsigned pk = cvt_pk_bf16(v[i] * rs * nw[i], v[i + 1] * rs * nw[i + 1]);
              VNT[(32 * qd + i) * PT + s] = (bf16_t)(pk & 0xffffu); VNT[(32 * qd + i + 1) * PT + s] = (bf16_t)(pk >> 16); }
        }
        { float cw[3][8];
#pragma unroll
          for (int k = 0; k < 3; ++k) { const f32x4 a = *(const f32x4*)(conv_w + k * D + ch), bq = *(const f32x4*)(conv_w + k * D + ch + 4);
              cw[k][0] = a.x; cw[k][1] = a.y; cw[k][2] = a.z; cw[k][3] = a.w; cw[k][4] = bq.x; cw[k][5] = bq.y; cw[k][6] = bq.z; cw[k][7] = bq.w; }
#pragma unroll
          for (int i = 0; i < 4; ++i) { float o[8];
#pragma unroll
              for (int p = 0; p < 4; ++p) { const unsigned u0 = ur[i][p], u1 = ur[i + 1][p], u2 = ur[i + 2][p];
                  o[2 * p] = bf_lo(gv[i][p]) * (cw[0][2 * p] * bf_lo(u0) + cw[1][2 * p] * bf_lo(u1) + cw[2][2 * p] * bf_lo(u2));
                  o[2 * p + 1] = bf_hi(gv[i][p]) * (cw[0][2 * p + 1] * bf_hi(u0) + cw[1][2 * p + 1] * bf_hi(u1) + cw[2][2 * p + 1] * bf_hi(u2)); }
              u32x4 wv; wv.x = cvt_pk_bf16(o[0], o[1]); wv.y = cvt_pk_bf16(o[2], o[3]); wv.z = cvt_pk_bf16(o[4], o[5]); wv.w = cvt_pk_bf16(o[6], o[7]);
              *(u32x4*)(Y + (row + i) * 2048 + ch) = wv; }
        }
        __syncthreads();
        f32x4 acc[8];
#pragma unroll
        for (int tt = 0; tt < 8; ++tt) acc[tt] = (f32x4){0.f, 0.f, 0.f, 0.f};
#pragma unroll
        for (int ks = 0; ks < 4; ++ks) { const bf16x8 a = *(const LAS bf16x8*)(VNT + (16 * w + fr) * PT + 32 * ks + 8 * fq);
#pragma unroll
            for (int tt = 2 * ks; tt < 8; ++tt) { const bf16x8 bw = *(const LAS bf16x8*)(WL + (16 * tt + fr) * PT + 32 * ks + 8 * fq);
                acc[tt] = __builtin_amdgcn_mfma_f32_16x16x32_bf16(a, bw, acc[tt], 0, 0, 0); } }
#pragma unroll
        for (int tt = 0; tt < 8; ++tt) { const int t = 16 * tt + fr; const float bb = sg_b[g * 128 + t];
            *(LAS f32x4*)(SG + t * 132 + 16 * w + 4 * fq) = acc[tt] + bb; }
        __syncthreads();
        { bf16_t* yp = Y + (r0 + s) * 2048 + 1024 + 128 * g + 32 * qd;
#pragma unroll
          for (int i = 0; i < 4; ++i) { const f32x4 s0 = *(const LAS f32x4*)(SG + s * 132 + 32 * qd + 8 * i), s1 = *(const LAS f32x4*)(SG + s * 132 + 32 * qd + 8 * i + 4);
              u32x4 wv; wv.x = cvt_pk_bf16(bf_lo(uz[i].x) * s0.x, bf_hi(uz[i].x) * s0.y); wv.y = cvt_pk_bf16(bf_lo(uz[i].y) * s0.z, bf_hi(uz[i].y) * s0.w);
              wv.z = cvt_pk_bf16(bf_lo(uz[i].z) * s1.x, bf_hi(uz[i].z) * s1.y); wv.w = cvt_pk_bf16(bf_lo(uz[i].w) * s1.z, bf_hi(uz[i].w) * s1.w);
              *(u32x4*)(yp + 8 * i) = wv; }
        }
    }
    __syncthreads();
}

__device__ __forceinline__ int crow(int i, int hi) { return (i & 3) + 8 * (i >> 2) + 4 * hi; }
__device__ __forceinline__ void attn_load_k(bf16x8 (&kf)[4], bool in_lds, LAS unsigned char* KL, int kl0, const bf16_t* kg, int ql, int hi) {
    if (in_lds) { const int r = kl0 + ql; LAS unsigned char* rp = KL + r * 128; const int sw = (r >> 1) & 7;
#pragma unroll
        for (int kk = 0; kk < 4; ++kk) kf[kk] = *(const LAS bf16x8*)(rp + (((2 * kk + hi) ^ sw) << 4));
    } else {
#pragma unroll
        for (int kk = 0; kk < 4; ++kk) kf[kk] = *(const bf16x8*)(kg + 16 * kk);
    }
}
__device__ __forceinline__ void attn_phase(LAS unsigned char* lds, const bf16_t* Q, const bf16_t* Kb, const bf16_t* VT, const bf16_t* Zs, bf16_t* OZ, int vcu, int G) {
    const int tid = threadIdx.x, lane = tid & 63, w = __builtin_amdgcn_readfirstlane(tid >> 6), ql = lane & 31, hi = lane >> 5;
    constexpr float STOP = 5.421010862427522e-20f;
    LAS unsigned char* KL = lds;
    LAS unsigned char* VL = lds + 49152;
    constexpr int NU = BATCH * 16 * (SEQ / 256);
    u32x4 sk[6], sv[6];
#define ATT_DECODE(u_, h_, rb_, q0b_, kw0_) const int h_ = ((u_) >> 5) & 15; const size_t rb_ = (size_t)((u_) >> 9) * SEQ; const int q0b_ = 256 * ((u_) & 31), kw0_ = q0b_ >= 128 ? q0b_ - 128 : 0;
#define ATT_LOAD_STAGE(u_) do { ATT_DECODE(u_, h__, rb__, q0b__, kw0__) \
        _Pragma("unroll") for (int i = 0; i < 6; ++i) { const int idx = tid + NTHR * i, r = idx >> 3, c = idx & 7; sk[i] = *(const u32x4*)(Kb + (rb__ + kw0__ + r) * D + h__ * 64 + 8 * c); } \
        _Pragma("unroll") for (int i = 0; i < 6; ++i) { const int idx = tid + NTHR * i, d = idx / 48, ch = idx % 48; sv[i] = *(const u32x4*)(VT + (size_t)(h__ * 64 + d) * M + rb__ + kw0__ + 8 * ch); } } while (0)
    if (vcu < NU) ATT_LOAD_STAGE(vcu);
    for (int unit = vcu; unit < NU; unit += G) {
        ATT_DECODE(unit, h, rowbase, q0b, kw0)
        const int qblk = unit & 31;
        const int qb = 8 * qblk + w, q0 = 32 * qb;
        bf16x8 qf[4];
        { const bf16_t* qp = Q + (rowbase + q0 + ql) * D + h * 64 + 8 * hi;
#pragma unroll
          for (int kk = 0; kk < 4; ++kk) qf[kk] = *(const bf16x8*)(qp + 16 * kk); }
        u32x2 zz[8];
        { const bf16_t* zp = Zs + (rowbase + q0 + ql) * D + h * 64 + 4 * hi;
#pragma unroll
          for (int g4 = 0; g4 < 4; ++g4) { zz[g4] = *(const u32x2*)(zp + 8 * g4); zz[4 + g4] = *(const u32x2*)(zp + 32 + 8 * g4); } }
        asm volatile("" ::: "memory");
#pragma unroll
        for (int i = 0; i < 6; ++i) { const int idx = tid + NTHR * i, r = idx >> 3, c = idx & 7;
            *(LAS u32x4*)(KL + r * 128 + ((c ^ ((r >> 1) & 7)) << 4)) = sk[i]; }
#pragma unroll
        for (int i = 0; i < 6; ++i) { const int idx = tid + NTHR * i, d = idx / 48, ch = idx % 48;
            { u32x4 v = sv[i]; const int gp = (2 * ch) ^ (d & 31);
                if (d & 1) { const u32x4 t = v; v.x = t.z; v.y = t.w; v.z = t.x; v.w = t.y; }
                *(LAS u32x4*)(VL + d * 768 + ((gp & ~1) << 3)) = v; } }
        __syncthreads();
        { const int nu_ = unit + G < NU ? unit + G : unit; ATT_LOAD_STAGE(nu_); }
        f32x16 o0, o1;
#pragma unroll
        for (int i = 0; i < 16; ++i) { o0[i] = 0.f; o1[i] = 0.f; }
        float carry = 1.f;
#define ATT_TILE(IN_LDS_) { const int key0 = 32 * kt; \
            u32x2 vf[2][2][2]; \
            if (IN_LDS_) { const int g0 = ((key0 - kw0) >> 2) + hi; \
_Pragma("unroll") \
                for (int dh = 0; dh < 2; ++dh) { LAS unsigned char* rp = VL + (32 * dh + ql) * 768; \
_Pragma("unroll") \
                    for (int s = 0; s < 2; ++s) { vf[dh][s][0] = *(const LAS u32x2*)(rp + (((g0 + 4 * s) ^ ql) << 3)); vf[dh][s][1] = *(const LAS u32x2*)(rp + (((g0 + 4 * s + 2) ^ ql) << 3)); } } \
            } else { const bf16_t* vp = VT + (size_t)(h * 64 + ql) * M + rowbase + key0 + 4 * hi; \
_Pragma("unroll") \
                for (int dh = 0; dh < 2; ++dh) \
_Pragma("unroll") \
                    for (int s = 0; s < 2; ++s) { vf[dh][s][0] = *(const u32x2*)(vp + (size_t)dh * 32 * M + 16 * s); vf[dh][s][1] = *(const u32x2*)(vp + (size_t)dh * 32 * M + 16 * s + 8); } } \
            bf16x8 kf[4]; \
            attn_load_k(kf, IN_LDS_, KL, key0 - kw0, Kb + (rowbase + key0 + ql) * D + h * 64 + 8 * hi, ql, hi); \
            f32x16 S; \
_Pragma("unroll") \
            for (int i = 0; i < 16; ++i) S[i] = 0.f; \
_Pragma("unroll") \
            for (int kk = 0; kk < 4; ++kk) S = __builtin_amdgcn_mfma_f32_32x32x16_bf16(kf[kk], qf[kk], S, 0, 0, 0); \
            float be[16], om[16]; \
            const bool diag = (kt == qb); \
_Pragma("unroll") \
            for (int i = 0; i < 16; ++i) { const float zc = __builtin_fmaxf(S[i], -126.0f); const float E = fast_exp2(-zc); float bv = fast_rcp(1.0f + E); float ov = E * bv; \
                if (diag) { const bool valid = crow(i, hi) < ql; bv = valid ? bv : 0.f; ov = valid ? ov : 1.f; } \
                be[i] = bv; om[i] = ov; } \
            float gs[4], pg[4]; \
_Pragma("unroll") \
            for (int gi = 0; gi < 4; ++gi) { gs[gi] = (om[4 * gi] * om[4 * gi + 1]) * (om[4 * gi + 2] * om[4 * gi + 3]); pg[gi] = __shfl_xor(gs[gi], 32); } \
            float run = carry; float wv[16]; \
_Pragma("unroll") \
            for (int gi = 3; gi >= 0; --gi) { const float base = hi == 0 ? run * pg[gi] : run; \
                const float s3 = base, s2 = s3 * om[4 * gi + 3], s1 = s2 * om[4 * gi + 2], s0 = s1 * om[4 * gi + 1]; \
                wv[4 * gi + 3] = be[4 * gi + 3] * s3; wv[4 * gi + 2] = be[4 * gi + 2] * s2; wv[4 * gi + 1] = be[4 * gi + 1] * s1; wv[4 * gi] = be[4 * gi] * s0; \
                run *= gs[gi] * pg[gi]; } \
            carry = run; \
_Pragma("unroll") \
            for (int s = 0; s < 2; ++s) { u32x4 pk; pk.x = cvt_pk_bf16(wv[8 * s], wv[8 * s + 1]); pk.y = cvt_pk_bf16(wv[8 * s + 2], wv[8 * s + 3]); pk.z = cvt_pk_bf16(wv[8 * s + 4], wv[8 * s + 5]); pk.w = cvt_pk_bf16(wv[8 * s + 6], wv[8 * s + 7]); \
                const bf16x8 pf = __builtin_bit_cast(bf16x8, pk); \
                { u32x4 a; a.x = vf[0][s][0].x; a.y = vf[0][s][0].y; a.z = vf[0][s][1].x; a.w = vf[0][s][1].y; o0 = __builtin_amdgcn_mfma_f32_32x32x16_bf16(__builtin_bit_cast(bf16x8, a), pf, o0, 0, 0, 0); } \
                { u32x4 a; a.x = vf[1][s][0].x; a.y = vf[1][s][0].y; a.z = vf[1][s][1].x; a.w = vf[1][s][1].y; o1 = __builtin_amdgcn_mfma_f32_32x32x16_bf16(__builtin_bit_cast(bf16x8, a), pf, o1, 0, 0, 0); } } }
        int kt = qb; bool done = false;
        for (; kt >= 0 && 32 * kt >= kw0; --kt) {
            ATT_TILE(true)
            if (__all(carry < STOP)) { done = true; break; }
        }
        if (!done) for (; kt >= 0; --kt) {
            ATT_TILE(false)
            if (__all(carry < STOP)) break;
        }
#undef ATT_TILE
        bf16_t* op = OZ + (rowbase + q0 + ql) * D + h * 64 + 4 * hi;
#pragma unroll
        for (int g4 = 0; g4 < 4; ++g4) {
            { const u32x2 z2 = zz[g4]; u32x2 wo; wo.x = cvt_pk_bf16(o0[4 * g4] * bf_lo(z2.x), o0[4 * g4 + 1] * bf_hi(z2.x)); wo.y = cvt_pk_bf16(o0[4 * g4 + 2] * bf_lo(z2.y), o0[4 * g4 + 3] * bf_hi(z2.y)); *(u32x2*)(op + 8 * g4) = wo; }
            { const u32x2 z2 = zz[4 + g4]; u32x2 wo; wo.x = cvt_pk_bf16(o1[4 * g4] * bf_lo(z2.x), o1[4 * g4 + 1] * bf_hi(z2.x)); wo.y = cvt_pk_bf16(o1[4 * g4 + 2] * bf_lo(z2.y), o1[4 * g4 + 3] * bf_hi(z2.y)); *(u32x2*)(op + 32 + 8 * g4) = wo; }
        }
        __syncthreads();
    }
#undef ATT_DECODE
#undef ATT_LOAD_STAGE
}

constexpr int N_PHASES = 9;
__global__ void __launch_bounds__(NTHR, 2) hybrid_fwd(Args a) {
    extern __shared__ __attribute__((aligned(16))) unsigned char lds_raw[];
    LAS unsigned char* lds = (LAS unsigned char*)lds_raw;
    const int tid = threadIdx.x, lane = tid & 63, wave = __builtin_amdgcn_readfirstlane(tid >> 6);
    const int G = gridDim.x, bx = blockIdx.x;
    const int vcu = (G % 8 == 0) ? (bx % 8) * (G / 8) + bx / 8 : bx;
    const int gw = vcu * NWAVES + wave, NGW = G * NWAVES;
    unsigned char* ws = a.ws;
    float* MOD = (float*)(ws + WS_MOD); float* SWp = (float*)(ws + WS_SW); float* SSQ = (float*)(ws + WS_SSQ);
    bf16_t* WAB = (bf16_t*)(ws + WS_WAB); bf16_t* WOAB = (bf16_t*)(ws + WS_WOAB); bf16_t* WC = (bf16_t*)(ws + WS_WC); bf16_t* WOC = (bf16_t*)(ws + WS_WOC);
    bf16_t* H0 = (bf16_t*)(ws + WS_H0); bf16_t* Y = (bf16_t*)(ws + WS_Y);
    bf16_t* Ub = (bf16_t*)(ws + WS_U); bf16_t* Gb = (bf16_t*)(ws + WS_G); bf16_t* UZb = (bf16_t*)(ws + WS_UZ); bf16_t* Vb = (bf16_t*)(ws + WS_V);
    bf16_t* X1 = (bf16_t*)(ws + WS_X1); bf16_t* H1 = (bf16_t*)(ws + WS_H1);
    bf16_t* Qb = (bf16_t*)(ws + WS_Q); bf16_t* Kb = (bf16_t*)(ws + WS_K); bf16_t* Zb = (bf16_t*)(ws + WS_Z); bf16_t* VTb = (bf16_t*)(ws + WS_VT); bf16_t* OZb = (bf16_t*)(ws + WS_OZ);
    const int lo = a.ph_lo, hi = a.ph_hi;
#define IN(k) (lo <= (k) && (k) < hi)
    volatile LAS unsigned* bst = (volatile LAS unsigned*)(lds + LDS_BYTES - 64);
    if (tid < 4) bst[tid] = 0u;
    __syncthreads();
    XcdBarrier xbar; xbar.bar = (unsigned*)(ws + WS_CTL); xbar.x = 0; xbar.st = bst;
    if (hi - lo > 1) xbar = xcd_barrier_post((unsigned*)(ws + WS_CTL), bst);
#define SEAM(k) do { if (IN(k) && IN((k) + 1)) xcd_barrier(xbar); } while (0)

    if (IN(0)) {
        for (int task = bx; task < 192; task += G) {
            LAS float* sc_l = (LAS float*)lds; LAS float* red = sc_l + 2048;
            for (int i = tid; i < BATCH * D; i += NTHR) { const float v = a.c[i]; sc_l[i] = v / (1.0f + __expf(-v)); }
            __syncthreads();
            const int l = task / 96, n0 = (task % 96) * 32, kc = wave * 2 + (lane >> 5), n = n0 + (lane & 31);
            const float* W = a.ada_w + (size_t)l * D * 3072 + (size_t)(kc * 64) * 3072 + n;
            float a0 = 0.f, a1 = 0.f;
#pragma unroll
            for (int k = 0; k < 64; ++k) { const float wv = W[(size_t)k * 3072]; a0 += sc_l[kc * 64 + k] * wv; a1 += sc_l[D + kc * 64 + k] * wv; }
            red[(kc * 2 + 0) * 32 + (lane & 31)] = a0; red[(kc * 2 + 1) * 32 + (lane & 31)] = a1;
            __syncthreads();
            if (tid < 64) { const int b = tid >> 5, nn = tid & 31; float s = 0.f;
#pragma unroll
                for (int k = 0; k < 16; ++k) s += red[(k * 2 + b) * 32 + nn];
                MOD[(l * 2 + b) * 3072 + n0 + nn] = s + a.ada_b[l * 3072 + n0 + nn]; }
            __syncthreads();
        }
        for (int i = gw * 64 + lane; i < 8 * 128 * 128 / 8; i += NGW * 64) {
            const int e0 = 8 * i, t = (e0 >> 7) & 127, s0 = e0 & 127; const f32x4 p = *(const f32x4*)(a.sg_w + e0), q = *(const f32x4*)(a.sg_w + e0 + 4);
            float e[8] = {p.x, p.y, p.z, p.w, q.x, q.y, q.z, q.w};
#pragma unroll
            for (int k = 0; k < 8; ++k) if (s0 + k > t) e[k] = 0.f;
            u32x4 wv; wv.x = cvt_pk_bf16(e[0], e[1]); wv.y = cvt_pk_bf16(e[2], e[3]); wv.z = cvt_pk_bf16(e[4], e[5]); wv.w = cvt_pk_bf16(e[6], e[7]);
            *(u32x4*)((bf16_t*)(ws + WS_WTR) + e0) = wv; }
        const bool split0 = IN(1);
        if (split0) xcd_barrier_arrive(xbar);
        LAS float* scr = (LAS float*)(lds + wave * 16384);
        constexpr int I_AB = (D / 64) * (IN_AB / 32), I_OAB = (2048 / 64) * (D / 32), I_C = (D / 64) * (IN_C / 32), I_OC = (D / 64) * (D / 32);
        for (int it = gw; it < I_AB; it += NGW) p0_transpose_item<1>(a.w_in_ab, D, IN_AB, WAB, scr, it, lane);
        if (split0) xcd_barrier_wait(xbar, 0u);
    }
    if (IN(1)) {
        rms_phase(a.x, a.ln_g, MOD, H0, gw, NGW, lane);
        { LAS float* scr = (LAS float*)(lds + wave * 16384);
          constexpr int I_OAB = (2048 / 64) * (D / 32), I_C = (D / 64) * (IN_C / 32), I_OC = (D / 64) * (D / 32);
          for (int it = gw; it < I_OAB + I_C + I_OC; it += NGW) {
              int r = it;
              if (r < I_OAB) { p0_transpose_item<0>(a.w_out_ab, 2048, D, WOAB, scr, r, lane); continue; } r -= I_OAB;
              if (r < I_C) { p0_transpose_item<2>(a.w_in_c, D, IN_C, WC, scr, r, lane); continue; } r -= I_C;
              p0_transpose_item<0>(a.w_out_c, D, D, WOC, scr, r, lane);
          } }
    }
    SEAM(1);
    if (IN(2)) { pg8::Sched2 S; S.init(H0, WAB, M, IN_AB, nullptr, nullptr, 0, 0, D, G, bx);
        pg8::EpiP1 E{Ub}; pg8::gemm_phase<pg8::EpiP1, true, true>(lds, S, E); }
    SEAM(2);
    if (IN(3)) {
        { f32x4 s0[2][2], s1[2][2];
#pragma unroll
          for (int c = 0; c < 2; ++c)
#pragma unroll
              for (int q = 0; q < 2; ++q) { s0[c][q] = *(const f32x4*)(MOD + 2 * 3072 + 512 * c + 8 * lane + 4 * q); s1[c][q] = *(const f32x4*)(MOD + 3 * 3072 + 512 * c + 8 * lane + 4 * q); }
          for (int n = gw; n < IN_C; n += NGW) {
              const bf16_t* wr_ = WC + (size_t)c_row(n) * D + 8 * lane; float a0 = 0.f, a1 = 0.f;
#pragma unroll
              for (int c = 0; c < 2; ++c) { const u32x4 t = *(const u32x4*)(wr_ + 512 * c);
                  const f32x4 w0 = (f32x4){bf_lo(t.x), bf_hi(t.x), bf_lo(t.y), bf_hi(t.y)}, w1 = (f32x4){bf_lo(t.z), bf_hi(t.z), bf_lo(t.w), bf_hi(t.w)};
                  const f32x4 p0 = w0 * s0[c][0] + w1 * s0[c][1], p1 = w0 * s1[c][0] + w1 * s1[c][1];
                  a0 += (p0[0] + p0[1]) + (p0[2] + p0[3]); a1 += (p1[0] + p1[1]) + (p1[2] + p1[3]); }
              a0 = wave_sum(a0); a1 = wave_sum(a1);
              if (lane == 0) { SWp[n] = a0; SWp[4096 + n] = a1; } } }
    }
    if (IN(3)) mixer_phase(lds, Ub, Gb, UZb, Vb, a.conv_w, a.sg_norm, (const bf16_t*)(ws + WS_WTR), a.sg_b, Y, vcu, G);
    SEAM(3);
    if (IN(4)) { pg8::Sched2 S; S.init(Y, WOAB, M, D, nullptr, nullptr, 0, 0, 2048, G, bx);
        pg8::EpiRes<true> E{a.x, X1, MOD + 2048, a.ln_g + D, MOD + 2 * 3072 + 1024, H1, SSQ}; pg8::gemm_phase<pg8::EpiRes<true>, true, true>(lds, S, E); }
    if (IN(4) && IN(6)) xcd_barrier(xbar);
    if (IN(6)) { pg8::Sched2 S; S.init(H1, WC, M, 3072, WC + (size_t)3072 * D, H1, D, M, D, G, bx);
        pg8::EpiP5 E{Qb, VTb, a.q_norm, a.k_norm, SSQ, SWp}; pg8::gemm_phase<pg8::EpiP5, true, true>(lds, S, E); }
    SEAM(6);
    if (IN(7)) attn_phase(lds, Qb, Kb, VTb, Zb, OZb, vcu, G);
    SEAM(7);
    if (IN(8)) { pg8::Sched2 S; S.init(OZb, WOC, M, D, nullptr, nullptr, 0, 0, D, G, bx);
        pg8::EpiRes<false> E{X1, a.out, MOD + 2 * 3072 + 2048, nullptr, nullptr, nullptr, nullptr}; pg8::gemm_phase<pg8::EpiRes<false>, true, true>(lds, S, E); }
#undef IN
#undef SEAM
}

extern "C" void kernel_launch(void* const* d_in, const int* in_sizes, int n_in, void* d_out, int out_size, void* d_ws, size_t ws_size, hipStream_t stream) {
    static int grid = 0;
    if (grid == 0) {
        if (n_in != 15 || in_sizes[0] != M * D || out_size != M * D || ws_size < WS_END) { fprintf(stderr, "kernel_launch: unexpected problem geometry (n_in %d, ws %zu)\n", n_in, ws_size); grid = -1; return; }
        int dev = 0, cus = 0, per_cu = 0;
        (void)hipGetDevice(&dev); (void)hipDeviceGetAttribute(&cus, hipDeviceAttributeMultiprocessorCount, dev);
        if (hipFuncSetAttribute((const void*)hybrid_fwd, hipFuncAttributeMaxDynamicSharedMemorySize, LDS_BYTES) != hipSuccess) { fprintf(stderr, "kernel_launch: hipFuncSetAttribute failed\n"); grid = -1; return; }
        if (hipOccupancyMaxActiveBlocksPerMultiprocessor(&per_cu, (const void*)hybrid_fwd, NTHR, LDS_BYTES) != hipSuccess || per_cu < 1) { fprintf(stderr, "kernel_launch: occupancy query says %d\n", per_cu); per_cu = 1; }
        (void)hipGetLastError();
        grid = cus * per_cu;
    }
    if (grid < 0) return;
    Args a{};
    a.x = (const float*)d_in[0]; a.c = (const float*)d_in[1]; a.ln_g = (const float*)d_in[2]; a.ada_w = (const float*)d_in[3]; a.ada_b = (const float*)d_in[4];
    a.w_in_ab = (const float*)d_in[5]; a.conv_w = (const float*)d_in[6]; a.sg_norm = (const float*)d_in[7]; a.sg_w = (const float*)d_in[8]; a.sg_b = (const float*)d_in[9];
    a.w_out_ab = (const float*)d_in[10]; a.w_in_c = (const float*)d_in[11]; a.q_norm = (const float*)d_in[12]; a.k_norm = (const float*)d_in[13]; a.w_out_c = (const float*)d_in[14];
    a.out = (float*)d_out; a.ws = (unsigned char*)d_ws;
#if MK_MULTI
    for (int p = 0; p < N_PHASES; ++p) { a.ph_lo = p; a.ph_hi = p + 1; hipLaunchKernelGGL(hybrid_fwd, dim3(grid), dim3(NTHR), LDS_BYTES, stream, a); }
#else
    a.ph_lo = 0; a.ph_hi = N_PHASES;
    (void)hipMemsetAsync((char*)d_ws + WS_CTL, 0, CTL_ZERO_BYTES, stream);
    void* args[] = {&a};
    hipError_t e = hipLaunchCooperativeKernel((const void*)hybrid_fwd, dim3(grid), dim3(NTHR), args, LDS_BYTES, stream);
    if (e != hipSuccess) fprintf(stderr, "kernel_launch: cooperative launch failed: %s (grid %d)\n", hipGetErrorString(e), grid);
#endif
}
```
